# Optimizing an MI355X kernel written in HIP

```python
import math
import jax
import jax.numpy as jnp
from jax import lax
import numpy as np

D_MODEL = 1024
BATCH = 2
SEQ = 8192
DEPTH = 1
DEC_BATCH = 32
DEC_SEQ = 4
PAST_LEN = 16384
PAGE_SIZE = 128

HEAD_DIM = 64
ATTN_WIDTH = D_MODEL // 2
N_HEADS = ATTN_WIDTH // HEAD_DIM
GQA = 4
N_KV = N_HEADS // GQA
N_BRANCH = 3
KV_COLS = 2 * N_KV * HEAD_DIM
SSM_WIDTH = D_MODEL - ATTN_WIDTH
SSM_GROUP = 16
N_SSM_GROUPS = SSM_WIDTH // SSM_GROUP
SSM_STATE = 64
IN_COLS = ATTN_WIDTH + N_BRANCH * KV_COLS + N_BRANCH * N_HEADS + SSM_WIDTH
CMP_LEN = 32
CMP_STRIDE = 16
CMP_HID = 2 * HEAD_DIM
SLC_BLOCK = 64
TOP_K = 16
WINDOW = 512
Q_CHUNK = 128
ROT_DIM = HEAD_DIM // 4
ROPE_THETA = 500000.0
D_FF = 256 * math.ceil(8 * D_MODEL / 3 / 256)
EPS = 1e-6
NEG = -1e30
BIG = 1e4

kernel_name = "hymba_nsa_s5_adaln_decode_step"


def rmsnorm(x, g):
    xf = x.astype(jnp.float32)
    y = xf * lax.rsqrt(jnp.mean(xf * xf, axis=-1, keepdims=True) + EPS)
    return (y * g.astype(jnp.float32)).astype(x.dtype)


def rope(x, pos):
    half = ROT_DIM // 2
    inv = ROPE_THETA ** (-(jnp.arange(half, dtype=jnp.float32) * 2.0 / ROT_DIM))
    ang = pos.astype(jnp.float32)[:, None] * inv[None, :]
    shape = (1, pos.shape[0]) + (1,) * (x.ndim - 3) + (half,)
    cos = jnp.cos(ang).reshape(shape)
    sin = jnp.sin(ang).reshape(shape)
    xf = x.astype(jnp.float32)
    x1 = xf[..., :half]
    x2 = xf[..., half:ROT_DIM]
    out = jnp.concatenate([x1 * cos - x2 * sin, x1 * sin + x2 * cos, xf[..., ROT_DIM:]], axis=-1)
    return out.astype(x.dtype)


def masked_softmax(s, mask):
    p = jax.nn.softmax(jnp.where(mask, s, NEG), axis=-1)
    return jnp.where(mask, p, 0.0)


def block_overlap(nc, ns):
    cs = np.arange(nc) * CMP_STRIDE
    ss = np.arange(ns) * SLC_BLOCK
    ov = np.minimum(cs[:, None] + CMP_LEN, ss[None, :] + SLC_BLOCK) - np.maximum(cs[:, None], ss[None, :])
    return jnp.asarray((np.clip(ov, 0, None) / CMP_LEN).astype(np.float32))


def compress(rows, pe, w1, w2):
    bn, length, g, dh = rows.shape
    r = CMP_LEN // CMP_STRIDE
    n_chunk = length // CMP_STRIDE
    nc = n_chunk - r + 1
    ch = rows[:, :n_chunk * CMP_STRIDE].reshape(bn, n_chunk, CMP_STRIDE, g, dh)
    blk = jnp.concatenate([ch[:, m:m + nc] for m in range(r)], axis=2) + pe[None, None, :, None, :]
    flat = blk.transpose(0, 1, 3, 2, 4).reshape(bn, nc, g, CMP_LEN * dh)
    return jax.nn.gelu(flat @ w1) @ w2


def to_blocks(rows):
    bn, length, g, dh = rows.shape
    ns = -(-length // SLC_BLOCK)
    r = jnp.pad(rows, ((0, 0), (0, ns * SLC_BLOCK - length), (0, 0), (0, 0)))
    return r.reshape(bn, ns, SLC_BLOCK, g, dh).transpose(0, 3, 1, 2, 4)


def nsa_attend(q, q_pos, k_cmp, v_cmp, cmp_end, k_blk, v_blk, kv_win, win_pos, gates):
    bn, nq = q.shape[:2]
    nc = k_cmp.shape[1]
    ns = k_blk.shape[2]
    scale = HEAD_DIM ** -0.5
    qg = q.reshape(bn, nq, N_KV, GQA, HEAD_DIM)
    s_c = jnp.einsum('bqgrd,bcgd->bqgrc', qg, k_cmp).astype(jnp.float32) * scale
    m_c = (cmp_end[None, :] <= q_pos[:, None])[None, :, None, None, :]
    p_c = masked_softmax(s_c, m_c)
    o_c = jnp.einsum('bqgrc,bcgd->bqgrd', p_c.astype(v_cmp.dtype), v_cmp)
    imp = jnp.einsum('bqgrc,cj->bqgj', p_c, block_overlap(nc, ns))
    cur = q_pos // SLC_BLOCK
    j = jnp.arange(ns)
    future = (j[None, :] > cur[:, None])[None, :, None, :]
    forced = ((j[None, :] == 0) | (j[None, :] == cur[:, None]) | (j[None, :] == cur[:, None] - 1))[None, :, None, :]
    imp = jnp.where(future, NEG, jnp.where(forced, BIG, imp))
    _, idx = lax.top_k(imp, min(TOP_K, ns))
    bi = jnp.arange(bn)[:, None, None, None]
    gi = jnp.arange(N_KV)[None, None, :, None]
    k_sel = k_blk[bi, gi, idx]
    v_sel = v_blk[bi, gi, idx]
    n_sel = idx.shape[-1] * SLC_BLOCK
    key_pos = (idx[..., None] * SLC_BLOCK + jnp.arange(SLC_BLOCK)).reshape(bn, nq, N_KV, 1, n_sel)
    s_s = jnp.einsum('bqgrd,bqgkjd->bqgrkj', qg, k_sel).reshape(bn, nq, N_KV, GQA, n_sel)
    p_s = masked_softmax(s_s.astype(jnp.float32) * scale, key_pos <= q_pos[None, :, None, None, None])
    o_s = jnp.einsum('bqgrn,bqgnd->bqgrd', p_s.astype(v_sel.dtype), v_sel.reshape(bn, nq, N_KV, n_sel, HEAD_DIM))
    s_w = jnp.einsum('bqgrd,bwgd->bqgrw', qg, kv_win[:, :, 0]).astype(jnp.float32) * scale
    m_w = (win_pos[None, :] <= q_pos[:, None]) & (win_pos[None, :] >= q_pos[:, None] - WINDOW) & (win_pos[None, :] >= 0)
    p_w = masked_softmax(s_w, m_w[None, :, None, None, :])
    o_w = jnp.einsum('bqgrw,bwgd->bqgrd', p_w.astype(kv_win.dtype), kv_win[:, :, 1])
    g = gates.reshape(bn, nq, N_KV, GQA, N_BRANCH)
    o = g[..., 0:1] * o_c + g[..., 1:2] * o_s + g[..., 2:3] * o_w
    return o.reshape(bn, nq, ATTN_WIDTH)


def complex_affine_combine(e1, e2):
    a1r, a1i, b1r, b1i = e1
    a2r, a2i, b2r, b2i = e2
    return (a2r * a1r - a2i * a1i, a2r * a1i + a2i * a1r,
            a2r * b1r - a2i * b1i + b2r, a2r * b1i + a2i * b1r + b2i)


def s5_scan(u, h0_re, h0_im, prm):
    f32 = jnp.float32
    bn, length, _ = u.shape
    uf = u.astype(f32).reshape(bn, length, N_SSM_GROUPS, SSM_GROUP)
    a_re = prm['ssm_a_re'].astype(f32)
    a_im = prm['ssm_a_im'].astype(f32)
    dt = jnp.exp(prm['ssm_log_dt'].astype(f32))[:, None]
    mag = jnp.exp(a_re * dt)
    lb_re = mag * jnp.cos(a_im * dt)
    lb_im = mag * jnp.sin(a_im * dt)
    den = a_re * a_re + a_im * a_im
    n_re = lb_re - 1.0
    f_re = (n_re * a_re + lb_im * a_im) / den
    f_im = (lb_im * a_re - n_re * a_im) / den
    b_re = prm['ssm_b_re'].astype(f32)
    b_im = prm['ssm_b_im'].astype(f32)
    bb_re = f_re[..., None] * b_re - f_im[..., None] * b_im
    bb_im = f_re[..., None] * b_im + f_im[..., None] * b_re
    bu_re = jnp.einsum('blgi,gpi->blgp', uf, bb_re)
    bu_im = jnp.einsum('blgi,gpi->blgp', uf, bb_im)
    h0r = h0_re.astype(f32)
    h0i = h0_im.astype(f32)
    bu_re = bu_re.at[:, 0].add(lb_re * h0r - lb_im * h0i)
    bu_im = bu_im.at[:, 0].add(lb_re * h0i + lb_im * h0r)
    ar = jnp.broadcast_to(lb_re, bu_re.shape)
    ai = jnp.broadcast_to(lb_im, bu_im.shape)
    _, _, h_re, h_im = lax.associative_scan(complex_affine_combine, (ar, ai, bu_re, bu_im), axis=1)
    y = (jnp.einsum('blgp,gip->blgi', h_re, prm['ssm_c_re'].astype(f32))
         - jnp.einsum('blgp,gip->blgi', h_im, prm['ssm_c_im'].astype(f32))
         + prm['ssm_d'].astype(f32) * uf)
    return y.reshape(bn, length, SSM_WIDTH).astype(u.dtype), h_re[:, -1], h_im[:, -1]


def project(x, c, pos, prm):
    bn, length, _ = x.shape
    ada = (jax.nn.silu(c) @ prm['w_ada'] + prm['b_ada']).reshape(bn, 6, D_MODEL)
    shift1, scale1, gate1, shift2, scale2, gate2 = [ada[:, i][:, None, :] for i in range(6)]
    h = rmsnorm(x, prm['norm_mix_g']) * (1.0 + scale1) + shift1
    z = h @ prm['w_in']
    o1 = ATTN_WIDTH
    o2 = o1 + N_BRANCH * KV_COLS
    o3 = o2 + N_BRANCH * N_HEADS
    q = rope(rmsnorm(z[..., :o1].reshape(bn, length, N_HEADS, HEAD_DIM), prm['q_norm_g']), pos)
    kv = z[..., o1:o2].reshape(bn, length, N_BRANCH, 2, N_KV, HEAD_DIM)
    k = rope(rmsnorm(kv[:, :, :, 0], prm['k_norm_g'][:, None, :]), pos)
    kv = jnp.stack([k, kv[:, :, :, 1]], axis=3)
    gates = jax.nn.sigmoid(z[..., o2:o3]).reshape(bn, length, N_HEADS, N_BRANCH)
    u = z[..., o3:]
    return q, kv[:, :, 0], kv[:, :, 1], kv[:, :, 2], gates, u, (gate1, shift2, scale2, gate2)


def finish(x, attn, y_ssm, ada, prm):
    gate1, shift2, scale2, gate2 = ada
    s = jax.nn.gelu(y_ssm)
    s = s * jax.nn.sigmoid(s @ prm['w_glu'] + prm['b_glu'])
    mix = jnp.concatenate([rmsnorm(attn, prm['attn_out_g']), rmsnorm(s, prm['ssm_out_g'])], axis=-1) @ prm['w_out']
    x = x + gate1 * mix
    h = rmsnorm(x, prm['norm_ffn_g']) * (1.0 + scale2) + shift2
    f = (jax.nn.silu(h @ prm['w_ffn_gate']) * (h @ prm['w_ffn_up'])) @ prm['w_ffn_down']
    return x + gate2 * f


def compressed_kv(rows, prm):
    k_cmp = compress(rows[:, :, 0], prm['cmp_pe_k'], prm['cmp_w1_k'], prm['cmp_w2_k'])
    v_cmp = compress(rows[:, :, 1], prm['cmp_pe_v'], prm['cmp_w1_v'], prm['cmp_w2_v'])
    cmp_end = jnp.arange(k_cmp.shape[1]) * CMP_STRIDE + CMP_LEN - 1
    return k_cmp, v_cmp, cmp_end


def prompt_layer(x, c, prm):
    bn, length, _ = x.shape
    pos = jnp.arange(length)
    q, kv_c, kv_s, kv_w, gates, u, ada = project(x, c, pos, prm)
    k_cmp, v_cmp, cmp_end = compressed_kv(kv_c, prm)
    k_blk = to_blocks(kv_s[:, :, 0])
    v_blk = to_blocks(kv_s[:, :, 1])
    kv_w_pad = jnp.pad(kv_w, ((0, 0), (WINDOW, 0), (0, 0), (0, 0), (0, 0)))

    def chunk(ci):
        start = ci * Q_CHUNK
        q_c = lax.dynamic_slice_in_dim(q, start, Q_CHUNK, axis=1)
        g_c = lax.dynamic_slice_in_dim(gates, start, Q_CHUNK, axis=1)
        w_c = lax.dynamic_slice_in_dim(kv_w_pad, start, WINDOW + Q_CHUNK, axis=1)
        q_pos = start + jnp.arange(Q_CHUNK)
        w_pos = start - WINDOW + jnp.arange(WINDOW + Q_CHUNK)
        return nsa_attend(q_c, q_pos, k_cmp, v_cmp, cmp_end, k_blk, v_blk, w_c, w_pos, g_c)

    attn = lax.map(chunk, jnp.arange(length // Q_CHUNK))
    attn = jnp.moveaxis(attn, 0, 1).reshape(bn, length, ATTN_WIDTH)
    h0 = jnp.zeros((bn, N_SSM_GROUPS, SSM_STATE), jnp.float32)
    y_ssm, h_re, h_im = s5_scan(u, h0, h0, prm)
    y = finish(x, attn, y_ssm, ada, prm)
    keep = min(WINDOW, length)
    return y, (kv_c, kv_s, kv_w[:, length - keep:], h_re, h_im)


def sample_layer(x, c, l, cache_kv_cmp, cache_kv_slc, cache_kv_win, state_ssm_re, state_ssm_im, page_table, prm):
    bn, length, _ = x.shape
    past = page_table.shape[1] * PAGE_SIZE
    pos = past + jnp.arange(length)
    q, kv_c, kv_s, kv_w, gates, u, ada = project(x, c, pos, prm)
    row_shape = (bn, past, 2, N_KV, HEAD_DIM)
    full_c = jnp.concatenate([cache_kv_cmp[l, page_table].reshape(row_shape).astype(kv_c.dtype), kv_c], axis=1)
    full_s = jnp.concatenate([cache_kv_slc[l, page_table].reshape(row_shape).astype(kv_s.dtype), kv_s], axis=1)
    k_cmp, v_cmp, cmp_end = compressed_kv(full_c, prm)
    k_blk = to_blocks(full_s[:, :, 0])
    v_blk = to_blocks(full_s[:, :, 1])
    win = jnp.concatenate([cache_kv_win[l].astype(kv_w.dtype), kv_w], axis=1)
    w_pos = past - cache_kv_win.shape[2] + jnp.arange(win.shape[1])
    attn = nsa_attend(q, pos, k_cmp, v_cmp, cmp_end, k_blk, v_blk, win, w_pos, gates)
    y_ssm, h_re, h_im = s5_scan(u, state_ssm_re[l], state_ssm_im[l], prm)
    y = finish(x, attn, y_ssm, ada, prm)
    return y, (kv_c, kv_s, kv_w, h_re, h_im)


def setup_inputs(seed: int = 0) -> dict:
    key = jax.random.key(seed)
    ks = iter(jax.random.split(key, 48))
    f32 = jnp.float32

    def nrm(shape, s):
        return jax.random.normal(next(ks), shape, f32) * s

    n_pages = PAST_LEN // PAGE_SIZE
    n_used = DEC_BATCH * n_pages
    n_phys = n_used + max(1, n_used // 4)
    win_buf = min(WINDOW, PAST_LEN)
    dp = DEPTH
    g, p = N_SSM_GROUPS, SSM_STATE
    x_prompt = nrm((BATCH, SEQ, D_MODEL), 1.0)
    x_sample = nrm((DEC_BATCH, DEC_SEQ, D_MODEL), 1.0)
    cache_kv_cmp = nrm((dp, n_phys, PAGE_SIZE, 2, N_KV, HEAD_DIM), 1.0)
    cache_kv_slc = nrm((dp, n_phys, PAGE_SIZE, 2, N_KV, HEAD_DIM), 1.0)
    cache_kv_win = nrm((dp, DEC_BATCH, win_buf, 2, N_KV, HEAD_DIM), 1.0)
    state_ssm_re = nrm((dp, DEC_BATCH, g, p), 1.0)
    state_ssm_im = nrm((dp, DEC_BATCH, g, p), 1.0)
    page_table = jax.random.permutation(next(ks), n_phys)[:n_used].reshape(DEC_BATCH, n_pages).astype(jnp.int32)
    c_prompt = nrm((BATCH, D_MODEL), 1.0)
    c_sample = nrm((DEC_BATCH, D_MODEL), 1.0)
    return {
        'x_prompt': x_prompt, 'x_sample': x_sample,
        'cache_kv_cmp': cache_kv_cmp, 'cache_kv_slc': cache_kv_slc, 'cache_kv_win': cache_kv_win,
        'state_ssm_re': state_ssm_re, 'state_ssm_im': state_ssm_im, 'page_table': page_table,
        'c_prompt': c_prompt, 'c_sample': c_sample,
        'norm_mix_g': 1.0 + nrm((dp, D_MODEL), 0.01),
        'w_ada': nrm((dp, D_MODEL, 6 * D_MODEL), 0.5 * D_MODEL ** -0.5),
        'b_ada': nrm((dp, 6 * D_MODEL), 0.01),
        'w_in': nrm((dp, D_MODEL, IN_COLS), D_MODEL ** -0.5),
        'q_norm_g': 1.0 + nrm((dp, HEAD_DIM), 0.01),
        'k_norm_g': 1.0 + nrm((dp, N_BRANCH, HEAD_DIM), 0.01),
        'cmp_pe_k': nrm((dp, CMP_LEN, HEAD_DIM), 0.1),
        'cmp_w1_k': nrm((dp, CMP_LEN * HEAD_DIM, CMP_HID), (CMP_LEN * HEAD_DIM) ** -0.5),
        'cmp_w2_k': nrm((dp, CMP_HID, HEAD_DIM), CMP_HID ** -0.5),
        'cmp_pe_v': nrm((dp, CMP_LEN, HEAD_DIM), 0.1),
        'cmp_w1_v': nrm((dp, CMP_LEN * HEAD_DIM, CMP_HID), (CMP_LEN * HEAD_DIM) ** -0.5),
        'cmp_w2_v': nrm((dp, CMP_HID, HEAD_DIM), CMP_HID ** -0.5),
        'ssm_a_re': -0.5 + nrm((dp, g, p), 0.01),
        'ssm_a_im': jnp.pi * jnp.arange(p, dtype=f32)[None, None, :] + nrm((dp, g, p), 0.01),
        'ssm_log_dt': jax.random.uniform(next(ks), (dp, g), f32, math.log(1e-3), math.log(1e-1)),
        'ssm_b_re': nrm((dp, g, p, SSM_GROUP), (2 * SSM_GROUP) ** -0.5),
        'ssm_b_im': nrm((dp, g, p, SSM_GROUP), (2 * SSM_GROUP) ** -0.5),
        'ssm_c_re': nrm((dp, g, SSM_GROUP, p), (2 * p) ** -0.5),
        'ssm_c_im': nrm((dp, g, SSM_GROUP, p), (2 * p) ** -0.5),
        'ssm_d': nrm((dp, g, SSM_GROUP), 1.0),
        'w_glu': nrm((dp, SSM_WIDTH, SSM_WIDTH), SSM_WIDTH ** -0.5),
        'b_glu': nrm((dp, SSM_WIDTH), 0.01),
        'attn_out_g': 1.0 + nrm((dp, ATTN_WIDTH), 0.01),
        'ssm_out_g': 1.0 + nrm((dp, SSM_WIDTH), 0.01),
        'w_out': nrm((dp, ATTN_WIDTH + SSM_WIDTH, D_MODEL), (ATTN_WIDTH + SSM_WIDTH) ** -0.5),
        'norm_ffn_g': 1.0 + nrm((dp, D_MODEL), 0.01),
        'w_ffn_gate': nrm((dp, D_MODEL, D_FF), D_MODEL ** -0.5),
        'w_ffn_up': nrm((dp, D_MODEL, D_FF), D_MODEL ** -0.5),
        'w_ffn_down': nrm((dp, D_FF, D_MODEL), D_FF ** -0.5),
    }


def reference(x_prompt, x_sample, cache_kv_cmp, cache_kv_slc, cache_kv_win, state_ssm_re, state_ssm_im,
              page_table, c_prompt, c_sample, norm_mix_g, w_ada, b_ada, w_in, q_norm_g, k_norm_g,
              cmp_pe_k, cmp_w1_k, cmp_w2_k, cmp_pe_v, cmp_w1_v, cmp_w2_v, ssm_a_re, ssm_a_im, ssm_log_dt,
              ssm_b_re, ssm_b_im, ssm_c_re, ssm_c_im, ssm_d, w_glu, b_glu, attn_out_g, ssm_out_g, w_out,
              norm_ffn_g, w_ffn_gate, w_ffn_up, w_ffn_down):
    xp, xs = x_prompt, x_sample
    outs = [[] for _ in range(10)]
    for l in range(DEPTH):
        prm = dict(
            norm_mix_g=norm_mix_g[l], w_ada=w_ada[l], b_ada=b_ada[l], w_in=w_in[l],
            q_norm_g=q_norm_g[l], k_norm_g=k_norm_g[l],
            cmp_pe_k=cmp_pe_k[l], cmp_w1_k=cmp_w1_k[l], cmp_w2_k=cmp_w2_k[l],
            cmp_pe_v=cmp_pe_v[l], cmp_w1_v=cmp_w1_v[l], cmp_w2_v=cmp_w2_v[l],
            ssm_a_re=ssm_a_re[l], ssm_a_im=ssm_a_im[l], ssm_log_dt=ssm_log_dt[l],
            ssm_b_re=ssm_b_re[l], ssm_b_im=ssm_b_im[l], ssm_c_re=ssm_c_re[l], ssm_c_im=ssm_c_im[l],
            ssm_d=ssm_d[l], w_glu=w_glu[l], b_glu=b_glu[l], attn_out_g=attn_out_g[l],
            ssm_out_g=ssm_out_g[l], w_out=w_out[l], norm_ffn_g=norm_ffn_g[l],
            w_ffn_gate=w_ffn_gate[l], w_ffn_up=w_ffn_up[l], w_ffn_down=w_ffn_down[l])
        xp, st_p = prompt_layer(xp, c_prompt, prm)
        xs, st_s = sample_layer(xs, c_sample, l, cache_kv_cmp, cache_kv_slc, cache_kv_win,
                                state_ssm_re, state_ssm_im, page_table, prm)
        for i, a in enumerate(st_p + st_s):
            outs[i].append(a)
    n = [jnp.stack(o) for o in outs]
    return (xp, xs, n[0], n[1], n[2], n[3], n[4], n[5], n[6], n[7], n[8], n[9])
```

```cpp
#include <hip/hip_runtime.h>
#include <cstdio>
#include <cstdint>
#include <cstddef>

namespace pg8 {
#define PG8_LAS __attribute__((address_space(3)))
typedef unsigned short bf16_t;
typedef short bf16x8 __attribute__((ext_vector_type(8)));
typedef float f32x4 __attribute__((ext_vector_type(4)));
typedef unsigned u32x4 __attribute__((ext_vector_type(4)));
constexpr int BM = 256, BK = 64, HALF = 128, HTB = HALF * BK * 2  , STAGE_BYTES = 8 * HTB, NXCD = 8, WGM = 8;

__host__ __device__ __forceinline__ int lds_byte(int r, int c) { const int st = (r >> 4) * 2 + (c >> 5), rr = r & 15, cc = c & 31, ob = rr * 64 + cc * 2; return st * 1024 + (ob ^ (((ob >> 9) & 1) << 5)); }
__host__ __device__ __forceinline__ void stage_rc(int b, int& R, int& C) { const int st = b / 1024, sb = b % 1024, swz = sb ^ (((sb >> 9) & 1) << 5); R = (st >> 1) * 16 + swz / 64; C = (st & 1) * 32 + (swz % 64) / 2; }
__host__ __device__ __forceinline__ int perm32(int rho) { const int n = rho >> 4, i = rho & 15; return 8 * (i >> 2) + 4 * n + (i & 3); }

struct Unit { int pm, pn; };
struct Gemm { const bf16_t* A; const bf16_t* Bt; int M, N, K; };

struct StaticOrder {
    int nM, nN, nwg, G, c;
    __host__ __device__ void init(int M, int N, int G_, int c_) { nM = M / BM; nN = N / BM; nwg = nM * nN; G = G_; c = c_; }
    __host__ __device__ bool next(int i, Unit& u) const {
        const long L = (long)i * G + c; if (L >= nwg) return false;
        int wgid = (int)L; { const int q = nwg / NXCD, r = nwg % NXCD, xcd = wgid % NXCD, off = wgid / NXCD; wgid = (xcd < r ? xcd * (q + 1) : r * (q + 1) + (xcd - r) * q) + off; }
        const int nig = WGM * nN, gid = wgid / nig, fm = gid * WGM, gsz = (nM - fm) < WGM ? (nM - fm) : WGM;
        u.pm = fm + ((wgid % nig) % gsz); u.pn = (wgid % nig) / gsz; return true;
    }
    __device__ __forceinline__ void a_ready(const Unit&) const {}
    __device__ __forceinline__ void done(const Unit&) const {}
};
__device__ __forceinline__ unsigned cvt_pk_bf16(float lo, float hi) { unsigned r; asm volatile("v_cvt_pk_bf16_f32 %0, %1, %2" : "=v"(r) : "v"(lo), "v"(hi)); return r; }
typedef float f32x2 __attribute__((ext_vector_type(2)));
struct EpiF32 {
    static constexpr bool PERM = false, AFTER_DRAIN = false;
    float* C; int ldc; const float* bias;
    __device__ __forceinline__ void operator()(const f32x4 (&acc)[2][2][4][2], const Unit& u, int wr, int wc, int fr, int fq) const {
        const int row0 = u.pm * BM + wr * 64 + fr, col0 = u.pn * BM + wc * 32 + 4 * fq;
        f32x4 bv[2][2];
#pragma unroll
        for (int bj = 0; bj < 2; ++bj)
#pragma unroll
            for (int n = 0; n < 2; ++n) bv[bj][n] = bias ? *(const f32x4*)(bias + col0 + bj * HALF + n * 16) : (f32x4){0.f, 0.f, 0.f, 0.f};
#pragma unroll
        for (int ai = 0; ai < 2; ++ai)
#pragma unroll
            for (int m = 0; m < 4; ++m) { float* rowp = C + (size_t)(row0 + ai * HALF + m * 16) * ldc + col0;
#pragma unroll
                for (int bj = 0; bj < 2; ++bj)
#pragma unroll
                    for (int n = 0; n < 2; ++n) *(f32x4*)(rowp + bj * HALF + n * 16) = acc[ai][bj][m][n] + bv[bj][n]; }
    }
};
template <class Epi, class Sched, bool STAMP = false>
__device__ __forceinline__ void gemm_phase(PG8_LAS unsigned char* lds, const Gemm g, const Sched& S, const Epi& E, unsigned long long* stamps) {
    const int tid = threadIdx.x, wid = __builtin_amdgcn_readfirstlane(tid >> 6), lane = tid & 63, wr = wid >> 2, wc = wid & 3, fr = lane & 15, fq = lane >> 4;
    const int K = g.K, nt = K / BK;
    int ts_lo = 0, ts_hi = 0, nts = 0; const unsigned long long rt_entry = STAMP ? (unsigned long long)wall_clock64() : 0ull;
#define PG8_STAMP() do { if (STAMP && wid == 0 && nts < 64) { const unsigned long long _c = (unsigned long long)clock64(); \
        ts_lo = (lane == nts) ? (int)(unsigned)_c : ts_lo; ts_hi = (lane == nts) ? (int)(unsigned)(_c >> 32) : ts_hi; ++nts; } } while (0)
    PG8_STAMP();
    unsigned voffA[2], voffB[2];
#pragma unroll
    for (int i = 0; i < 2; ++i) { int R, C; stage_rc(tid * 16 + i * 8192, R, C); const int Rb = Epi::PERM ? ((R & ~31) + perm32(R & 31)) : R;
        voffA[i] = (unsigned)(R * K + C) * 2u; voffB[i] = (unsigned)(Rb * K + C) * 2u; }
    const size_t kstep = (size_t)(BK * 2);
    const size_t hstep = (size_t)HALF * K * 2;
    const size_t tstep = 2 * hstep;
    const unsigned ldsw = (unsigned)wid * 1024u;
    const int aoff = lds_byte(wr * 64 + fr, fq * 8), boff = lds_byte(wc * 32 + fr, fq * 8);
#define PG8_SA(b, h) (((b) * 2 + (h)) * HTB)
#define PG8_SB(b, h) ((4 + (b) * 2 + (h)) * HTB)
#define PG8_STAGE(bufoff, gbase, voff) do { _Pragma("unroll") for (int _i = 0; _i < 2; ++_i) \
        __builtin_amdgcn_global_load_lds((const unsigned*)((const char*)(gbase) + (voff)[_i]), (PG8_LAS unsigned*)(lds + (bufoff) + ldsw + _i * 8192), 16, 0, 0); } while (0)
#define PG8_LDA(dst, b, h) do { _Pragma("unroll") for (int m = 0; m < 4; ++m) _Pragma("unroll") for (int k = 0; k < 2; ++k) dst[m][k] = *(const PG8_LAS bf16x8*)(lds + PG8_SA(b, h) + aoff + m * 2048 + k * 1024); } while (0)
#define PG8_LDB(dst, b, h) do { _Pragma("unroll") for (int n = 0; n < 2; ++n) _Pragma("unroll") for (int k = 0; k < 2; ++k) dst[n][k] = *(const PG8_LAS bf16x8*)(lds + PG8_SB(b, h) + boff + n * 2048 + k * 1024); } while (0)
#define PG8_MMA(ai, bj, At, Bt) do { __builtin_amdgcn_s_setprio(1); _Pragma("unroll") for (int m = 0; m < 4; ++m) _Pragma("unroll") for (int n = 0; n < 2; ++n) _Pragma("unroll") for (int k = 0; k < 2; ++k) \
        acc[ai][bj][m][n] = __builtin_amdgcn_mfma_f32_16x16x32_bf16(Bt[n][k], At[m][k], acc[ai][bj][m][n], 0, 0, 0); __builtin_amdgcn_s_setprio(0); } while (0)
#define PG8_WAIT_V(n) asm volatile("s_waitcnt vmcnt(" #n ")" ::: "memory")
#define PG8_WAIT_L(n) asm volatile("s_waitcnt lgkmcnt(" #n ")" ::: "memory")
#define PG8_BAR __builtin_amdgcn_s_barrier()
#define PG8_SCHED __builtin_amdgcn_sched_barrier(0)
    Unit cur, nxt; int ui = 0;
    if (!S.next(0, cur)) return;
    f32x4 acc[2][2][4][2];
#pragma unroll
    for (int a = 0; a < 2; ++a)
#pragma unroll
        for (int b = 0; b < 2; ++b)
#pragma unroll
            for (int m = 0; m < 4; ++m)
#pragma unroll
                for (int n = 0; n < 2; ++n) acc[a][b][m][n] = (f32x4){0.f, 0.f, 0.f, 0.f};
    bf16x8 At[4][2], B0[2][2], B1[2][2];
    const char* cA = (const char*)g.A + (size_t)cur.pm * tstep; const char* cB = (const char*)g.Bt + (size_t)cur.pn * tstep;
    S.a_ready(cur);
    PG8_STAGE(PG8_SB(0, 0), cB, voffB); PG8_STAGE(PG8_SA(0, 0), cA, voffA); PG8_STAGE(PG8_SB(0, 1), cB + hstep, voffB); PG8_STAGE(PG8_SA(0, 1), cA + hstep, voffA);
    if (wr == 1) PG8_BAR;
    PG8_WAIT_V(4); PG8_BAR;
    PG8_STAGE(PG8_SB(1, 0), cB + kstep, voffB); PG8_STAGE(PG8_SA(1, 0), cA + kstep, voffA); PG8_STAGE(PG8_SB(1, 1), cB + hstep + kstep, voffB);
    PG8_WAIT_V(6); PG8_BAR;
    PG8_STAMP();
    for (;;) {
        const bool has_next = S.next(ui + 1, nxt);
        const char* nA = has_next ? (const char*)g.A + (size_t)nxt.pm * tstep : cA; const char* nB = has_next ? (const char*)g.Bt + (size_t)nxt.pn * tstep : cB;
        for (int t = 0; t < nt; t += 2) {
            const bool last = (t == nt - 2);
            const char* a1 = cA + (size_t)(t + 1) * kstep;
            const char* a2 = last ? nA : cA + (size_t)(t + 2) * kstep; const char* b2 = last ? nB : cB + (size_t)(t + 2) * kstep;
            const char* a3 = a2 + kstep; const char* b3 = b2 + kstep;
            if (last && has_next) S.a_ready(nxt);
            PG8_LDB(B0, 0, 0); PG8_SCHED; PG8_LDA(At, 0, 0); PG8_STAGE(PG8_SA(1, 1), a1 + hstep, voffA);
            PG8_WAIT_L(8); PG8_BAR; PG8_WAIT_L(0); PG8_MMA(0, 0, At, B0); PG8_BAR; PG8_SCHED;
            PG8_LDB(B1, 0, 1); PG8_STAGE(PG8_SB(0, 0), b2, voffB);
            PG8_BAR; PG8_WAIT_L(0); PG8_MMA(0, 1, At, B1); PG8_BAR;
            PG8_LDA(At, 0, 1); PG8_STAGE(PG8_SA(0, 0), a2, voffA);
            PG8_BAR; PG8_WAIT_L(0); PG8_MMA(1, 0, At, B0); PG8_BAR; PG8_SCHED;
            PG8_STAGE(PG8_SB(0, 1), b2 + hstep, voffB);
            PG8_WAIT_V(6); PG8_BAR; PG8_MMA(1, 1, At, B1); PG8_BAR;
            PG8_LDB(B0, 1, 0); PG8_SCHED; PG8_LDA(At, 1, 0); PG8_STAGE(PG8_SA(0, 1), a2 + hstep, voffA);
            PG8_WAIT_L(8); PG8_BAR; PG8_WAIT_L(0); PG8_MMA(0, 0, At, B0); PG8_BAR; PG8_SCHED;
            PG8_LDB(B1, 1, 1); PG8_STAGE(PG8_SB(1, 0), b3, voffB);
            PG8_BAR; PG8_WAIT_L(0); PG8_MMA(0, 1, At, B1); PG8_BAR;
            PG8_LDA(At, 1, 1); PG8_STAGE(PG8_SA(1, 0), a3, voffA);
            PG8_BAR; PG8_WAIT_L(0); PG8_MMA(1, 0, At, B0); PG8_BAR; PG8_SCHED;
            PG8_STAGE(PG8_SB(1, 1), b3 + hstep, voffB);
            PG8_WAIT_V(6); PG8_BAR; PG8_MMA(1, 1, At, B1); PG8_BAR;
        }
        PG8_STAMP();
        if constexpr (!Epi::AFTER_DRAIN) { E(acc, cur, wr, wc, fr, fq); S.done(cur); }
        PG8_STAMP();
        if (!has_next) break;
#pragma unroll
        for (int a = 0; a < 2; ++a)
#pragma unroll
            for (int b = 0; b < 2; ++b)
#pragma unroll
                for (int m = 0; m < 4; ++m)
#pragma unroll
                    for (int n = 0; n < 2; ++n) acc[a][b][m][n] = (f32x4){0.f, 0.f, 0.f, 0.f};
        cur = nxt; cA = nA; cB = nB; ++ui;
    }
    PG8_WAIT_V(0);
    if (wr == 0) PG8_BAR;
    PG8_BAR;
    if constexpr (Epi::AFTER_DRAIN) { E.fused(acc, cur, wr, wc, fr, fq, lds, wid, lane); S.done(cur); }
    PG8_STAMP();
    if (STAMP && wid == 0) { stamps[lane] = lane < nts ? (((unsigned long long)(unsigned)ts_hi << 32) | (unsigned)ts_lo) : 0ull;
        if (lane == 62) stamps[62] = rt_entry; if (lane == 63) stamps[63] = (unsigned long long)wall_clock64(); }
#undef PG8_STAMP
#undef PG8_SA
#undef PG8_SB
#undef PG8_STAGE
#undef PG8_LDA
#undef PG8_LDB
#undef PG8_MMA
#undef PG8_WAIT_V
#undef PG8_WAIT_L
#undef PG8_BAR
#undef PG8_SCHED
}
}

#define LAS __attribute__((address_space(3)))
typedef unsigned short bf16;
typedef float f32x4 __attribute__((ext_vector_type(4)));
typedef unsigned u32x4 __attribute__((ext_vector_type(4)));
typedef unsigned u32x2 __attribute__((ext_vector_type(2)));

constexpr int D = 1024, SEQ = 8192, NBP = 2, MP = NBP * SEQ;
constexpr int DB = 32, DSQ = 4, MS = DB * DSQ, MR = MP + MS;
constexpr int MPAD = 16640;
constexpr int PAST = 16384, PAGE = 128, NPG = 128;
constexpr int HD = 64, AW = 512, NH = 8, GQ = 4, NKV = 2;
constexpr int SW = 512, SG = 16, NSG = 32, SST = 64;
constexpr int INC = 1816, INP = 2048, O1 = 512, O2 = 1280, O3 = 1304;
constexpr int DFF = 2816;
constexpr int NC_P = 511, NC_S = 1023;
constexpr int CMP_ROWS_S = DB * 1024 * 2, CMP_ROWS_P = NBP * 512 * 2, CMP_ROWS = CMP_ROWS_S + CMP_ROWS_P;
constexpr int CMPO_S = DB * NC_S * 2 * 64, CMPO_P = NBP * NC_P * 2 * 64, CMPO = CMPO_S + CMPO_P;
constexpr float EPS = 1e-6f;
constexpr int SCH = 128, NCH = SEQ / SCH;

constexpr size_t O_YP = 0, O_YS = 16777216, O_KVC_P = 16908288, O_KVS_P = 21102592, O_KVW_P = 25296896, O_SRE_P = 25559040, O_SIM_P = 25563136,
                 O_KVC_S = 25567232, O_KVS_S = 25600000, O_KVW_S = 25632768, O_SRE_S = 25665536, O_SIM_S = 25731072, O_END = 25796608;

constexpr size_t A256(size_t x) { return (x + 255) & ~(size_t)255; }
constexpr size_t WS_CTL    = 0;
constexpr size_t WS_ADA    = (size_t)1 << 20;
constexpr size_t WS_LB     = WS_ADA + A256((size_t)34 * 6144 * 4);
constexpr size_t WS_BBR    = WS_LB + A256(2048 * 2 * 4);
constexpr size_t WS_BBI    = WS_BBR + A256(2048 * 16 * 4);
constexpr size_t WS_PEB    = WS_BBI + A256(2048 * 16 * 4);
constexpr size_t WS_WIN_T  = WS_PEB + A256(2 * 128 * 4);
constexpr size_t WS_WGLU_T = WS_WIN_T + (size_t)2048 * 1024 * 2;
constexpr size_t WS_WOUT_T = WS_WGLU_T + (size_t)512 * 512 * 2;
constexpr size_t WS_WUP_T  = WS_WOUT_T + (size_t)1024 * 1024 * 2;
constexpr size_t WS_WDN_T  = WS_WUP_T + (size_t)5632 * 1024 * 2;
constexpr size_t WS_WC1_T  = WS_WDN_T + (size_t)1024 * 2816 * 2;
constexpr size_t WS_H      = WS_WC1_T + (size_t)2 * 256 * 1024 * 2;
constexpr size_t WS_Z      = WS_H + (size_t)MPAD * 1024 * 2;
constexpr size_t WS_Q      = WS_Z + (size_t)MPAD * 2048 * 4;
constexpr size_t WS_KV3    = WS_Q + (size_t)MR * 512 * 4;
constexpr size_t WS_GATES  = WS_KV3 + (size_t)3 * MR * 256 * 4;
constexpr size_t WS_U      = WS_GATES + A256((size_t)MR * 24 * 4);
constexpr size_t WS_ACMP   = WS_U + (size_t)MR * 512 * 4;
constexpr size_t WS_PC     = WS_ACMP + (size_t)2 * CMP_ROWS * 1024 * 2;
constexpr size_t WS_CMPKV  = WS_PC + (size_t)2 * CMP_ROWS * 256 * 4;
constexpr size_t WS_E      = WS_CMPKV + A256((size_t)2 * CMPO * 4);
constexpr size_t WS_SF     = WS_E + (size_t)NBP * NSG * NCH * 64 * 2 * 4;
constexpr size_t WS_SB     = WS_SF + (size_t)MPAD * 512 * 4;
constexpr size_t WS_ATTN   = WS_SB + (size_t)MPAD * 512 * 2;
constexpr size_t WS_S2     = WS_ATTN + (size_t)MR * 512 * 4;
constexpr size_t WS_MIX    = WS_S2 + (size_t)MPAD * 512 * 4;
constexpr size_t WS_X1     = WS_MIX + (size_t)MPAD * 1024 * 2;
constexpr size_t WS_FF     = WS_X1 + (size_t)MPAD * 1024 * 4;
constexpr size_t WS_END    = WS_FF + (size_t)MPAD * 2816 * 2;

constexpr int LDS_BYTES = 150 * 1024;

struct P {
    const float *xp, *xs, *cache_c, *cache_s, *cache_w, *st_re, *st_im; const int* pt;
    const float *cp, *cs, *norm_mix_g, *w_ada, *b_ada, *w_in, *q_g, *k_g, *pe_k, *w1_k, *w2_k, *pe_v, *w1_v, *w2_v;
    const float *a_re, *a_im, *log_dt, *b_re, *b_im, *c_re, *c_im, *ssm_d, *w_glu, *b_glu, *attn_g, *ssm_g, *w_out, *norm_ffn_g, *w_gate, *w_up, *w_down;
    float* out; unsigned char* ws;
};

__device__ __forceinline__ unsigned f2bf(float f) { unsigned u = __builtin_bit_cast(unsigned, f); return (u + 0x7fffu + ((u >> 16) & 1u)) >> 16; }
__device__ __forceinline__ unsigned pk2(float lo, float hi) { return f2bf(lo) | (f2bf(hi) << 16); }
__device__ __forceinline__ float wave_sum(float v) {
#pragma unroll
    for (int o = 1; o < 64; o <<= 1) v += __shfl_xor(v, o);
    return v;
}
__device__ __forceinline__ float wave_max(float v) {
#pragma unroll
    for (int o = 1; o < 64; o <<= 1) v = fmaxf(v, __shfl_xor(v, o));
    return v;
}
__device__ __forceinline__ float rdlane(float v, int l) { return __int_as_float(__builtin_amdgcn_readlane(__float_as_int(v), l)); }
__device__ __forceinline__ float sigmoid_f(float x) { return 1.0f / (1.0f + expf(-x)); }
__device__ __forceinline__ float silu_f(float x) { return x / (1.0f + expf(-x)); }
__device__ __forceinline__ float gelu_tanh(float x) {
    const float y = 0.7978845608028654f * (x + 0.044715f * x * x * x);
    const float t = 1.0f - 2.0f / (expf(2.0f * y) + 1.0f);
    return 0.5f * x * (1.0f + t);
}
__device__ __forceinline__ void sincos_d(double x, double& s, double& c) {
    const double k = rint(x * 0.63661977236758134308);
    double y = fma(-k, 1.57079632679489655800e+00, x);
    y = fma(-k, 6.12323399573676603587e-17, y);
    const double y2 = y * y;
    double sp = 1.0 / 355687428096000.0;
    sp = fma(sp, y2, -1.0 / 1307674368000.0); sp = fma(sp, y2, 1.0 / 6227020800.0); sp = fma(sp, y2, -1.0 / 39916800.0); sp = fma(sp, y2, 1.0 / 362880.0);
    sp = fma(sp, y2, -1.0 / 5040.0); sp = fma(sp, y2, 1.0 / 120.0); sp = fma(sp, y2, -1.0 / 6.0); sp = fma(sp, y2, 1.0);
    const double sy = sp * y;
    double cp = 1.0 / 20922789888000.0;
    cp = fma(cp, y2, -1.0 / 87178291200.0); cp = fma(cp, y2, 1.0 / 479001600.0); cp = fma(cp, y2, -1.0 / 3628800.0); cp = fma(cp, y2, 1.0 / 40320.0);
    cp = fma(cp, y2, -1.0 / 720.0); cp = fma(cp, y2, 1.0 / 24.0); cp = fma(cp, y2, -0.5); cp = fma(cp, y2, 1.0);
    const double cy = cp;
    const int q = (int)((long long)k & 3);
    s = (q == 0) ? sy : (q == 1) ? cy : (q == 2) ? -sy : -cy;
    c = (q == 0) ? cy : (q == 1) ? -sy : (q == 2) ? -cy : sy;
}
__device__ __forceinline__ const float* xrow_ptr(const P& p, int r) { return r < MP ? p.xp + (size_t)r * D : p.xs + (size_t)(r - MP) * D; }
__device__ __forceinline__ int ada_row(int r) { return r < MP ? r / SEQ : 2 + (r - MP) / DSQ; }

__device__ __forceinline__ void transpose_item(const float* W, int ldw, int nvalid, bf16* WT, int ldt, int kb, int nb, int rowmode, int rowoff, LAS float* scr, int lane) {
    const int k0 = 64 * kb, n0 = 32 * nb;
#pragma unroll 8
    for (int i = 0; i < 32; ++i) { const int kk = 2 * i + (lane >> 5); const int nn = n0 + (lane & 31);
        scr[kk * 33 + (lane & 31)] = nn < nvalid ? W[(size_t)(k0 + kk) * ldw + nn] : 0.f; }
    asm volatile("s_waitcnt lgkmcnt(0)" ::: "memory");
    const int c = lane & 7;
#pragma unroll
    for (int j = 0; j < 4; ++j) { const int n = (lane >> 3) + 8 * j, nn = n0 + n; const LAS float* s = scr + (8 * c) * 33 + n;
        u32x4 o; o.x = pk2(s[0 * 33], s[1 * 33]); o.y = pk2(s[2 * 33], s[3 * 33]); o.z = pk2(s[4 * 33], s[5 * 33]); o.w = pk2(s[6 * 33], s[7 * 33]);
        if (nn < nvalid) { const int drow = rowmode ? ((nn >> 7) * 256 + rowoff + (nn & 127)) : (rowoff + nn);
            *(u32x4*)(WT + (size_t)drow * ldt + k0 + 8 * c) = o; } }
    asm volatile("s_waitcnt lgkmcnt(0)" ::: "memory");
}

__device__ __forceinline__ void ph_prep(const P& p, LAS unsigned char* lds) {
    const int tid = threadIdx.x, lane = tid & 63, wave = tid >> 6;
    unsigned char* ws = p.ws;
    for (int job = blockIdx.x; job < 99; job += gridDim.x) {
        if (job < 96) {
            LAS float* cbuf = (LAS float*)lds;
            for (int i = tid; i < 34 * 256; i += 512) { const int r = i >> 8, k4 = i & 255;
                const float* src = r < 2 ? p.cp + r * D : p.cs + (r - 2) * D;
                f32x4 v = *(const f32x4*)(src + k4 * 4); v.x = silu_f(v.x); v.y = silu_f(v.y); v.z = silu_f(v.z); v.w = silu_f(v.w);
                *(LAS f32x4*)(cbuf + r * D + k4 * 4) = v; }
            __syncthreads();
            const int c0 = job * 64;
            float acc[34];
#pragma unroll
            for (int r = 0; r < 34; ++r) acc[r] = 0.f;
            const float* wp = p.w_ada + (size_t)(wave * 128) * 6144 + c0 + lane;
            for (int k4 = 0; k4 < 32; ++k4) {
                const float w0 = wp[(size_t)(k4 * 4 + 0) * 6144], w1 = wp[(size_t)(k4 * 4 + 1) * 6144], w2 = wp[(size_t)(k4 * 4 + 2) * 6144], w3 = wp[(size_t)(k4 * 4 + 3) * 6144];
#pragma unroll
                for (int r = 0; r < 34; ++r) { const f32x4 cv = *(const LAS f32x4*)(cbuf + r * D + wave * 128 + k4 * 4);
                    acc[r] += cv.x * w0 + cv.y * w1 + cv.z * w2 + cv.w * w3; }
            }
            __syncthreads();
            LAS float* red = (LAS float*)lds;
#pragma unroll
            for (int r = 0; r < 34; ++r) red[(wave * 34 + r) * 64 + lane] = acc[r];
            __syncthreads();
            float* ADA = (float*)(ws + WS_ADA);
            for (int o = tid; o < 34 * 64; o += 512) { const int r = o >> 6, c = o & 63; float s = p.b_ada[c0 + c];
#pragma unroll
                for (int w = 0; w < 8; ++w) s += red[(w * 34 + r) * 64 + c];
                ADA[(size_t)r * 6144 + c0 + c] = s; }
            __syncthreads();
        } else if (job < 98) {
            const int kv = job - 96; const float* pe = kv ? p.pe_v : p.pe_k; const float* w1 = kv ? p.w1_v : p.w1_k;
            float a0 = 0.f, a1 = 0.f;
            for (int k = wave * 256; k < wave * 256 + 256; ++k) { const float pv = pe[k]; a0 += pv * w1[(size_t)k * 128 + lane]; a1 += pv * w1[(size_t)k * 128 + 64 + lane]; }
            LAS float* red = (LAS float*)lds;
            red[wave * 128 + lane] = a0; red[wave * 128 + 64 + lane] = a1;
            __syncthreads();
            if (tid < 128) { float s = 0.f;
#pragma unroll
                for (int w = 0; w < 8; ++w) s += red[w * 128 + tid];
                ((float*)(ws + WS_PEB))[kv * 128 + tid] = s; }
            __syncthreads();
        } else {
            float* LB = (float*)(ws + WS_LB); float* BBR = (float*)(ws + WS_BBR); float* BBI = (float*)(ws + WS_BBI);
            for (int idx = tid; idx < NSG * SST; idx += 512) { const int g = idx >> 6;
                const double dt = exp((double)p.log_dt[g]), are = (double)p.a_re[idx], aim = (double)p.a_im[idx];
                const double mag = exp(are * dt); double sn, cs; sincos_d(aim * dt, sn, cs);
                const double lbr = mag * cs, lbi = mag * sn, den = are * are + aim * aim, nre = lbr - 1.0;
                const double fre = (nre * are + lbi * aim) / den, fim = (lbi * are - nre * aim) / den;
                LB[idx * 2] = (float)lbr; LB[idx * 2 + 1] = (float)lbi;
#pragma unroll
                for (int i = 0; i < SG; ++i) { const double br = (double)p.b_re[idx * SG + i], bi = (double)p.b_im[idx * SG + i];
                    BBR[idx * SG + i] = (float)(fre * br - fim * bi); BBI[idx * SG + i] = (float)(fre * bi + fim * br); } }
        }
    }
    __syncthreads();
    LAS float* scr = (LAS float*)(lds + wave * 8448);
    const int gw = blockIdx.x * 8 + wave, NGW = gridDim.x * 8;
    constexpr int I0 = 16 * 57, I1 = 8 * 16, I2 = 16 * 32, I3 = 16 * 88, I5 = 44 * 32, I6 = 16 * 4;
    constexpr int NT = I0 + I1 + I2 + 2 * I3 + I5 + 4 * I6;
    for (int it = gw; it < NT; it += NGW) {
        int r = it;
        if (r < I0) { transpose_item(p.w_in, INC, INC, (bf16*)(ws + WS_WIN_T), 1024, r / 57, r % 57, 0, 0, scr, lane); continue; } r -= I0;
        if (r < I1) { transpose_item(p.w_glu, 512, 512, (bf16*)(ws + WS_WGLU_T), 512, r / 16, r % 16, 0, 0, scr, lane); continue; } r -= I1;
        if (r < I2) { transpose_item(p.w_out, 1024, 1024, (bf16*)(ws + WS_WOUT_T), 1024, r / 32, r % 32, 0, 0, scr, lane); continue; } r -= I2;
        if (r < I3) { transpose_item(p.w_gate, DFF, DFF, (bf16*)(ws + WS_WUP_T), 1024, r / 88, r % 88, 1, 0, scr, lane); continue; } r -= I3;
        if (r < I3) { transpose_item(p.w_up, DFF, DFF, (bf16*)(ws + WS_WUP_T), 1024, r / 88, r % 88, 1, 128, scr, lane); continue; } r -= I3;
        if (r < I5) { transpose_item(p.w_down, 1024, 1024, (bf16*)(ws + WS_WDN_T), DFF, r / 32, r % 32, 0, 0, scr, lane); continue; } r -= I5;
        { const int m = r / I6, rr = r % I6, kv = m >> 1, half = m & 1; const float* w1 = kv ? p.w1_v : p.w1_k;
          transpose_item(w1 + (size_t)half * 1024 * 128, 128, 128, (bf16*)(ws + WS_WC1_T) + (size_t)kv * 256 * 1024, 1024, rr / 4, rr % 4, 0, half * 128, scr, lane); }
    }
}

template <int WHICH>
__device__ __forceinline__ void ph_normmod(const P& p) {
    const int tid = threadIdx.x, lane = tid & 63, wave = tid >> 6, gw = blockIdx.x * 8 + wave, NGW = gridDim.x * 8;
    const float* ADA = (const float*)(p.ws + WS_ADA); const float* gain = WHICH ? p.norm_ffn_g : p.norm_mix_g;
    bf16* H = (bf16*)(p.ws + WS_H);
    for (int r = gw; r < MR; r += NGW) {
        const float* src = WHICH ? (const float*)(p.ws + WS_X1) + (size_t)r * D : xrow_ptr(p, r);
        const float* ar = ADA + (size_t)ada_row(r) * 6144;
        const float* sh = ar + (WHICH ? 3 : 0) * D; const float* sc = ar + (WHICH ? 4 : 1) * D;
        f32x4 v[4]; float ss = 0.f;
#pragma unroll
        for (int j = 0; j < 4; ++j) { v[j] = *(const f32x4*)(src + 4 * (lane + 64 * j)); ss += (v[j].x * v[j].x + v[j].y * v[j].y) + (v[j].z * v[j].z + v[j].w * v[j].w); }
        const float rstd = 1.0f / sqrtf(wave_sum(ss) * (1.0f / D) + EPS);
#pragma unroll
        for (int j = 0; j < 4; ++j) { const int c = 4 * (lane + 64 * j);
            const f32x4 g = *(const f32x4*)(gain + c), s1 = *(const f32x4*)(sc + c), s0 = *(const f32x4*)(sh + c);
            const f32x4 y = (v[j] * rstd) * g * (s1 + 1.0f) + s0;
            u32x2 o; o.x = pk2(y.x, y.y); o.y = pk2(y.z, y.w);
            *(u32x2*)(H + (size_t)r * D + c) = o; }
    }
}

__device__ __forceinline__ void ph_split(const P& p, LAS unsigned char* lds) {
    const int tid = threadIdx.x, lane = tid & 63, wave = tid >> 6, gw = blockIdx.x * 8 + wave, NGW = gridDim.x * 8;
    LAS float* zrow = (LAS float*)(lds + wave * 7424);
    const float* Z = (const float*)(p.ws + WS_Z); float* Q = (float*)(p.ws + WS_Q); float* KV3 = (float*)(p.ws + WS_KV3);
    float* GATES = (float*)(p.ws + WS_GATES); float* U = (float*)(p.ws + WS_U);
    const float qg = p.q_g[lane];
    for (int r = gw; r < MR; r += NGW) {
        const float* zr = Z + (size_t)r * INP;
        for (int i = lane; i < INC / 4; i += 64) *(LAS f32x4*)(zrow + 4 * i) = *(const f32x4*)(zr + 4 * i);
        const int pos = r < MP ? (r % SEQ) : PAST + ((r - MP) % DSQ);
        float cs, sn;
        { const double inv = exp(-(double)(lane & 7) * 1.640295422175541); double sd, cd; sincos_d((double)pos * inv, sd, cd); cs = (float)cd; sn = (float)sd; }
        float *oc, *os, *ow;
        if (r < MP) { const int b = r / SEQ, t = r % SEQ; oc = p.out + O_KVC_P + (size_t)r * 256; os = p.out + O_KVS_P + (size_t)r * 256;
            ow = t >= SEQ - 512 ? p.out + O_KVW_P + (size_t)(b * 512 + t - (SEQ - 512)) * 256 : nullptr; }
        else { const int s = r - MP; oc = p.out + O_KVC_S + (size_t)s * 256; os = p.out + O_KVS_S + (size_t)s * 256; ow = p.out + O_KVW_S + (size_t)s * 256; }
        asm volatile("s_waitcnt lgkmcnt(0)" ::: "memory");
        for (int hh = 0; hh < 14; ++hh) {
            int off; float gain;
            if (hh < 8) { off = hh * 64; gain = qg; }
            else { const int kk = hh - 8, br = kk >> 1, g = kk & 1; off = O1 + br * 256 + g * 64; gain = p.k_g[br * 64 + lane]; }
            const float v = zrow[off + lane];
            const float ss = wave_sum(v * v);
            float y = v * (1.0f / sqrtf(ss * (1.0f / 64.0f) + EPS)) * gain;
            const float pr = __shfl_xor(y, 8);
            if (lane < 8) y = y * cs - pr * sn; else if (lane < 16) y = pr * sn + y * cs;
            if (hh < 8) Q[(size_t)r * AW + hh * 64 + lane] = y;
            else { const int kk = hh - 8, br = kk >> 1, g = kk & 1;
                KV3[((size_t)br * MR + r) * 256 + g * 64 + lane] = y;
                float* o = br == 0 ? oc : br == 1 ? os : ow; if (o) o[g * 64 + lane] = y; }
        }
#pragma unroll
        for (int br = 0; br < 3; ++br)
#pragma unroll
            for (int g = 0; g < 2; ++g) { const float v = zrow[O1 + br * 256 + 128 + g * 64 + lane];
                KV3[((size_t)br * MR + r) * 256 + 128 + g * 64 + lane] = v;
                float* o = br == 0 ? oc : br == 1 ? os : ow; if (o) o[128 + g * 64 + lane] = v; }
        if (lane < 24) GATES[(size_t)r * 24 + lane] = sigmoid_f(zrow[O2 + lane]);
        for (int i = lane; i < SW / 4; i += 64) *(f32x4*)(U + (size_t)r * SW + 4 * i) = *(const LAS f32x4*)(zrow + O3 + 4 * i);
        asm volatile("s_waitcnt lgkmcnt(0)" ::: "memory");
    }
}

__device__ __forceinline__ void ph_cmp_build(const P& p) {
    const int tid = threadIdx.x, lane = tid & 63, wave = tid >> 6, gw = blockIdx.x * 8 + wave, NGW = gridDim.x * 8;
    bf16* A = (bf16*)(p.ws + WS_ACMP); const float* KVC = (const float*)(p.ws + WS_KV3);
    const int seg = lane >> 4, kvi = seg >> 1, g = seg & 1, d4 = (lane & 15) * 4;
    constexpr int NS = DB * PAST, NTOT = NS + MP;
    for (int idx = gw; idx < NTOT; idx += NGW) {
        const float* src; size_t arow; int tok;
        if (idx < NS) { const int b = idx / PAST, t = idx % PAST; const int page = p.pt[b * NPG + t / PAGE];
            src = p.cache_c + ((size_t)page * PAGE + (t % PAGE)) * 256; arow = (size_t)(b * 1024 + t / 16) * 2 + g; tok = t & 15; }
        else { const int r = idx - NS, b = r / SEQ, t = r % SEQ; src = KVC + (size_t)r * 256; arow = (size_t)CMP_ROWS_S + (size_t)(b * 512 + t / 16) * 2 + g; tok = t & 15; }
        const f32x4 v = *(const f32x4*)(src + 4 * lane);
        u32x2 o; o.x = pk2(v.x, v.y); o.y = pk2(v.z, v.w);
        *(u32x2*)(A + ((size_t)kvi * CMP_ROWS + arow) * 1024 + tok * 64 + d4) = o;
    }
}

__device__ __forceinline__ void ph_cmp_out(const P& p, LAS unsigned char* lds) {
    const int tid = threadIdx.x, lane = tid & 63, wave = tid >> 6, gw = blockIdx.x * 8 + wave, NGW = gridDim.x * 8;
    LAS float* w2s = (LAS float*)lds;
    for (int i = tid; i < 2 * 128 * 64; i += 512) w2s[i] = i < 8192 ? p.w2_k[i] : p.w2_v[i - 8192];
    __syncthreads();
    const float* PC = (const float*)(p.ws + WS_PC); const float* PEB = (const float*)(p.ws + WS_PEB); float* CK = (float*)(p.ws + WS_CMPKV);
    constexpr int NOS = DB * NC_S * 2, NOP = NBP * NC_P * 2, NO = NOS + NOP;
    for (int it = gw; it < 2 * NO; it += NGW) {
        const int kv = it / NO, o = it % NO;
        size_t ra; size_t dst;
        if (o < NOS) { const int b = o / (NC_S * 2), rem = o % (NC_S * 2), i = rem >> 1, g = rem & 1; ra = (size_t)(b * 1024 + i) * 2 + g; dst = (size_t)o * 64; }
        else { const int o2 = o - NOS, b = o2 / (NC_P * 2), rem = o2 % (NC_P * 2), i = rem >> 1, g = rem & 1; ra = (size_t)CMP_ROWS_S + (size_t)(b * 512 + i) * 2 + g; dst = (size_t)CMPO_S + (size_t)o2 * 64; }
        const float* pa = PC + ((size_t)kv * CMP_ROWS + ra) * 256; const float* pb = pa + 2 * 256;
        const float h0 = gelu_tanh(pa[lane] + pb[128 + lane] + PEB[kv * 128 + lane]);
        const float h1 = gelu_tanh(pa[64 + lane] + pb[192 + lane] + PEB[kv * 128 + 64 + lane]);
        const LAS float* w2 = w2s + kv * 8192;
        float acc = 0.f;
#pragma unroll 8
        for (int n = 0; n < 64; ++n) acc += rdlane(h0, n) * w2[n * 64 + lane];
#pragma unroll 8
        for (int n = 0; n < 64; ++n) acc += rdlane(h1, n) * w2[(64 + n) * 64 + lane];
        CK[(size_t)kv * CMPO + dst + lane] = acc;
    }
}

__device__ __forceinline__ void ph_ssm1(const P& p) {
    const int tid = threadIdx.x, lane = tid & 63, wave = tid >> 6, gw = blockIdx.x * 8 + wave, NGW = gridDim.x * 8;
    const float* LB = (const float*)(p.ws + WS_LB); const float* BBR = (const float*)(p.ws + WS_BBR); const float* BBI = (const float*)(p.ws + WS_BBI);
    const float* U = (const float*)(p.ws + WS_U); float* E = (float*)(p.ws + WS_E);
    for (int it = gw; it < NBP * NSG * NCH; it += NGW) {
        const int c = it % NCH, g = (it / NCH) % NSG, b = it / (NCH * NSG);
        const int sp = g * SST + lane;
        float bbr[SG], bbi[SG];
#pragma unroll
        for (int q = 0; q < 4; ++q) { const f32x4 a = *(const f32x4*)(BBR + sp * SG + 4 * q), bb = *(const f32x4*)(BBI + sp * SG + 4 * q);
            bbr[4 * q] = a.x; bbr[4 * q + 1] = a.y; bbr[4 * q + 2] = a.z; bbr[4 * q + 3] = a.w; bbi[4 * q] = bb.x; bbi[4 * q + 1] = bb.y; bbi[4 * q + 2] = bb.z; bbi[4 * q + 3] = bb.w; }
        const float lbr = LB[sp * 2], lbi = LB[sp * 2 + 1];
        float hr = 0.f, hi = 0.f;
        const int r0 = b * SEQ + c * SCH;
        for (int sb = 0; sb < SCH / 64; ++sb) {
            float ur[SG];
            const float* up = U + (size_t)(r0 + sb * 64 + lane) * SW + g * SG;
#pragma unroll
            for (int q = 0; q < 4; ++q) { const f32x4 a = *(const f32x4*)(up + 4 * q); ur[4 * q] = a.x; ur[4 * q + 1] = a.y; ur[4 * q + 2] = a.z; ur[4 * q + 3] = a.w; }
            for (int tt = 0; tt < 64; ++tt) {
                float br = 0.f, bi = 0.f;
#pragma unroll
                for (int i = 0; i < SG; ++i) { const float uv = rdlane(ur[i], tt); br += bbr[i] * uv; bi += bbi[i] * uv; }
                const float nr = lbr * hr - lbi * hi + br, ni = lbr * hi + lbi * hr + bi;
                hr = nr; hi = ni;
            }
        }
        float* e = E + ((size_t)((b * NSG + g) * NCH + c) * 64 + lane) * 2;
        e[0] = hr; e[1] = hi;
    }
}

__device__ __forceinline__ void ph_ssm2(const P& p, LAS unsigned char* lds) {
    const int tid = threadIdx.x, lane = tid & 63, wave = tid >> 6, gw = blockIdx.x * 8 + wave, NGW = gridDim.x * 8;
    const float* LB = (const float*)(p.ws + WS_LB); const float* BBR = (const float*)(p.ws + WS_BBR); const float* BBI = (const float*)(p.ws + WS_BBI);
    const float* U = (const float*)(p.ws + WS_U); const float* E = (const float*)(p.ws + WS_E);
    float* SF = (float*)(p.ws + WS_SF); bf16* SB = (bf16*)(p.ws + WS_SB);
    LAS float* cbuf = (LAS float*)(lds + wave * 16896);
    LAS float* hbuf = cbuf + 2048;
    constexpr int NIT_P = NBP * NSG * NCH, NIT = NIT_P + DB * NSG;
    for (int it = gw; it < NIT; it += NGW) {
        int b, g, c, r0, ntok; const bool prompt = it < NIT_P;
        if (prompt) { c = it % NCH; g = (it / NCH) % NSG; b = it / (NCH * NSG); r0 = b * SEQ + c * SCH; ntok = SCH; }
        else { const int i2 = it - NIT_P; c = 0; g = i2 % NSG; b = i2 / NSG; r0 = MP + b * DSQ; ntok = DSQ; }
        const int sp = g * SST + lane;
        float bbr[SG], bbi[SG];
#pragma unroll
        for (int q = 0; q < 4; ++q) { const f32x4 a = *(const f32x4*)(BBR + sp * SG + 4 * q), bb = *(const f32x4*)(BBI + sp * SG + 4 * q);
            bbr[4 * q] = a.x; bbr[4 * q + 1] = a.y; bbr[4 * q + 2] = a.z; bbr[4 * q + 3] = a.w; bbi[4 * q] = bb.x; bbi[4 * q + 1] = bb.y; bbi[4 * q + 2] = bb.z; bbi[4 * q + 3] = bb.w; }
        const float lbr = LB[sp * 2], lbi = LB[sp * 2 + 1];
        float hr, hi;
        if (prompt) {
            float tr = lbr, ti = lbi;
#pragma unroll
            for (int q = 0; q < 7; ++q) { const float nr = tr * tr - ti * ti, ni = 2.0f * tr * ti; tr = nr; ti = ni; }
            hr = 0.f; hi = 0.f;
            const float* e = E + ((size_t)((b * NSG + g) * NCH) * 64 + lane) * 2;
            for (int cc = 0; cc < c; ++cc) { const float er = e[(size_t)cc * 128], ei = e[(size_t)cc * 128 + 1];
                const float nr = tr * hr - ti * hi + er, ni = tr * hi + ti * hr + ei; hr = nr; hi = ni; }
        } else { hr = p.st_re[(b * NSG + g) * SST + lane]; hi = p.st_im[(b * NSG + g) * SST + lane]; }
        for (int i = 0; i < SG; ++i) { cbuf[lane * 16 + i] = p.c_re[(g * SG + i) * SST + lane]; cbuf[(64 + lane) * 16 + i] = -p.c_im[(g * SG + i) * SST + lane]; }
        const int tq = lane >> 2, iq = lane & 3;
        const f32x4 dv = *(const f32x4*)(p.ssm_d + g * SG + 4 * iq);
        for (int sb = 0; sb < (ntok + 15) / 16; ++sb) {
            const int nt = ntok - sb * 16 < 16 ? ntok - sb * 16 : 16;
            float ur[SG];
            { const int tl = (lane & 15) < nt ? (lane & 15) : 0; const float* up = U + (size_t)(r0 + sb * 16 + tl) * SW + g * SG;
#pragma unroll
              for (int q = 0; q < 4; ++q) { const f32x4 a = *(const f32x4*)(up + 4 * q); ur[4 * q] = a.x; ur[4 * q + 1] = a.y; ur[4 * q + 2] = a.z; ur[4 * q + 3] = a.w; } }
            for (int tt = 0; tt < nt; ++tt) {
                float br = 0.f, bi = 0.f;
#pragma unroll
                for (int i = 0; i < SG; ++i) { const float uv = rdlane(ur[i], tt); br += bbr[i] * uv; bi += bbi[i] * uv; }
                const float nr = lbr * hr - lbi * hi + br, ni = lbr * hi + lbi * hr + bi;
                hr = nr; hi = ni;
                hbuf[tt * 132 + lane] = hr; hbuf[tt * 132 + 64 + lane] = hi;
            }
            asm volatile("s_waitcnt lgkmcnt(0)" ::: "memory");
            if (tq < nt) {
                f32x4 acc = (f32x4){0.f, 0.f, 0.f, 0.f};
#pragma unroll 4
                for (int k4 = 0; k4 < 32; ++k4) { const f32x4 hv = *(const LAS f32x4*)(hbuf + tq * 132 + 4 * k4);
                    acc += hv.x * *(const LAS f32x4*)(cbuf + (4 * k4 + 0) * 16 + 4 * iq); acc += hv.y * *(const LAS f32x4*)(cbuf + (4 * k4 + 1) * 16 + 4 * iq);
                    acc += hv.z * *(const LAS f32x4*)(cbuf + (4 * k4 + 2) * 16 + 4 * iq); acc += hv.w * *(const LAS f32x4*)(cbuf + (4 * k4 + 3) * 16 + 4 * iq); }
                const int r = r0 + sb * 16 + tq;
                const f32x4 uv = *(const f32x4*)(U + (size_t)r * SW + g * SG + 4 * iq);
                f32x4 y = acc + dv * uv;
                y.x = gelu_tanh(y.x); y.y = gelu_tanh(y.y); y.z = gelu_tanh(y.z); y.w = gelu_tanh(y.w);
                *(f32x4*)(SF + (size_t)r * SW + g * SG + 4 * iq) = y;
                u32x2 o; o.x = pk2(y.x, y.y); o.y = pk2(y.z, y.w);
                *(u32x2*)(SB + (size_t)r * SW + g * SG + 4 * iq) = o;
            }
            asm volatile("s_waitcnt lgkmcnt(0)" ::: "memory");
        }
        if (prompt) { if (c == NCH - 1) { p.out[O_SRE_P + (b * NSG + g) * SST + lane] = hr; p.out[O_SIM_P + (b * NSG + g) * SST + lane] = hi; } }
        else { p.out[O_SRE_S + (b * NSG + g) * SST + lane] = hr; p.out[O_SIM_S + (b * NSG + g) * SST + lane] = hi; }
    }
}

constexpr float NEGM = -1e30f;
__device__ __forceinline__ void att_scores(const float* kp, int stride, int klo, int khi, LAS float* tile, int lane, const float (&q)[4], float (&s)[4]) {
    for (int kk = klo; kk < khi; ++kk) tile[kk * 65 + lane] = kp[(ptrdiff_t)kk * stride + lane];
    asm volatile("s_waitcnt vmcnt(0) lgkmcnt(0)" ::: "memory");
    s[0] = 0.f; s[1] = 0.f; s[2] = 0.f; s[3] = 0.f;
#pragma unroll 8
    for (int d = 0; d < 64; ++d) { const float kv = tile[lane * 65 + d];
        s[0] += kv * rdlane(q[0], d); s[1] += kv * rdlane(q[1], d); s[2] += kv * rdlane(q[2], d); s[3] += kv * rdlane(q[3], d); }
    asm volatile("s_waitcnt lgkmcnt(0)" ::: "memory");
}
__device__ __forceinline__ void att_tile(const float* kp, const float* vp, int stride, int klo, int khi, bool valid, LAS float* tile, int lane,
                                         const float (&q)[4], float (&m)[4], float (&l)[4], float (&o)[4]) {
    float s[4], pr[4];
    att_scores(kp, stride, klo, khi, tile, lane, q, s);
#pragma unroll
    for (int h = 0; h < 4; ++h) {
        const float sc = valid ? s[h] : NEGM;
        const float mn = fmaxf(m[h], wave_max(sc));
        const float pv = valid ? expf(sc - mn) : 0.f;
        const float al = expf(m[h] - mn);
        l[h] = l[h] * al + wave_sum(pv); o[h] *= al; m[h] = mn; pr[h] = pv;
    }
    for (int kk = klo; kk < khi; ++kk) { const float vv = vp[(ptrdiff_t)kk * stride + lane];
        o[0] += rdlane(pr[0], kk) * vv; o[1] += rdlane(pr[1], kk) * vv; o[2] += rdlane(pr[2], kk) * vv; o[3] += rdlane(pr[3], kk) * vv; }
}

__device__ __forceinline__ void ph_attn(const P& p, LAS unsigned char* lds) {
    const int tid = threadIdx.x, lane = tid & 63, wave = tid >> 6, gw = blockIdx.x * 8 + wave, NGW = gridDim.x * 8;
    LAS float* tile = (LAS float*)(lds + wave * 18432);
    LAS float* imp = tile + 64 * 65;
    LAS int* sel = (LAS int*)(imp + 320);
    const float* Q = (const float*)(p.ws + WS_Q); const float* KV3 = (const float*)(p.ws + WS_KV3); const float* GATES = (const float*)(p.ws + WS_GATES);
    const float* CK = (const float*)(p.ws + WS_CMPKV); float* ATTN = (float*)(p.ws + WS_ATTN);
    const float* KVS = KV3 + (size_t)MR * 256; const float* KVW = KV3 + (size_t)2 * MR * 256;
    for (int it = gw; it < MR * 2; it += NGW) {
        const int r = it >> 1, g = it & 1;
        const bool prompt = r < MP;
        const int b = prompt ? r / SEQ : (r - MP) / DSQ, t = prompt ? r % SEQ : PAST + (r - MP) % DSQ;
        const int qi = prompt ? 0 : (r - MP) % DSQ;
        float q[4];
#pragma unroll
        for (int h = 0; h < 4; ++h) q[h] = Q[(size_t)r * AW + (g * 4 + h) * 64 + lane] * 0.125f;
        float outv[4] = {0.f, 0.f, 0.f, 0.f};
        const float* gt = GATES + (size_t)r * 24 + g * 12;
        const int nc = prompt ? NC_P : NC_S, nblk = prompt ? 128 : 257;
        const int nvis = prompt ? (t >= 31 ? ((t - 31) / 16 + 1 < nc ? (t - 31) / 16 + 1 : nc) : 0) : nc;
        const float* kc = CK + (prompt ? (size_t)CMPO_S + (size_t)b * NC_P * 128 : (size_t)b * NC_S * 128) + g * 64;
        const float* vc = kc + CMPO;
        const int ntile = (nvis + 63) / 64;
        float m[4], l[4], o[4];
#pragma unroll
        for (int h = 0; h < 4; ++h) { m[h] = NEGM; l[h] = 0.f; o[h] = 0.f; }
        for (int ti = 0; ti < ntile; ++ti) { const int khi = nc - 64 * ti < 64 ? nc - 64 * ti : 64;
            att_tile(kc + (size_t)ti * 64 * 128, vc + (size_t)ti * 64 * 128, 128, 0, khi, 64 * ti + lane < nvis, tile, lane, q, m, l, o); }
#pragma unroll
        for (int h = 0; h < 4; ++h) if (l[h] > 0.f) outv[h] += gt[h * 3 + 0] * o[h] / l[h];
        for (int j = lane; j < 320; j += 64) imp[j] = 0.f;
        asm volatile("s_waitcnt lgkmcnt(0)" ::: "memory");
        {
            float carry = 0.f;
            float il[4];
#pragma unroll
            for (int h = 0; h < 4; ++h) il[h] = l[h] > 0.f ? 1.0f / l[h] : 0.f;
            for (int ti = 0; ti < ntile; ++ti) { const int khi = nc - 64 * ti < 64 ? nc - 64 * ti : 64;
                float s[4]; att_scores(kc + (size_t)ti * 64 * 128, 128, 0, khi, tile, lane, q, s);
                const bool valid = 64 * ti + lane < nvis;
                float ps = 0.f;
#pragma unroll
                for (int h = 0; h < 4; ++h) ps += valid ? expf(s[h] - m[h]) * il[h] : 0.f;
                const float val = (lane & 3) == 3 ? 0.5f * ps : ps;
                float qs = val + __shfl_xor(val, 1); qs += __shfl_xor(qs, 2);
                float up = __shfl_up(ps, 1) * 0.5f; if (lane == 0) up = carry;
                if ((lane & 3) == 0) imp[ti * 16 + (lane >> 2)] = qs + up;
                carry = 0.5f * rdlane(ps, 63);
            }
        }
        asm volatile("s_waitcnt lgkmcnt(0)" ::: "memory");
        {
            const int cur = t >> 6;
            unsigned long long key[5];
#pragma unroll
            for (int i = 0; i < 5; ++i) { const int j = lane + 64 * i; unsigned hi32 = 0u;
                if (j < nblk) { const float v = imp[j];
                    if (j > cur) hi32 = 1u; else if (j == 0 || j == cur || j == cur - 1) hi32 = __float_as_uint(1e4f) + 2u; else hi32 = __float_as_uint(fmaxf(v, 0.f)) + 2u; }
                key[i] = ((unsigned long long)hi32 << 32) | (unsigned)(0xFFFFFFFFu - (unsigned)j); }
            for (int k = 0; k < 16; ++k) {
                unsigned long long best = key[0];
#pragma unroll
                for (int i = 1; i < 5; ++i) best = key[i] > best ? key[i] : best;
#pragma unroll
                for (int o2 = 1; o2 < 64; o2 <<= 1) { const unsigned lo = __shfl_xor((unsigned)best, o2), hi = __shfl_xor((unsigned)(best >> 32), o2);
                    const unsigned long long ot = ((unsigned long long)hi << 32) | lo; best = ot > best ? ot : best; }
                const int wj = (int)(0xFFFFFFFFu - (unsigned)best);
                if (lane == 0) sel[k] = wj;
#pragma unroll
                for (int i = 0; i < 5; ++i) if (lane + 64 * i == wj) key[i] = (unsigned long long)(0xFFFFFFFFu - (unsigned)wj);
            }
        }
        asm volatile("s_waitcnt lgkmcnt(0)" ::: "memory");
#pragma unroll
        for (int h = 0; h < 4; ++h) { m[h] = NEGM; l[h] = 0.f; o[h] = 0.f; }
        for (int k = 0; k < 16; ++k) {
            const int j = __builtin_amdgcn_readfirstlane(sel[k]);
            const int pos0 = j * 64;
            if (pos0 > t) continue;
            if (prompt) { const float* kp = KVS + (size_t)(b * SEQ + pos0) * 256 + g * 64;
                att_tile(kp, kp + 128, 256, 0, 64, pos0 + lane <= t, tile, lane, q, m, l, o); }
            else if (j < 256) { const int page = p.pt[b * NPG + (j >> 1)]; const float* kp = p.cache_s + ((size_t)page * PAGE + (j & 1) * 64) * 256 + g * 64;
                att_tile(kp, kp + 128, 256, 0, 64, true, tile, lane, q, m, l, o); }
            else { const float* kp = KVS + (size_t)(MP + b * DSQ) * 256 + g * 64;
                att_tile(kp, kp + 128, 256, 0, DSQ, lane <= qi, tile, lane, q, m, l, o); }
        }
#pragma unroll
        for (int h = 0; h < 4; ++h) if (l[h] > 0.f) outv[h] += gt[h * 3 + 1] * o[h] / l[h];
#pragma unroll
        for (int h = 0; h < 4; ++h) { m[h] = NEGM; l[h] = 0.f; o[h] = 0.f; }
        if (prompt) {
            for (int ti = 0; ti < 9; ++ti) { const int pos0 = t - 512 + 64 * ti;
                int klo = pos0 < 0 ? -pos0 : 0, khi = t - pos0 + 1; if (khi > 64) khi = 64;
                if (klo >= khi) continue;
                const float* kp = KVW + ((ptrdiff_t)(b * SEQ) + pos0) * 256 + g * 64;
                att_tile(kp, kp + 128, 256, klo, khi, lane >= klo && lane < khi, tile, lane, q, m, l, o); }
        } else {
            for (int ti = 0; ti < 8; ++ti) { const float* kp = p.cache_w + ((size_t)(b * 512 + 64 * ti)) * 256 + g * 64;
                att_tile(kp, kp + 128, 256, 0, 64, 64 * ti + lane >= qi, tile, lane, q, m, l, o); }
            const float* kp = KVW + (size_t)(MP + b * DSQ) * 256 + g * 64;
            att_tile(kp, kp + 128, 256, 0, DSQ, lane <= qi, tile, lane, q, m, l, o);
        }
#pragma unroll
        for (int h = 0; h < 4; ++h) if (l[h] > 0.f) outv[h] += gt[h * 3 + 2] * o[h] / l[h];
#pragma unroll
        for (int h = 0; h < 4; ++h) ATTN[(size_t)r * AW + (g * 4 + h) * 64 + lane] = outv[h];
    }
}

__device__ __forceinline__ void ph_mixin(const P& p) {
    const int tid = threadIdx.x, lane = tid & 63, wave = tid >> 6, gw = blockIdx.x * 8 + wave, NGW = gridDim.x * 8;
    const float* ATTN = (const float*)(p.ws + WS_ATTN); const float* S2 = (const float*)(p.ws + WS_S2); bf16* MIX = (bf16*)(p.ws + WS_MIX);
    for (int r = gw; r < MR; r += NGW) {
#pragma unroll
        for (int part = 0; part < 2; ++part) {
            const float* src = (part ? S2 : ATTN) + (size_t)r * 512; const float* gain = part ? p.ssm_g : p.attn_g;
            f32x4 v[2]; float ss = 0.f;
#pragma unroll
            for (int j = 0; j < 2; ++j) { v[j] = *(const f32x4*)(src + 4 * (lane + 64 * j)); ss += (v[j].x * v[j].x + v[j].y * v[j].y) + (v[j].z * v[j].z + v[j].w * v[j].w); }
            const float rstd = 1.0f / sqrtf(wave_sum(ss) * (1.0f / 512.0f) + EPS);
#pragma unroll
            for (int j = 0; j < 2; ++j) { const int c = 4 * (lane + 64 * j); const f32x4 gn = *(const f32x4*)(gain + c); const f32x4 y = v[j] * rstd * gn;
                u32x2 o; o.x = pk2(y.x, y.y); o.y = pk2(y.z, y.w); *(u32x2*)(MIX + (size_t)r * D + part * 512 + c) = o; }
        }
    }
}

struct EpiCmp {
    static constexpr bool PERM = false, AFTER_DRAIN = false;
    float* C;
    __device__ __forceinline__ void operator()(const pg8::f32x4 (&acc)[2][2][4][2], const pg8::Unit& u, int wr, int wc, int fr, int fq) const {
        const int row0 = u.pm * 256 + wr * 64 + fr, col0 = wc * 32 + 4 * fq;
#pragma unroll
        for (int ai = 0; ai < 2; ++ai)
#pragma unroll
            for (int m = 0; m < 4; ++m) { float* rowp = C + (size_t)(row0 + ai * 128 + m * 16) * 256 + col0;
#pragma unroll
                for (int bj = 0; bj < 2; ++bj)
#pragma unroll
                    for (int n = 0; n < 2; ++n) *(pg8::f32x4*)(rowp + bj * 128 + n * 16) = acc[ai][bj][m][n]; }
    }
};
struct CmpOrder {
    int G, c;
    __device__ bool next(int i, pg8::Unit& u) const { const int L = i * G + c; if (L >= 2 * (CMP_ROWS / 256)) return false; u.pm = L; u.pn = L >= CMP_ROWS / 256 ? 1 : 0; return true; }
    __device__ __forceinline__ void a_ready(const pg8::Unit&) const {}
    __device__ __forceinline__ void done(const pg8::Unit&) const {}
};
struct EpiGlu {
    static constexpr bool PERM = false, AFTER_DRAIN = false;
    const float* SF; float* S2; const float* bias;
    __device__ __forceinline__ void operator()(const pg8::f32x4 (&acc)[2][2][4][2], const pg8::Unit& u, int wr, int wc, int fr, int fq) const {
        const int row0 = u.pm * 256 + wr * 64 + fr, col0 = u.pn * 256 + wc * 32 + 4 * fq;
#pragma unroll
        for (int ai = 0; ai < 2; ++ai)
#pragma unroll
            for (int m = 0; m < 4; ++m) { const size_t ro = (size_t)(row0 + ai * 128 + m * 16) * 512 + col0;
#pragma unroll
                for (int bj = 0; bj < 2; ++bj)
#pragma unroll
                    for (int n = 0; n < 2; ++n) { const int co = bj * 128 + n * 16; const pg8::f32x4 s = *(const pg8::f32x4*)(SF + ro + co); const pg8::f32x4 bv = *(const pg8::f32x4*)(bias + col0 + co);
                        const pg8::f32x4 t = acc[ai][bj][m][n] + bv; pg8::f32x4 o;
                        o[0] = s[0] * sigmoid_f(t[0]); o[1] = s[1] * sigmoid_f(t[1]); o[2] = s[2] * sigmoid_f(t[2]); o[3] = s[3] * sigmoid_f(t[3]);
                        *(pg8::f32x4*)(S2 + ro + co) = o; } }
    }
};
struct EpiOut {
    static constexpr bool PERM = false, AFTER_DRAIN = false;
    const float *xp, *xs, *ADA; float* X1;
    __device__ __forceinline__ void operator()(const pg8::f32x4 (&acc)[2][2][4][2], const pg8::Unit& u, int wr, int wc, int fr, int fq) const {
        const int row0 = u.pm * 256 + wr * 64 + fr, col0 = u.pn * 256 + wc * 32 + 4 * fq;
#pragma unroll
        for (int ai = 0; ai < 2; ++ai)
#pragma unroll
            for (int m = 0; m < 4; ++m) { const int r = row0 + ai * 128 + m * 16;
                if (r < MR) { const float* xr = (r < MP ? xp + (size_t)r * D : xs + (size_t)(r - MP) * D) + col0; const float* gr = ADA + (size_t)ada_row(r) * 6144 + 2 * D + col0;
#pragma unroll
                    for (int bj = 0; bj < 2; ++bj)
#pragma unroll
                        for (int n = 0; n < 2; ++n) { const int co = bj * 128 + n * 16;
                            *(pg8::f32x4*)(X1 + (size_t)r * D + col0 + co) = *(const pg8::f32x4*)(xr + co) + *(const pg8::f32x4*)(gr + co) * acc[ai][bj][m][n]; } } }
    }
};
struct EpiUp {
    static constexpr bool PERM = true, AFTER_DRAIN = false;
    bf16* FF;
    __device__ __forceinline__ void operator()(const pg8::f32x4 (&acc)[2][2][4][2], const pg8::Unit& u, int wr, int wc, int fr, int fq) const {
        const int row0 = u.pm * 256 + wr * 64 + fr, col0 = u.pn * 128 + wc * 32 + 8 * fq;
#pragma unroll
        for (int ai = 0; ai < 2; ++ai)
#pragma unroll
            for (int m = 0; m < 4; ++m) { bf16* rowp = FF + (size_t)(row0 + ai * 128 + m * 16) * DFF + col0;
                const pg8::f32x4 g0 = acc[ai][0][m][0], g1 = acc[ai][0][m][1], u0 = acc[ai][1][m][0], u1 = acc[ai][1][m][1];
                pg8::u32x4 w; w.x = pk2(silu_f(g0[0]) * u0[0], silu_f(g0[1]) * u0[1]); w.y = pk2(silu_f(g0[2]) * u0[2], silu_f(g0[3]) * u0[3]);
                w.z = pk2(silu_f(g1[0]) * u1[0], silu_f(g1[1]) * u1[1]); w.w = pk2(silu_f(g1[2]) * u1[2], silu_f(g1[3]) * u1[3]);
                *(pg8::u32x4*)rowp = w; }
    }
};
struct EpiDown {
    static constexpr bool PERM = false, AFTER_DRAIN = false;
    const float *X1, *ADA; float* out;
    __device__ __forceinline__ void operator()(const pg8::f32x4 (&acc)[2][2][4][2], const pg8::Unit& u, int wr, int wc, int fr, int fq) const {
        const int row0 = u.pm * 256 + wr * 64 + fr, col0 = u.pn * 256 + wc * 32 + 4 * fq;
#pragma unroll
        for (int ai = 0; ai < 2; ++ai)
#pragma unroll
            for (int m = 0; m < 4; ++m) { const int r = row0 + ai * 128 + m * 16;
                if (r < MR) { const float* xr = X1 + (size_t)r * D + col0; const float* gr = ADA + (size_t)ada_row(r) * 6144 + 5 * D + col0;
                    float* orow = (r < MP ? out + O_YP + (size_t)r * D : out + O_YS + (size_t)(r - MP) * D) + col0;
#pragma unroll
                    for (int bj = 0; bj < 2; ++bj)
#pragma unroll
                        for (int n = 0; n < 2; ++n) { const int co = bj * 128 + n * 16;
                            *(pg8::f32x4*)(orow + co) = *(const pg8::f32x4*)(xr + co) + *(const pg8::f32x4*)(gr + co) * acc[ai][bj][m][n]; } } }
    }
};

enum { PH_PREP = 0, PH_H, PH_INPROJ, PH_SPLIT, PH_CMPBUILD, PH_CMPGEMM, PH_CMPOUT, PH_SSM1, PH_SSM2, PH_ATTN, PH_GLU, PH_MIXIN, PH_OUT, PH_H2, PH_UP, PH_DOWN, PH_N };

template <int PH>
__global__ void __launch_bounds__(512, 2) k_ph(P p) {
    extern __shared__ __attribute__((aligned(16))) unsigned char lds_raw[];
    LAS unsigned char* lds = (LAS unsigned char*)lds_raw;
    unsigned char* ws = p.ws;
    if constexpr (PH == PH_PREP) ph_prep(p, lds);
    if constexpr (PH == PH_H) ph_normmod<0>(p);
    if constexpr (PH == PH_INPROJ) { pg8::Gemm g{(const bf16*)(ws + WS_H), (const bf16*)(ws + WS_WIN_T), MPAD, INP, D}; pg8::StaticOrder S; S.init(MPAD, INP, gridDim.x, blockIdx.x);
        pg8::EpiF32 E{(float*)(ws + WS_Z), INP, nullptr}; pg8::gemm_phase<pg8::EpiF32, pg8::StaticOrder>(lds, g, S, E, nullptr); }
    if constexpr (PH == PH_SPLIT) ph_split(p, lds);
    if constexpr (PH == PH_CMPBUILD) ph_cmp_build(p);
    if constexpr (PH == PH_CMPGEMM) { pg8::Gemm g{(const bf16*)(ws + WS_ACMP), (const bf16*)(ws + WS_WC1_T), 2 * CMP_ROWS, 512, 1024}; CmpOrder S{(int)gridDim.x, (int)blockIdx.x};
        EpiCmp E{(float*)(ws + WS_PC)}; pg8::gemm_phase<EpiCmp, CmpOrder>(lds, g, S, E, nullptr); }
    if constexpr (PH == PH_CMPOUT) ph_cmp_out(p, lds);
    if constexpr (PH == PH_SSM1) ph_ssm1(p);
    if constexpr (PH == PH_SSM2) ph_ssm2(p, lds);
    if constexpr (PH == PH_ATTN) ph_attn(p, lds);
    if constexpr (PH == PH_GLU) { pg8::Gemm g{(const bf16*)(ws + WS_SB), (const bf16*)(ws + WS_WGLU_T), MPAD, 512, 512}; pg8::StaticOrder S; S.init(MPAD, 512, gridDim.x, blockIdx.x);
        EpiGlu E{(const float*)(ws + WS_SF), (float*)(ws + WS_S2), p.b_glu}; pg8::gemm_phase<EpiGlu, pg8::StaticOrder>(lds, g, S, E, nullptr); }
    if constexpr (PH == PH_MIXIN) ph_mixin(p);
    if constexpr (PH == PH_OUT) { pg8::Gemm g{(const bf16*)(ws + WS_MIX), (const bf16*)(ws + WS_WOUT_T), MPAD, D, D}; pg8::StaticOrder S; S.init(MPAD, D, gridDim.x, blockIdx.x);
        EpiOut E{p.xp, p.xs, (const float*)(ws + WS_ADA), (float*)(ws + WS_X1)}; pg8::gemm_phase<EpiOut, pg8::StaticOrder>(lds, g, S, E, nullptr); }
    if constexpr (PH == PH_H2) ph_normmod<1>(p);
    if constexpr (PH == PH_UP) { pg8::Gemm g{(const bf16*)(ws + WS_H), (const bf16*)(ws + WS_WUP_T), MPAD, 2 * DFF, D}; pg8::StaticOrder S; S.init(MPAD, 2 * DFF, gridDim.x, blockIdx.x);
        EpiUp E{(bf16*)(ws + WS_FF)}; pg8::gemm_phase<EpiUp, pg8::StaticOrder>(lds, g, S, E, nullptr); }
    if constexpr (PH == PH_DOWN) { pg8::Gemm g{(const bf16*)(ws + WS_FF), (const bf16*)(ws + WS_WDN_T), MPAD, D, DFF}; pg8::StaticOrder S; S.init(MPAD, D, gridDim.x, blockIdx.x);
        EpiDown E{(const float*)(ws + WS_X1), (const float*)(ws + WS_ADA), p.out}; pg8::gemm_phase<EpiDown, pg8::StaticOrder>(lds, g, S, E, nullptr); }
}

template <int PH> static void launch_ph(const P& p, int grid, hipStream_t stream) {
    static bool init = false;
    if (!init) { (void)hipFuncSetAttribute((const void*)k_ph<PH>, hipFuncAttributeMaxDynamicSharedMemorySize, LDS_BYTES); init = true; }
    hipLaunchKernelGGL(k_ph<PH>, dim3(grid), dim3(512), LDS_BYTES, stream, p);
}

extern "C" void kernel_launch(void* const* d_in, const int* in_sizes, int n_in, void* d_out, int out_size, void* d_ws, size_t ws_size, hipStream_t stream) {
    if (n_in != 39 || (size_t)out_size != O_END || ws_size < WS_END) { fprintf(stderr, "kernel_launch: unexpected shapes (n_in %d out %d ws %zu need %zu)\n", n_in, out_size, ws_size, (size_t)WS_END); return; }
    P p{};
    const float** pf = (const float**)&p;
    (void)pf;
    p.xp = (const float*)d_in[0]; p.xs = (const float*)d_in[1]; p.cache_c = (const float*)d_in[2]; p.cache_s = (const float*)d_in[3]; p.cache_w = (const float*)d_in[4];
    p.st_re = (const float*)d_in[5]; p.st_im = (const float*)d_in[6]; p.pt = (const int*)d_in[7]; p.cp = (const float*)d_in[8]; p.cs = (const float*)d_in[9];
    p.norm_mix_g = (const float*)d_in[10]; p.w_ada = (const float*)d_in[11]; p.b_ada = (const float*)d_in[12]; p.w_in = (const float*)d_in[13]; p.q_g = (const float*)d_in[14]; p.k_g = (const float*)d_in[15];
    p.pe_k = (const float*)d_in[16]; p.w1_k = (const float*)d_in[17]; p.w2_k = (const float*)d_in[18]; p.pe_v = (const float*)d_in[19]; p.w1_v = (const float*)d_in[20]; p.w2_v = (const float*)d_in[21];
    p.a_re = (const float*)d_in[22]; p.a_im = (const float*)d_in[23]; p.log_dt = (const float*)d_in[24]; p.b_re = (const float*)d_in[25]; p.b_im = (const float*)d_in[26]; p.c_re = (const float*)d_in[27]; p.c_im = (const float*)d_in[28];
    p.ssm_d = (const float*)d_in[29]; p.w_glu = (const float*)d_in[30]; p.b_glu = (const float*)d_in[31]; p.attn_g = (const float*)d_in[32]; p.ssm_g = (const float*)d_in[33]; p.w_out = (const float*)d_in[34];
    p.norm_ffn_g = (const float*)d_in[35]; p.w_gate = (const float*)d_in[36]; p.w_up = (const float*)d_in[37]; p.w_down = (const float*)d_in[38];
    p.out = (float*)d_out; p.ws = (unsigned char*)d_ws;
    const int grid = 256;
    launch_ph<PH_PREP>(p, grid, stream);
    launch_ph<PH_H>(p, grid, stream);
    launch_ph<PH_INPROJ>(p, grid, stream);
    launch_ph<PH_SPLIT>(p, grid, stream);
    launch_ph<PH_CMPBUILD>(p, grid, stream);
    launch_ph<PH_CMPGEMM>(p, grid, stream);
    launch_ph<PH_CMPOUT>(p, grid, stream);
    launch_ph<PH_SSM1>(p, grid, stream);
    launch_ph<PH_SSM2>(p, grid, stream);
    launch_ph<PH_ATTN>(p, grid, stream);
    launch_ph<PH_GLU>(p, grid, stream);
    launch_ph<PH_MIXIN>(p, grid, stream);
    launch_ph<PH_OUT>(p, grid, stream);
    launch_ph<PH_H2>(p, grid, stream);
    launch_ph<PH_UP>(p, grid, stream);
    launch_ph<PH_DOWN>(p, grid, stream);
}
```

```cpp
#include <hip/hip_runtime.h>
#include <cstdio>
#include <cstdint>
#include <cstddef>

namespace pg8 {
#define PG8_LAS __attribute__((address_space(3)))
typedef unsigned short bf16_t;
typedef short bf16x8 __attribute__((ext_vector_type(8)));
typedef float f32x4 __attribute__((ext_vector_type(4)));
typedef unsigned u32x4 __attribute__((ext_vector_type(4)));
constexpr int BM = 256, BK = 64, HALF = 128, HTB = HALF * BK * 2  , STAGE_BYTES = 8 * HTB, NXCD = 8, WGM = 8;

__host__ __device__ __forceinline__ int lds_byte(int r, int c) { const int st = (r >> 4) * 2 + (c >> 5), rr = r & 15, cc = c & 31, ob = rr * 64 + cc * 2; return st * 1024 + (ob ^ (((ob >> 9) & 1) << 5)); }
__host__ __device__ __forceinline__ void stage_rc(int b, int& R, int& C) { const int st = b / 1024, sb = b % 1024, swz = sb ^ (((sb >> 9) & 1) << 5); R = (st >> 1) * 16 + swz / 64; C = (st & 1) * 32 + (swz % 64) / 2; }
__host__ __device__ __forceinline__ int perm32(int rho) { const int n = rho >> 4, i = rho & 15; return 8 * (i >> 2) + 4 * n + (i & 3); }

struct Unit { int pm, pn; };
struct Gemm { const bf16_t* A; const bf16_t* Bt; int M, N, K; };

struct StaticOrder {
    int nM, nN, nwg, G, c;
    __host__ __device__ void init(int M, int N, int G_, int c_) { nM = M / BM; nN = N / BM; nwg = nM * nN; G = G_; c = c_; }
    __host__ __device__ bool next(int i, Unit& u) const {
        const long L = (long)i * G + c; if (L >= nwg) return false;
        int wgid = (int)L; { const int q = nwg / NXCD, r = nwg % NXCD, xcd = wgid % NXCD, off = wgid / NXCD; wgid = (xcd < r ? xcd * (q + 1) : r * (q + 1) + (xcd - r) * q) + off; }
        const int nig = WGM * nN, gid = wgid / nig, fm = gid * WGM, gsz = (nM - fm) < WGM ? (nM - fm) : WGM;
        u.pm = fm + ((wgid % nig) % gsz); u.pn = (wgid % nig) / gsz; return true;
    }
    __device__ __forceinline__ void a_ready(const Unit&) const {}
    __device__ __forceinline__ void done(const Unit&) const {}
};
__device__ __forceinline__ unsigned cvt_pk_bf16(float lo, float hi) { unsigned r; asm volatile("v_cvt_pk_bf16_f32 %0, %1, %2" : "=v"(r) : "v"(lo), "v"(hi)); return r; }
typedef float f32x2 __attribute__((ext_vector_type(2)));
struct EpiF32 {
    static constexpr bool PERM = false, AFTER_DRAIN = false;
    float* C; int ldc; const float* bias;
    __device__ __forceinline__ void operator()(const f32x4 (&acc)[2][2][4][2], const Unit& u, int wr, int wc, int fr, int fq) const {
        const int row0 = u.pm * BM + wr * 64 + fr, col0 = u.pn * BM + wc * 32 + 4 * fq;
        f32x4 bv[2][2];
#pragma unroll
        for (int bj = 0; bj < 2; ++bj)
#pragma unroll
            for (int n = 0; n < 2; ++n) bv[bj][n] = bias ? *(const f32x4*)(bias + col0 + bj * HALF + n * 16) : (f32x4){0.f, 0.f, 0.f, 0.f};
#pragma unroll
        for (int ai = 0; ai < 2; ++ai)
#pragma unroll
            for (int m = 0; m < 4; ++m) { float* rowp = C + (size_t)(row0 + ai * HALF + m * 16) * ldc + col0;
#pragma unroll
                for (int bj = 0; bj < 2; ++bj)
#pragma unroll
                    for (int n = 0; n < 2; ++n) *(f32x4*)(rowp + bj * HALF + n * 16) = acc[ai][bj][m][n] + bv[bj][n]; }
    }
};
template <class Epi, class Sched, bool STAMP = false>
__device__ __forceinline__ void gemm_phase(PG8_LAS unsigned char* lds, const Gemm g, const Sched& S, const Epi& E, unsigned long long* stamps) {
    int tid_ = threadIdx.x; asm volatile("" : "+v"(tid_));
    const int tid = tid_, wid = __builtin_amdgcn_readfirstlane(tid >> 6), lane = tid & 63, wr = wid >> 2, wc = wid & 3, fr = lane & 15, fq = lane >> 4;
    const int K = g.K, nt = K / BK;
    int ts_lo = 0, ts_hi = 0, nts = 0; const unsigned long long rt_entry = STAMP ? (unsigned long long)wall_clock64() : 0ull;
#define PG8_STAMP() do { if (STAMP && wid == 0 && nts < 64) { const unsigned long long _c = (unsigned long long)clock64(); \
        ts_lo = (lane == nts) ? (int)(unsigned)_c : ts_lo; ts_hi = (lane == nts) ? (int)(unsigned)(_c >> 32) : ts_hi; ++nts; } } while (0)
    PG8_STAMP();
    unsigned voffA[2], voffB[2];
#pragma unroll
    for (int i = 0; i < 2; ++i) { int R, C; stage_rc(tid * 16 + i * 8192, R, C); const int Rb = Epi::PERM ? ((R & ~31) + perm32(R & 31)) : R;
        voffA[i] = (unsigned)(R * K + C) * 2u; voffB[i] = (unsigned)(Rb * K + C) * 2u; }
    const size_t kstep = (size_t)(BK * 2);
    const size_t hstep = (size_t)HALF * K * 2;
    const size_t tstep = 2 * hstep;
    const unsigned ldsw = (unsigned)wid * 1024u;
    const int aoff = lds_byte(wr * 64 + fr, fq * 8), boff = lds_byte(wc * 32 + fr, fq * 8);
#define PG8_SA(b, h) (((b) * 2 + (h)) * HTB)
#define PG8_SB(b, h) ((4 + (b) * 2 + (h)) * HTB)
#define PG8_STAGE(bufoff, gbase, voff) do { _Pragma("unroll") for (int _i = 0; _i < 2; ++_i) \
        __builtin_amdgcn_global_load_lds((const unsigned*)((const char*)(gbase) + (voff)[_i]), (PG8_LAS unsigned*)(lds + (bufoff) + ldsw + _i * 8192), 16, 0, 0); } while (0)
#define PG8_LDA(dst, b, h) do { _Pragma("unroll") for (int m = 0; m < 4; ++m) _Pragma("unroll") for (int k = 0; k < 2; ++k) dst[m][k] = *(const PG8_LAS bf16x8*)(lds + PG8_SA(b, h) + aoff + m * 2048 + k * 1024); } while (0)
#define PG8_LDB(dst, b, h) do { _Pragma("unroll") for (int n = 0; n < 2; ++n) _Pragma("unroll") for (int k = 0; k < 2; ++k) dst[n][k] = *(const PG8_LAS bf16x8*)(lds + PG8_SB(b, h) + boff + n * 2048 + k * 1024); } while (0)
#define PG8_MMA(ai, bj, At, Bt) do { __builtin_amdgcn_s_setprio(1); _Pragma("unroll") for (int m = 0; m < 4; ++m) _Pragma("unroll") for (int n = 0; n < 2; ++n) _Pragma("unroll") for (int k = 0; k < 2; ++k) \
        acc[ai][bj][m][n] = __builtin_amdgcn_mfma_f32_16x16x32_bf16(Bt[n][k], At[m][k], acc[ai][bj][m][n], 0, 0, 0); __builtin_amdgcn_s_setprio(0); } while (0)
#define PG8_WAIT_V(n) asm volatile("s_waitcnt vmcnt(" #n ")" ::: "memory")
#define PG8_WAIT_L(n) asm volatile("s_waitcnt lgkmcnt(" #n ")" ::: "memory")
#define PG8_BAR __builtin_amdgcn_s_barrier()
#define PG8_SCHED __builtin_amdgcn_sched_barrier(0)
    Unit cur, nxt; int ui = 0;
    if (!S.next(0, cur)) return;
    f32x4 acc[2][2][4][2];
#pragma unroll
    for (int a = 0; a < 2; ++a)
#pragma unroll
        for (int b = 0; b < 2; ++b)
#pragma unroll
            for (int m = 0; m < 4; ++m)
#pragma unroll
                for (int n = 0; n < 2; ++n) acc[a][b][m][n] = (f32x4){0.f, 0.f, 0.f, 0.f};
    bf16x8 At[4][2], B0[2][2], B1[2][2];
    const char* cA = (const char*)g.A + (size_t)cur.pm * tstep; const char* cB = (const char*)g.Bt + (size_t)cur.pn * tstep;
    S.a_ready(cur);
    PG8_STAGE(PG8_SB(0, 0), cB, voffB); PG8_STAGE(PG8_SA(0, 0), cA, voffA); PG8_STAGE(PG8_SB(0, 1), cB + hstep, voffB); PG8_STAGE(PG8_SA(0, 1), cA + hstep, voffA);
    if (wr == 1) PG8_BAR;
    PG8_WAIT_V(4); PG8_BAR;
    PG8_STAGE(PG8_SB(1, 0), cB + kstep, voffB); PG8_STAGE(PG8_SA(1, 0), cA + kstep, voffA); PG8_STAGE(PG8_SB(1, 1), cB + hstep + kstep, voffB);
    PG8_WAIT_V(6); PG8_BAR;
    PG8_STAMP();
    for (;;) {
        const bool has_next = S.next(ui + 1, nxt);
        const char* nA = has_next ? (const char*)g.A + (size_t)nxt.pm * tstep : cA; const char* nB = has_next ? (const char*)g.Bt + (size_t)nxt.pn * tstep : cB;
        for (int t = 0; t < nt; t += 2) {
            const bool last = (t == nt - 2);
            const char* a1 = cA + (size_t)(t + 1) * kstep;
            const char* a2 = last ? nA : cA + (size_t)(t + 2) * kstep; const char* b2 = last ? nB : cB + (size_t)(t + 2) * kstep;
            const char* a3 = a2 + kstep; const char* b3 = b2 + kstep;
            if (last && has_next) S.a_ready(nxt);
            PG8_LDB(B0, 0, 0); PG8_SCHED; PG8_LDA(At, 0, 0); PG8_STAGE(PG8_SA(1, 1), a1 + hstep, voffA);
            PG8_WAIT_L(8); PG8_BAR; PG8_WAIT_L(0); PG8_MMA(0, 0, At, B0); PG8_BAR; PG8_SCHED;
            PG8_LDB(B1, 0, 1); PG8_STAGE(PG8_SB(0, 0), b2, voffB);
            PG8_BAR; PG8_WAIT_L(0); PG8_MMA(0, 1, At, B1); PG8_BAR;
            PG8_LDA(At, 0, 1); PG8_STAGE(PG8_SA(0, 0), a2, voffA);
            PG8_BAR; PG8_WAIT_L(0); PG8_MMA(1, 0, At, B0); PG8_BAR; PG8_SCHED;
            PG8_STAGE(PG8_SB(0, 1), b2 + hstep, voffB);
            PG8_WAIT_V(6); PG8_BAR; PG8_MMA(1, 1, At, B1); PG8_BAR;
            PG8_LDB(B0, 1, 0); PG8_SCHED; PG8_LDA(At, 1, 0); PG8_STAGE(PG8_SA(0, 1), a2 + hstep, voffA);
            PG8_WAIT_L(8); PG8_BAR; PG8_WAIT_L(0); PG8_MMA(0, 0, At, B0); PG8_BAR; PG8_SCHED;
            PG8_LDB(B1, 1, 1); PG8_STAGE(PG8_SB(1, 0), b3, voffB);
            PG8_BAR; PG8_WAIT_L(0); PG8_MMA(0, 1, At, B1); PG8_BAR;
            PG8_LDA(At, 1, 1); PG8_STAGE(PG8_SA(1, 0), a3, voffA);
            PG8_BAR; PG8_WAIT_L(0); PG8_MMA(1, 0, At, B0); PG8_BAR; PG8_SCHED;
            PG8_STAGE(PG8_SB(1, 1), b3 + hstep, voffB);
            PG8_WAIT_V(6); PG8_BAR; PG8_MMA(1, 1, At, B1); PG8_BAR;
        }
        PG8_STAMP();
        if constexpr (!Epi::AFTER_DRAIN) { E(acc, cur, wr, wc, fr, fq); S.done(cur); }
        PG8_STAMP();
        if (!has_next) break;
#pragma unroll
        for (int a = 0; a < 2; ++a)
#pragma unroll
            for (int b = 0; b < 2; ++b)
#pragma unroll
                for (int m = 0; m < 4; ++m)
#pragma unroll
                    for (int n = 0; n < 2; ++n) acc[a][b][m][n] = (f32x4){0.f, 0.f, 0.f, 0.f};
        cur = nxt; cA = nA; cB = nB; ++ui;
    }
    PG8_WAIT_V(0);
    if (wr == 0) PG8_BAR;
    PG8_BAR;
    if constexpr (Epi::AFTER_DRAIN) { E.fused(acc, cur, wr, wc, fr, fq, lds, wid, lane); S.done(cur); }
    PG8_STAMP();
    if (STAMP && wid == 0) { stamps[lane] = lane < nts ? (((unsigned long long)(unsigned)ts_hi << 32) | (unsigned)ts_lo) : 0ull;
        if (lane == 62) stamps[62] = rt_entry; if (lane == 63) stamps[63] = (unsigned long long)wall_clock64(); }
#undef PG8_STAMP
#undef PG8_SA
#undef PG8_SB
#undef PG8_STAGE
#undef PG8_LDA
#undef PG8_LDB
#undef PG8_MMA
#undef PG8_WAIT_V
#undef PG8_WAIT_L
#undef PG8_BAR
#undef PG8_SCHED
}
}

#define LAS __attribute__((address_space(3)))
typedef unsigned short bf16;
typedef float f32x4 __attribute__((ext_vector_type(4)));
typedef unsigned u32x4 __attribute__((ext_vector_type(4)));
typedef unsigned u32x2 __attribute__((ext_vector_type(2)));

constexpr int D = 1024, SEQ = 8192, NBP = 2, MP = NBP * SEQ;
constexpr int DB = 32, DSQ = 4, MS = DB * DSQ, MR = MP + MS;
constexpr int MPAD = 16640;
constexpr int PAST = 16384, PAGE = 128, NPG = 128;
constexpr int HD = 64, AW = 512, NH = 8, GQ = 4, NKV = 2;
constexpr int SW = 512, SG = 16, NSG = 32, SST = 64;
constexpr int INC = 1816, INP = 2048, O1 = 512, O2 = 1280, O3 = 1304;
constexpr int DFF = 2816;
constexpr int NC_P = 511, NC_S = 1023;
constexpr int CMP_ROWS_S = DB * 1024 * 2, CMP_ROWS_P = NBP * 512 * 2, CMP_ROWS = CMP_ROWS_S + CMP_ROWS_P;
constexpr int CMPO_S = DB * NC_S * 2 * 64, CMPO_P = NBP * NC_P * 2 * 64, CMPO = CMPO_S + CMPO_P;
constexpr float EPS = 1e-6f;
constexpr int SCH = 128, NCH = SEQ / SCH;

constexpr size_t O_YP = 0, O_YS = 16777216, O_KVC_P = 16908288, O_KVS_P = 21102592, O_KVW_P = 25296896, O_SRE_P = 25559040, O_SIM_P = 25563136,
                 O_KVC_S = 25567232, O_KVS_S = 25600000, O_KVW_S = 25632768, O_SRE_S = 25665536, O_SIM_S = 25731072, O_END = 25796608;

constexpr size_t A256(size_t x) { return (x + 255) & ~(size_t)255; }
constexpr size_t WS_CTL    = 0;
constexpr size_t WS_ADA    = (size_t)1 << 20;
constexpr size_t WS_LB     = WS_ADA + A256((size_t)34 * 6144 * 4);
constexpr size_t WS_BBR    = WS_LB + A256(2048 * 2 * 4);
constexpr size_t WS_BBI    = WS_BBR + A256(2048 * 16 * 4);
constexpr size_t WS_PEB    = WS_BBI + A256(2048 * 16 * 4);
constexpr size_t WS_WIN_T  = WS_PEB + A256(2 * 8 * 128 * 4);
constexpr size_t WS_WGLU_T = WS_WIN_T + (size_t)2048 * 1024 * 2;
constexpr size_t WS_WOUT_T = WS_WGLU_T + (size_t)512 * 512 * 2;
constexpr size_t WS_WUP_T  = WS_WOUT_T + (size_t)1024 * 1024 * 2;
constexpr size_t WS_WDN_T  = WS_WUP_T + (size_t)5632 * 1024 * 2;
constexpr size_t WS_WC1_T  = WS_WDN_T + (size_t)1024 * 2816 * 2;
constexpr size_t WS_H      = WS_WC1_T + (size_t)2 * 256 * 1024 * 2;
constexpr size_t WS_Z      = WS_H + (size_t)MPAD * 1024 * 2;
constexpr size_t WS_H2     = WS_Z;
constexpr size_t WS_Q      = WS_Z + (size_t)MPAD * 2048 * 4;
constexpr size_t WS_KV3    = WS_Q + (size_t)MR * 512 * 4;
constexpr size_t WS_GATES  = WS_KV3 + (size_t)3 * MR * 256 * 4;
constexpr size_t WS_U      = WS_GATES + A256((size_t)MR * 24 * 4);
constexpr size_t WS_ACMP   = WS_U + (size_t)MR * 512 * 4;
constexpr size_t WS_PC     = WS_ACMP + (size_t)2 * CMP_ROWS * 1024 * 2;
constexpr size_t WS_CMPKV  = WS_PC + (size_t)2 * CMP_ROWS * 256 * 4;
constexpr size_t WS_E      = WS_CMPKV + A256((size_t)2 * CMPO * 4);
constexpr size_t WS_SF     = WS_E + (size_t)NBP * NSG * NCH * 64 * 2 * 4;
constexpr size_t WS_SB     = WS_SF + (size_t)MPAD * 512 * 4;
constexpr size_t WS_ATTN   = WS_SB + (size_t)MPAD * 512 * 2;
constexpr size_t WS_S2     = WS_ATTN + (size_t)MR * 512 * 4;
constexpr size_t WS_MIX    = WS_S2 + (size_t)MPAD * 512 * 4;
constexpr size_t WS_X1     = WS_MIX + (size_t)MPAD * 1024 * 2;
constexpr size_t WS_FF     = WS_X1 + (size_t)MPAD * 1024 * 4;
constexpr size_t WS_QB     = WS_FF + (size_t)MPAD * 2816 * 2;
constexpr size_t WS_KB     = WS_QB + (size_t)NBP * 2 * SEQ * 256 * 2;
constexpr size_t WS_VB     = WS_KB + (size_t)2 * NBP * 2 * SEQ * 64 * 2;
constexpr size_t WS_KCB    = WS_VB + (size_t)2 * NBP * 2 * SEQ * 64 * 2;
constexpr size_t WS_ROPE   = WS_KCB + (size_t)2 * NBP * 2 * 512 * 64 * 2;
constexpr size_t WS_END    = WS_ROPE + (size_t)SEQ * 16 * 4;

constexpr int LDS_BYTES = 150 * 1024;

struct P {
    const float *xp, *xs, *cache_c, *cache_s, *cache_w, *st_re, *st_im; const int* pt;
    const float *cp, *cs, *norm_mix_g, *w_ada, *b_ada, *w_in, *q_g, *k_g, *pe_k, *w1_k, *w2_k, *pe_v, *w1_v, *w2_v;
    const float *a_re, *a_im, *log_dt, *b_re, *b_im, *c_re, *c_im, *ssm_d, *w_glu, *b_glu, *attn_g, *ssm_g, *w_out, *norm_ffn_g, *w_gate, *w_up, *w_down;
    float* out; unsigned char* ws;
};

__device__ __forceinline__ int tid_now() { int t = threadIdx.x; asm volatile("" : "+v"(t)); return t; }
__device__ __forceinline__ unsigned pk2(float lo, float hi) { unsigned r; asm("v_cvt_pk_bf16_f32 %0, %1, %2" : "=v"(r) : "v"(lo), "v"(hi)); return r; }
__device__ __forceinline__ unsigned f2bf(float f) { return pk2(f, 0.f) & 0xffffu; }
template <int CTRL> __device__ __forceinline__ float dpp_mov(float v) { return __int_as_float(__builtin_amdgcn_update_dpp(0, __float_as_int(v), CTRL, 0xF, 0xF, true)); }
__device__ __forceinline__ float wave_sum(float v) {
    v += dpp_mov<0xB1>(v); v += dpp_mov<0x4E>(v); v += dpp_mov<0x141>(v); v += dpp_mov<0x140>(v);
    const float a = __int_as_float(__builtin_amdgcn_readlane(__float_as_int(v), 0)), b = __int_as_float(__builtin_amdgcn_readlane(__float_as_int(v), 16));
    const float c = __int_as_float(__builtin_amdgcn_readlane(__float_as_int(v), 32)), d = __int_as_float(__builtin_amdgcn_readlane(__float_as_int(v), 48));
    return (a + b) + (c + d);
}
__device__ __forceinline__ float wave_max(float v) {
    v = fmaxf(v, dpp_mov<0xB1>(v)); v = fmaxf(v, dpp_mov<0x4E>(v)); v = fmaxf(v, dpp_mov<0x141>(v)); v = fmaxf(v, dpp_mov<0x140>(v));
    const float a = __int_as_float(__builtin_amdgcn_readlane(__float_as_int(v), 0)), b = __int_as_float(__builtin_amdgcn_readlane(__float_as_int(v), 16));
    const float c = __int_as_float(__builtin_amdgcn_readlane(__float_as_int(v), 32)), d = __int_as_float(__builtin_amdgcn_readlane(__float_as_int(v), 48));
    return fmaxf(fmaxf(a, b), fmaxf(c, d));
}
__device__ __forceinline__ float rdlane(float v, int l) { return __int_as_float(__builtin_amdgcn_readlane(__float_as_int(v), l)); }
__device__ __forceinline__ float sigmoid_f(float x) { return 1.0f / (1.0f + expf(-x)); }
__device__ __forceinline__ float silu_f(float x) { return x / (1.0f + expf(-x)); }
__device__ __forceinline__ float gelu_tanh(float x) {
    const float y = 0.7978845608028654f * (x + 0.044715f * x * x * x);
    const float t = 1.0f - 2.0f / (expf(2.0f * y) + 1.0f);
    return 0.5f * x * (1.0f + t);
}
__device__ __forceinline__ void sincos_d(double x, double& s, double& c) {
    const double k = rint(x * 0.63661977236758134308);
    double y = fma(-k, 1.57079632679489655800e+00, x);
    y = fma(-k, 6.12323399573676603587e-17, y);
    const double y2 = y * y;
    double sp = 1.0 / 355687428096000.0;
    sp = fma(sp, y2, -1.0 / 1307674368000.0); sp = fma(sp, y2, 1.0 / 6227020800.0); sp = fma(sp, y2, -1.0 / 39916800.0); sp = fma(sp, y2, 1.0 / 362880.0);
    sp = fma(sp, y2, -1.0 / 5040.0); sp = fma(sp, y2, 1.0 / 120.0); sp = fma(sp, y2, -1.0 / 6.0); sp = fma(sp, y2, 1.0);
    const double sy = sp * y;
    double cp = 1.0 / 20922789888000.0;
    cp = fma(cp, y2, -1.0 / 87178291200.0); cp = fma(cp, y2, 1.0 / 479001600.0); cp = fma(cp, y2, -1.0 / 3628800.0); cp = fma(cp, y2, 1.0 / 40320.0);
    cp = fma(cp, y2, -1.0 / 720.0); cp = fma(cp, y2, 1.0 / 24.0); cp = fma(cp, y2, -0.5); cp = fma(cp, y2, 1.0);
    const double cy = cp;
    const int q = (int)((long long)k & 3);
    s = (q == 0) ? sy : (q == 1) ? cy : (q == 2) ? -sy : -cy;
    c = (q == 0) ? cy : (q == 1) ? -sy : (q == 2) ? -cy : sy;
}
__device__ __forceinline__ const float* xrow_ptr(const P& p, int r) { return r < MP ? p.xp + (size_t)r * D : p.xs + (size_t)(r - MP) * D; }
__device__ __forceinline__ int ada_row(int r) { return r < MP ? r / SEQ : 2 + (r - MP) / DSQ; }

__device__ __forceinline__ void transpose_item(const float* W, int ldw, int nvalid, bf16* WT, int ldt, int kb, int nb, int rowmode, int rowoff, LAS float* scr, int lane) {
    const int k0 = 64 * kb, n0 = 32 * nb;
    { float v[32]; const int nn = n0 + (lane & 31);
#pragma unroll
      for (int i = 0; i < 32; ++i) v[i] = nn < nvalid ? __builtin_nontemporal_load(W + (size_t)(k0 + 2 * i + (lane >> 5)) * ldw + nn) : 0.f;
#pragma unroll
      for (int i = 0; i < 32; ++i) scr[(2 * i + (lane >> 5)) * 33 + (lane & 31)] = v[i]; }
    asm volatile("s_waitcnt lgkmcnt(0)" ::: "memory");
    const int c = lane & 7;
#pragma unroll
    for (int j = 0; j < 4; ++j) { const int n = (lane >> 3) + 8 * j, nn = n0 + n; const LAS float* s = scr + (8 * c) * 33 + n;
        u32x4 o; o.x = pk2(s[0 * 33], s[1 * 33]); o.y = pk2(s[2 * 33], s[3 * 33]); o.z = pk2(s[4 * 33], s[5 * 33]); o.w = pk2(s[6 * 33], s[7 * 33]);
        if (nn < nvalid) { const int drow = rowmode ? ((nn >> 7) * 256 + rowoff + (nn & 127)) : (rowoff + nn);
            *(u32x4*)(WT + (size_t)drow * ldt + k0 + 8 * c) = o; } }
    asm volatile("s_waitcnt lgkmcnt(0)" ::: "memory");
}

constexpr int PREP_JOBS = 224;
__device__ __forceinline__ f32x4 peb_load(const float* PEB, int kv, int col) {
    f32x4 s = *(const f32x4*)(PEB + (kv * 8) * 128 + col);
#pragma unroll
    for (int q = 1; q < 8; ++q) s += *(const f32x4*)(PEB + (kv * 8 + q) * 128 + col);
    return s;
}
__device__ __forceinline__ void ph_prep(const P& p, LAS unsigned char* lds) {
    const int tid = tid_now(), lane = tid & 63, wave = tid >> 6;
    unsigned char* ws = p.ws;
    for (int job = blockIdx.x; job < PREP_JOBS; job += gridDim.x) {
        if (job < 192) {
            LAS float* cbuf = (LAS float*)lds;
            { f32x4 cv[17];
#pragma unroll
              for (int it = 0; it < 17; ++it) { const int i = tid + it * 512, r = i >> 8, k4 = i & 255;
                  const float* src = r < 2 ? p.cp + r * D : p.cs + (r - 2) * D; cv[it] = *(const f32x4*)(src + k4 * 4); }
#pragma unroll
              for (int it = 0; it < 17; ++it) { const int i = tid + it * 512; f32x4 v = cv[it];
                  v.x = silu_f(v.x); v.y = silu_f(v.y); v.z = silu_f(v.z); v.w = silu_f(v.w);
                  *(LAS f32x4*)(cbuf + i * 4) = v; } }
            __syncthreads();
            const int c0 = job * 32, col = lane & 31, kh = lane >> 5, kbase = wave * 128 + kh * 64;
            float acc[34];
#pragma unroll
            for (int r = 0; r < 34; ++r) acc[r] = 0.f;
            const float* ub = p.w_ada + (size_t)(__builtin_amdgcn_readfirstlane(wave) * 128) * 6144 + c0;
            const unsigned voff = (unsigned)(kh * 64 * 6144 + col) * 4u;
            LAS const float* cb0 = cbuf + kbase; asm volatile("" : "+v"(cb0));
            LAS const float* cb1 = cb0 + 16 * D; asm volatile("" : "+v"(cb1));
            LAS const float* cb2 = cb0 + 32 * D; asm volatile("" : "+v"(cb2));
#pragma unroll
            for (int hb = 0; hb < 2; ++hb) {
                float wv[32];
#pragma unroll
                for (int k = 0; k < 32; ++k) wv[k] = __builtin_nontemporal_load((const float*)((const char*)(ub + (size_t)(hb * 32 + k) * 6144) + voff));
                asm volatile("" ::: "memory");
#pragma unroll
                for (int k4 = 0; k4 < 8; ++k4) {
#pragma unroll
                    for (int r = 0; r < 34; ++r) { const f32x4 cv = *(const LAS f32x4*)((r < 16 ? cb0 + r * D : r < 32 ? cb1 + (r - 16) * D : cb2 + (r - 32) * D) + hb * 32 + k4 * 4);
                        acc[r] += cv.x * wv[4 * k4] + cv.y * wv[4 * k4 + 1] + cv.z * wv[4 * k4 + 2] + cv.w * wv[4 * k4 + 3]; }
                    asm volatile("" ::: "memory");
                }
            }
            __syncthreads();
            LAS float* red = (LAS float*)lds;
#pragma unroll
            for (int r = 0; r < 34; ++r) red[((wave * 2 + kh) * 34 + r) * 32 + col] = acc[r];
            __syncthreads();
            float* ADA = (float*)(ws + WS_ADA);
            for (int o = tid; o < 34 * 32; o += 512) { const int r = o >> 5, c = o & 31; float s = p.b_ada[c0 + c];
#pragma unroll
                for (int w = 0; w < 16; ++w) s += red[(w * 34 + r) * 32 + c];
                ADA[(size_t)r * 6144 + c0 + c] = s; }
            __syncthreads();
        } else if (job < 208) {
            const int kv = (job - 192) >> 3, part = (job - 192) & 7; const float* pe = kv ? p.pe_v : p.pe_k; const float* w1 = kv ? p.w1_v : p.w1_k;
            float a0 = 0.f, a1 = 0.f;
#pragma unroll 1
            for (int kb = 0; kb < 2; ++kb) { const int k0 = part * 256 + wave * 32 + kb * 16; float x0[16], x1[16], pv[16];
#pragma unroll
                for (int u = 0; u < 16; ++u) { pv[u] = pe[k0 + u]; x0[u] = w1[(size_t)(k0 + u) * 128 + lane]; x1[u] = w1[(size_t)(k0 + u) * 128 + 64 + lane]; }
#pragma unroll
                for (int u = 0; u < 16; ++u) { a0 += pv[u] * x0[u]; a1 += pv[u] * x1[u]; } }
            LAS float* red = (LAS float*)lds;
            red[wave * 128 + lane] = a0; red[wave * 128 + 64 + lane] = a1;
            __syncthreads();
            if (tid < 128) { float s = 0.f;
#pragma unroll
                for (int w = 0; w < 8; ++w) s += red[w * 128 + tid];
                ((float*)(ws + WS_PEB))[(kv * 8 + part) * 128 + tid] = s; }
            __syncthreads();
        } else {
            const int sj = job - 208;
            float* LB = (float*)(ws + WS_LB); float* BBR = (float*)(ws + WS_BBR); float* BBI = (float*)(ws + WS_BBI);
            LAS double* fb = (LAS double*)lds;
            if (tid < 128) { const int idx = sj * 128 + tid, g = idx >> 6;
                const double dt = exp((double)p.log_dt[g]), are = (double)p.a_re[idx], aim = (double)p.a_im[idx];
                const double mag = exp(are * dt); double sn, cs; sincos_d(aim * dt, sn, cs);
                const double lbr = mag * cs, lbi = mag * sn, den = are * are + aim * aim, nre = lbr - 1.0;
                LB[idx * 2] = (float)lbr; LB[idx * 2 + 1] = (float)lbi;
                fb[tid * 2] = (nre * are + lbi * aim) / den; fb[tid * 2 + 1] = (lbi * are - nre * aim) / den; }
            __syncthreads();
#pragma unroll
            for (int it = 0; it < 4; ++it) { const int e = tid + it * 512, il = e >> 4, o = sj * 128 * SG + e;
                const double fre = fb[il * 2], fim = fb[il * 2 + 1], br = (double)p.b_re[o], bi = (double)p.b_im[o];
                BBR[o] = (float)(fre * br - fim * bi); BBI[o] = (float)(fre * bi + fim * br); }
            __syncthreads();
        }
    }
    __syncthreads();
    { float* ROPE = (float*)(ws + WS_ROPE);
      for (int idx = blockIdx.x * 512 + tid; idx < SEQ * 8; idx += gridDim.x * 512) { const int pos = idx >> 3, i = idx & 7;
          const double inv = exp(-(double)i * 1.640295422175541); double sd, cd; sincos_d((double)pos * inv, sd, cd);
          ROPE[pos * 16 + i] = (float)cd; ROPE[pos * 16 + 8 + i] = (float)sd; } }
    LAS float* scr = (LAS float*)(lds + wave * 8448);
    constexpr int I0 = 16 * 57, I1 = 8 * 16, I6 = 16 * 4;
    constexpr int NT = I0 + I1 + 4 * I6;
    const int it0 = (int)blockIdx.x * 8 + wave, step = (int)gridDim.x * 8, lim = NT;
    for (int it = it0; it < lim; it += step) {
        int r = it;
        if (r < I0) { transpose_item(p.w_in, INC, INC, (bf16*)(ws + WS_WIN_T), 1024, r / 57, r % 57, 0, 0, scr, lane); continue; } r -= I0;
        if (r < I1) { transpose_item(p.w_glu, 512, 512, (bf16*)(ws + WS_WGLU_T), 512, r / 16, r % 16, 0, 0, scr, lane); continue; } r -= I1;
        { const int m = r / I6, rr = r % I6, kv = m >> 1, half = m & 1; const float* w1 = kv ? p.w1_v : p.w1_k;
          transpose_item(w1 + (size_t)half * 1024 * 128, 128, 128, (bf16*)(ws + WS_WC1_T) + (size_t)kv * 256 * 1024, 1024, rr / 4, rr % 4, 0, half * 128, scr, lane); }
    }
}
__device__ __forceinline__ void ph_late_transposes(const P& p, LAS unsigned char* lds, int wg_lo, int wg_hi) {
    const int tid = tid_now(), lane = tid & 63, wave = tid >> 6;
    if ((int)blockIdx.x < wg_lo || (int)blockIdx.x >= wg_hi) return;
    unsigned char* ws = p.ws;
    LAS float* scr = (LAS float*)(lds + wave * 8448);
    constexpr int I2 = 16 * 32, I3 = 16 * 88, I5 = 44 * 32;
    constexpr int NT = I2 + 2 * I3 + I5;
    for (int it = ((int)blockIdx.x - wg_lo) * 8 + wave; it < NT; it += (wg_hi - wg_lo) * 8) {
        int r = it;
        if (r < I2) { transpose_item(p.w_out, 1024, 1024, (bf16*)(ws + WS_WOUT_T), 1024, r / 32, r % 32, 0, 0, scr, lane); continue; } r -= I2;
        if (r < I3) { transpose_item(p.w_gate, DFF, DFF, (bf16*)(ws + WS_WUP_T), 1024, r / 88, r % 88, 1, 0, scr, lane); continue; } r -= I3;
        if (r < I3) { transpose_item(p.w_up, DFF, DFF, (bf16*)(ws + WS_WUP_T), 1024, r / 88, r % 88, 1, 128, scr, lane); continue; } r -= I3;
        transpose_item(p.w_down, 1024, 1024, (bf16*)(ws + WS_WDN_T), DFF, r / 32, r % 32, 0, 0, scr, lane);
    }
}

template <int WHICH>
__device__ __forceinline__ void ph_normmod(const P& p) {
    const int tid = tid_now(), lane = tid & 63, wave = tid >> 6, gw = blockIdx.x * 8 + wave, NGW = gridDim.x * 8;
    const float* ADA = (const float*)(p.ws + WS_ADA); const float* gain = WHICH ? p.norm_ffn_g : p.norm_mix_g;
    bf16* H = (bf16*)(p.ws + (WHICH ? WS_H2 : WS_H));
    int cur = -1; f32x4 mul[4], add[4];
#pragma unroll
    for (int j = 0; j < 4; ++j) { mul[j] = (f32x4){0.f, 0.f, 0.f, 0.f}; add[j] = mul[j]; }
    for (int r0 = gw; r0 < MR; r0 += 4 * NGW) {
        f32x4 v[4][4];
#pragma unroll
        for (int i = 0; i < 4; ++i) { const int r = r0 + i * NGW < MR ? r0 + i * NGW : r0;
            const float* src = WHICH ? (const float*)(p.ws + WS_X1) + (size_t)r * D : xrow_ptr(p, r);
#pragma unroll
            for (int j = 0; j < 4; ++j) { if (WHICH == 0) v[i][j] = __builtin_nontemporal_load((const f32x4*)(src + 4 * (lane + 64 * j))); else v[i][j] = *(const f32x4*)(src + 4 * (lane + 64 * j)); } }
#pragma unroll
        for (int i = 0; i < 4; ++i) { const int r = r0 + i * NGW; if (r >= MR) break;
            const int arow = ada_row(r);
            if (arow != cur) { cur = arow; const float* ar = ADA + (size_t)arow * 6144; const float* sh = ar + (WHICH ? 3 : 0) * D; const float* sc = ar + (WHICH ? 4 : 1) * D;
#pragma unroll
                for (int j = 0; j < 4; ++j) { const int c = 4 * (lane + 64 * j); const f32x4 g = *(const f32x4*)(gain + c), s1 = *(const f32x4*)(sc + c); mul[j] = g * (s1 + 1.0f); add[j] = *(const f32x4*)(sh + c); } }
            float ss = 0.f;
#pragma unroll
            for (int j = 0; j < 4; ++j) ss += (v[i][j].x * v[i][j].x + v[i][j].y * v[i][j].y) + (v[i][j].z * v[i][j].z + v[i][j].w * v[i][j].w);
            const float rstd = 1.0f / sqrtf(wave_sum(ss) * (1.0f / D) + EPS);
#pragma unroll
            for (int j = 0; j < 4; ++j) { const int c = 4 * (lane + 64 * j);
                const f32x4 y = (v[i][j] * rstd) * mul[j] + add[j];
                u32x2 o; o.x = pk2(y.x, y.y); o.y = pk2(y.z, y.w);
                *(u32x2*)(H + (size_t)r * D + c) = o; } }
    }
}

__device__ __forceinline__ void ph_split(const P& p, LAS unsigned char* lds) {
    const int tid = tid_now(), lane = tid & 63, wave = tid >> 6, gw = blockIdx.x * 8 + wave, NGW = gridDim.x * 8;
    LAS float* zrow = (LAS float*)(lds + wave * 7424);
    const float* Z = (const float*)(p.ws + WS_Z); float* Q = (float*)(p.ws + WS_Q); float* KV3 = (float*)(p.ws + WS_KV3);
    float* GATES = (float*)(p.ws + WS_GATES); float* U = (float*)(p.ws + WS_U);
    bf16* QB = (bf16*)(p.ws + WS_QB); bf16* KB = (bf16*)(p.ws + WS_KB); bf16* VB = (bf16*)(p.ws + WS_VB);
    const float qg = p.q_g[lane];
    for (int r = MP + gw; r < MR; r += NGW) {
        const float* zr = Z + (size_t)r * INP;
        for (int i = lane; i < INC / 4; i += 64) *(LAS f32x4*)(zrow + 4 * i) = *(const f32x4*)(zr + 4 * i);
        const int pos = r < MP ? (r % SEQ) : PAST + ((r - MP) % DSQ);
        float cs, sn;
        { const double inv = exp(-(double)(lane & 7) * 1.640295422175541); double sd, cd; sincos_d((double)pos * inv, sd, cd); cs = (float)cd; sn = (float)sd; }
        float *oc, *os, *ow;
        if (r < MP) { const int b = r / SEQ, t = r % SEQ; oc = p.out + O_KVC_P + (size_t)r * 256; os = p.out + O_KVS_P + (size_t)r * 256;
            ow = t >= SEQ - 512 ? p.out + O_KVW_P + (size_t)(b * 512 + t - (SEQ - 512)) * 256 : nullptr; }
        else { const int s = r - MP; oc = p.out + O_KVC_S + (size_t)s * 256; os = p.out + O_KVS_S + (size_t)s * 256; ow = p.out + O_KVW_S + (size_t)s * 256; }
        asm volatile("s_waitcnt lgkmcnt(0)" ::: "memory");
        for (int hh = 0; hh < 14; ++hh) {
            int off; float gain;
            if (hh < 8) { off = hh * 64; gain = qg; }
            else { const int kk = hh - 8, br = kk >> 1, g = kk & 1; off = O1 + br * 256 + g * 64; gain = p.k_g[br * 64 + lane]; }
            const float v = zrow[off + lane];
            const float ss = wave_sum(v * v);
            float y = v * (1.0f / sqrtf(ss * (1.0f / 64.0f) + EPS)) * gain;
            const float pr = __shfl_xor(y, 8);
            if (lane < 8) y = y * cs - pr * sn; else if (lane < 16) y = pr * sn + y * cs;
            if (hh < 8) { if (r >= MP) Q[(size_t)r * AW + hh * 64 + lane] = y;
                if (r < MP) QB[((size_t)((r / SEQ) * 2 + (hh >> 2)) * SEQ + (r % SEQ)) * 256 + (hh & 3) * 64 + lane] = (bf16)f2bf(y * (0.125f * 1.4426950408889634f)); }
            else { const int kk = hh - 8, br = kk >> 1, g = kk & 1;
                if (r >= MP) KV3[((size_t)br * MR + r) * 256 + g * 64 + lane] = y;
                if (r < MP && br > 0) KB[((size_t)(((br - 1) * NBP + r / SEQ) * 2 + g) * SEQ + (r % SEQ)) * 64 + lane] = (bf16)f2bf(y);
                float* o = br == 0 ? oc : br == 1 ? os : ow; if (o) o[g * 64 + lane] = y; }
        }
#pragma unroll
        for (int br = 0; br < 3; ++br)
#pragma unroll
            for (int g = 0; g < 2; ++g) { const float v = zrow[O1 + br * 256 + 128 + g * 64 + lane];
                if (r >= MP) KV3[((size_t)br * MR + r) * 256 + 128 + g * 64 + lane] = v;
                if (r < MP && br > 0) VB[((size_t)(((br - 1) * NBP + r / SEQ) * 2 + g) * SEQ + (r % SEQ)) * 64 + lane] = (bf16)f2bf(v);
                float* o = br == 0 ? oc : br == 1 ? os : ow; if (o) o[128 + g * 64 + lane] = v; }
        if (lane < 24) GATES[(size_t)r * 24 + lane] = sigmoid_f(zrow[O2 + lane]);
        for (int i = lane; i < SW / 4; i += 64) *(f32x4*)(U + (size_t)r * SW + 4 * i) = *(const LAS f32x4*)(zrow + O3 + 4 * i);
        asm volatile("s_waitcnt lgkmcnt(0)" ::: "memory");
    }
}

template <int PART> __device__ __forceinline__ void ph_cmp_build(const P& p) {
    const int tid = tid_now(), lane = tid & 63, wave = tid >> 6, gw = blockIdx.x * 8 + wave, NGW = gridDim.x * 8;
    bf16* A = (bf16*)(p.ws + WS_ACMP); const float* KVC = (const float*)(p.ws + WS_KV3);
    const int seg = lane >> 4, kvi = seg >> 1, g = seg & 1, d4 = (lane & 15) * 4;
    constexpr int NIS = DB * PAST / 64, NIP = MP / 64, NI = NIS + NIP;
    for (int it = (PART ? NIS : 0) + gw; it < (PART ? NI : NIS); it += NGW) {
        const float* src; size_t arow0;
        if (it < NIS) { const int b = it / (PAST / 64), h64 = it % (PAST / 64), t0 = h64 * 64; const int page = p.pt[b * NPG + t0 / PAGE];
            src = p.cache_c + ((size_t)page * PAGE + (t0 % PAGE)) * 256; arow0 = (size_t)(b * 1024 + t0 / 16) * 2; }
        else { const int r0 = (it - NIS) * 64, b = r0 / SEQ, t0 = r0 % SEQ; src = KVC + (size_t)r0 * 256; arow0 = (size_t)CMP_ROWS_S + (size_t)(b * 512 + t0 / 16) * 2; }
#pragma unroll 1
        for (int c = 0; c < 4; ++c) {
            f32x4 v[16];
#pragma unroll
            for (int tok = 0; tok < 16; ++tok) v[tok] = *(const f32x4*)(src + (size_t)(c * 16 + tok) * 256 + 4 * lane);
            bf16* dst = A + ((size_t)kvi * CMP_ROWS + arow0 + 2 * c + g) * 1024 + d4;
#pragma unroll
            for (int tok = 0; tok < 16; ++tok) { u32x2 o; o.x = pk2(v[tok].x, v[tok].y); o.y = pk2(v[tok].z, v[tok].w); *(u32x2*)(dst + tok * 64) = o; }
        }
    }
}

__device__ __forceinline__ void ph_cmp_out(const P& p, LAS unsigned char* lds) {
    const int tid = tid_now(), lane = tid & 63, wave = tid >> 6, gw = blockIdx.x * 8 + wave, NGW = gridDim.x * 8;
    LAS float* w2s = (LAS float*)lds;
    for (int i = tid; i < 2 * 128 * 64; i += 512) w2s[i] = i < 8192 ? p.w2_k[i] : p.w2_v[i - 8192];
    __syncthreads();
    const float* PC = (const float*)(p.ws + WS_PC); const float* PEB = (const float*)(p.ws + WS_PEB); float* CK = (float*)(p.ws + WS_CMPKV);
    bf16* KCB = (bf16*)(p.ws + WS_KCB);
    constexpr int NOS = DB * NC_S * 2, NOP = NBP * NC_P * 2, NO = NOS + NOP;
    auto srcrow = [&](int it, int& kv, int& o, size_t& dst) -> const float* {
        kv = it / NO; o = it % NO; size_t ra;
        if (o < NOS) { const int b = o / (NC_S * 2), rem = o % (NC_S * 2), i = rem >> 1, g = rem & 1; ra = (size_t)(b * 1024 + i) * 2 + g; dst = (size_t)o * 64; }
        else { const int o2 = o - NOS, b = o2 / (NC_P * 2), rem = o2 % (NC_P * 2), i = rem >> 1, g = rem & 1; ra = (size_t)CMP_ROWS_S + (size_t)(b * 512 + i) * 2 + g; dst = (size_t)CMPO_S + (size_t)o2 * 64; }
        return PC + ((size_t)kv * CMP_ROWS + ra) * 256; };
    float x0 = 0.f, x1 = 0.f, x2 = 0.f, x3 = 0.f;
    if (gw < 2 * NO) { int kv, o; size_t dst; const float* pa = srcrow(gw, kv, o, dst); x0 = pa[lane]; x1 = pa[512 + 128 + lane]; x2 = pa[64 + lane]; x3 = pa[512 + 192 + lane]; }
    for (int it = gw; it < 2 * NO; it += NGW) {
        int kv, o; size_t dst; (void)srcrow(it, kv, o, dst);
        const float h0 = gelu_tanh(x0 + x1 + PEB[kv * 128 + lane]);
        const float h1 = gelu_tanh(x2 + x3 + PEB[kv * 128 + 64 + lane]);
        if (it + NGW < 2 * NO) { int kv2, o2; size_t d2; const float* pa = srcrow(it + NGW, kv2, o2, d2); x0 = pa[lane]; x1 = pa[512 + 128 + lane]; x2 = pa[64 + lane]; x3 = pa[512 + 192 + lane]; }
        const LAS float* w2 = w2s + kv * 8192;
        float acc0 = 0.f, acc1 = 0.f;
#pragma unroll 8
        for (int n = 0; n < 64; ++n) { acc0 += rdlane(h0, n) * w2[n * 64 + lane]; acc1 += rdlane(h1, n) * w2[(64 + n) * 64 + lane]; }
        const float acc = acc0 + acc1;
        CK[(size_t)kv * CMPO + dst + lane] = acc;
        if (o >= NOS) { const int o2 = o - NOS, b = o2 / (NC_P * 2), rem = o2 % (NC_P * 2), i = rem >> 1, g = rem & 1;
            KCB[((size_t)((kv * NBP + b) * 2 + g) * 512 + i) * 64 + lane] = (bf16)f2bf(acc);
            if (i == 0) KCB[((size_t)((kv * NBP + b) * 2 + g) * 512 + 511) * 64 + lane] = (bf16)0; }
    }
}
#define XB_TMO      128
#define XB_XCNT(j)  (256  + 64 * (j))
#define XB_XSUB(j)  (1280 + 64 * (j))
#define XB_XGEN(j)  (2304 + 64 * (j))
#define XB_TOP      3328
#define XB_TOPGEN   3392
#define XCD_BAR_WORDS 3456
#define XB_SPIN_CAP (1u << 21)
__device__ __forceinline__ unsigned xb_ld(unsigned* p)              { return __hip_atomic_load(p, __ATOMIC_RELAXED, __HIP_MEMORY_SCOPE_AGENT); }
__device__ __forceinline__ unsigned xb_add(unsigned* p, unsigned v) { return __hip_atomic_fetch_add(p, v, __ATOMIC_RELAXED, __HIP_MEMORY_SCOPE_AGENT); }
__device__ __forceinline__ unsigned xb_xcc_id() { return (unsigned)__builtin_amdgcn_s_getreg((3 << 11) | 20) & 0xFu; }
#define XB_SPIN(cond, bar) do { unsigned _sp = 0; while (cond) { __builtin_amdgcn_s_sleep(1); \
    if ((++_sp & 255u) == 0u) { if (xb_ld(&(bar)[XB_TMO])) break; if (_sp > XB_SPIN_CAP) { atomicAdd(&(bar)[XB_TMO], 1u); break; } } } } while (0)

struct XcdBarrier {
    unsigned* bar; unsigned x;
    volatile LAS unsigned* st;
};

__device__ __forceinline__ XcdBarrier xcd_barrier_post(unsigned* bar, volatile LAS unsigned* st) {
    XcdBarrier b; b.bar = bar; b.x = xb_xcc_id(); b.st = st;
    if (threadIdx.x == 0) (void)xb_add(&bar[XB_XCNT(b.x)], 1u);
    return b;
}
__device__ __forceinline__ void xcd_barrier_complete(unsigned* bar, unsigned x, unsigned& nloc, unsigned& nx) {
    const unsigned G = gridDim.x * gridDim.y * gridDim.z;
    unsigned sum, cnt, mine, sp = 0u;
    for (;;) {
        sum = 0u; cnt = 0u; mine = 0u;
#pragma unroll
        for (unsigned j = 0; j < 16; ++j) { const unsigned c = xb_ld(&bar[XB_XCNT(j)]); sum += c; cnt += (c > 0u) ? 1u : 0u; mine = (j == x) ? c : mine; }
        if (sum == G) break;
        __builtin_amdgcn_s_sleep(1);
        if ((++sp & 255u) == 0u) { if (xb_ld(&bar[XB_TMO])) break; if (sp > XB_SPIN_CAP) { atomicAdd(&bar[XB_TMO], 1u); break; } }
    }
    nloc = mine > 0u ? mine : 1u; nx = cnt > 0u ? cnt : 1u;
}

__device__ __forceinline__ void xcd_barrier(const XcdBarrier& b) {
    asm volatile("s_waitcnt vmcnt(0)" ::: "memory");
    __syncthreads();
    if (threadIdx.x == 0) {
        unsigned* bar = b.bar;
        __builtin_amdgcn_s_waitcnt(0);
        unsigned nloc = b.st[0], nx = b.st[1];
        if (nloc == 0u) { xcd_barrier_complete(bar, b.x, nloc, nx); b.st[0] = nloc; b.st[1] = nx; }
        const unsigned old = xb_add(&bar[XB_XSUB(b.x)], 1u);
        const unsigned gen = old / nloc;
        if (old + 1u == (gen + 1u) * nloc) {
            __builtin_amdgcn_fence(__ATOMIC_RELEASE, "agent");
            asm volatile("s_waitcnt vmcnt(0)" ::: "memory");
            const unsigned og = xb_add(&bar[XB_TOP], 1u);
            const unsigned tg = og / nx;
            if (og + 1u == (tg + 1u) * nx) xb_add(&bar[XB_TOPGEN], 1u);
            else XB_SPIN(xb_ld(&bar[XB_TOPGEN]) == tg, bar);
            __builtin_amdgcn_fence(__ATOMIC_ACQUIRE, "agent");
            xb_add(&bar[XB_XGEN(b.x)], 1u);
            asm volatile("s_waitcnt vmcnt(0)" ::: "memory");
        } else {
            XB_SPIN(xb_ld(&bar[XB_XGEN(b.x)]) == gen, bar);
            __builtin_amdgcn_fence(__ATOMIC_ACQUIRE, "agent");
            asm volatile("s_waitcnt vmcnt(0)" ::: "memory");
        }
    }
    __syncthreads();
}

typedef short bf16x8 __attribute__((ext_vector_type(8)));
#define MFMA16(a, b, c) __builtin_amdgcn_mfma_f32_16x16x32_bf16(a, b, c, 0, 0, 0)
__device__ __forceinline__ unsigned cvtpk_bf16(float lo, float hi) { unsigned r; asm("v_cvt_pk_bf16_f32 %0, %1, %2" : "=v"(r) : "v"(lo), "v"(hi)); return r; }
__device__ __forceinline__ void split8(const f32x4& x0, const f32x4& x1, bf16x8& hi, bf16x8& lo) {
    u32x4 h, l;
    h.x = cvtpk_bf16(x0.x, x0.y); h.y = cvtpk_bf16(x0.z, x0.w); h.z = cvtpk_bf16(x1.x, x1.y); h.w = cvtpk_bf16(x1.z, x1.w);
    l.x = cvtpk_bf16(x0.x - __uint_as_float(h.x << 16), x0.y - __uint_as_float(h.x & 0xffff0000u)); l.y = cvtpk_bf16(x0.z - __uint_as_float(h.y << 16), x0.w - __uint_as_float(h.y & 0xffff0000u));
    l.z = cvtpk_bf16(x1.x - __uint_as_float(h.z << 16), x1.y - __uint_as_float(h.z & 0xffff0000u)); l.w = cvtpk_bf16(x1.z - __uint_as_float(h.w << 16), x1.w - __uint_as_float(h.w & 0xffff0000u));
    hi = __builtin_bit_cast(bf16x8, h); lo = __builtin_bit_cast(bf16x8, l);
}
template <int PASS>
__device__ __forceinline__ void ph_ssm(const P& p, LAS unsigned char* lds, int wg_lo, int wg_hi, int vlo, int vhi, int vsplit, int vshift) {
    const int tid = tid_now(), lane = tid & 63, wave = tid >> 6, gw = ((int)blockIdx.x - wg_lo) * 8 + wave, NGW = (wg_hi - wg_lo) * 8;
    const float* LB = (const float*)(p.ws + WS_LB); const float* BBR = (const float*)(p.ws + WS_BBR); const float* BBI = (const float*)(p.ws + WS_BBI);
    const float* U = (const float*)(p.ws + WS_U); float* E = (float*)(p.ws + WS_E);
    float* SF = (float*)(p.ws + WS_SF); bf16* SB = (bf16*)(p.ws + WS_SB);
    LAS float* bu = (LAS float*)(lds + wave * 17920);
    LAS float* hb = bu + 16 * 132;
    LAS float* ubuf = hb + 16 * 132;
    constexpr int NIT_P = NBP * NSG * NCH, NIT = PASS == 1 ? NIT_P : NIT_P + DB * NSG;
    const int l15 = lane & 15, lq = lane >> 4, ih = 8 * (lq & 1);
    for (int vit = vlo + gw; vit < vhi; vit += NGW) {
        const int it = vit >= vsplit ? vit + vshift : vit;
        if (it >= NIT) break;
        int b, g, c, r0, ntok; const bool prompt = it < NIT_P;
        if (prompt) { c = it % NCH; g = (it / NCH) % NSG; b = it / (NCH * NSG); r0 = b * SEQ + c * SCH; ntok = SCH; }
        else { const int i2 = it - NIT_P; c = 0; g = i2 % NSG; b = i2 / NSG; r0 = MP + b * DSQ; ntok = DSQ; }
        const int sp = g * SST + lane;
        bf16x8 b1[8], b2[8];
#pragma unroll
        for (int ct = 0; ct < 8; ++ct) { const int n = 16 * ct + l15; const float* src = (ct < 4 ? BBR : BBI) + (size_t)(g * SST + (n & 63)) * SG + ih;
            bf16x8 lo; split8(*(const f32x4*)src, *(const f32x4*)(src + 4), b1[ct], lo); b2[ct] = lane < 32 ? lo : (bf16x8){0, 0, 0, 0, 0, 0, 0, 0}; }
        const float lbr = LB[sp * 2], lbi = LB[sp * 2 + 1];
        float hr = 0.f, hi = 0.f;
        if (PASS == 2) {
            if (prompt) {
                float tr = lbr, ti = lbi;
#pragma unroll
                for (int q = 0; q < 7; ++q) { const float nr = tr * tr - ti * ti, ni = 2.0f * tr * ti; tr = nr; ti = ni; }
                const float* e = E + ((size_t)((b * NSG + g) * NCH) * 64 + lane) * 2;
                for (int c0 = 0; c0 < c; c0 += 16) { float er[16], ei[16];
#pragma unroll
                    for (int u = 0; u < 16; ++u) { const int cc = c0 + u < c ? c0 + u : c - 1; er[u] = e[(size_t)cc * 128]; ei[u] = e[(size_t)cc * 128 + 1]; }
#pragma unroll
                    for (int u = 0; u < 16; ++u) if (c0 + u < c) { const float nr = tr * hr - ti * hi + er[u], ni = tr * hi + ti * hr + ei[u]; hr = nr; hi = ni; } }
            } else { hr = p.st_re[(b * NSG + g) * SST + lane]; hi = p.st_im[(b * NSG + g) * SST + lane]; }
        }
        bf16x8 ch[4], cl[4];
        f32x4 dv = (f32x4){0.f, 0.f, 0.f, 0.f};
        if (PASS == 2) {
#pragma unroll
            for (int ks = 0; ks < 4; ++ks) { const float* src = (ks < 2 ? p.c_re : p.c_im) + (size_t)(g * SG + l15) * SST + (32 * ks + 8 * lq) % 64;
                f32x4 x0 = *(const f32x4*)src, x1 = *(const f32x4*)(src + 4);
                if (ks >= 2) { x0 = -x0; x1 = -x1; }
                split8(x0, x1, ch[ks], cl[ks]); }
            dv[0] = p.ssm_d[g * SG + l15];
        }
        const int nsb = (ntok + 15) >> 4;
        for (int sb = 0; sb < nsb; ++sb) {
            const int nt = ntok - sb * 16 < 16 ? ntok - sb * 16 : 16;
            bf16x8 ua;
            { const int tl = l15 < nt ? l15 : 0; const float* up = U + (size_t)(r0 + sb * 16 + tl) * SW + g * SG + ih;
              const f32x4 x0 = *(const f32x4*)up, x1 = *(const f32x4*)(up + 4);
              bf16x8 uh, ul; split8(x0, x1, uh, ul); ua = lane < 32 ? uh : ul;
              if (PASS == 2 && lane < 32) { *(LAS f32x4*)(ubuf + l15 * 16 + ih) = x0; *(LAS f32x4*)(ubuf + l15 * 16 + ih + 4) = x1; } }
#pragma unroll
            for (int ct = 0; ct < 8; ++ct) { f32x4 d = (f32x4){0.f, 0.f, 0.f, 0.f}; d = MFMA16(ua, b1[ct], d); d = MFMA16(ua, b2[ct], d);
#pragma unroll
                for (int rg = 0; rg < 4; ++rg) bu[(4 * lq + rg) * 132 + 16 * ct + l15] = d[rg]; }
            asm volatile("s_waitcnt lgkmcnt(0)" ::: "memory");
            if (nt == 16) {
                float br[16], bi[16];
#pragma unroll
                for (int tt = 0; tt < 16; ++tt) { br[tt] = bu[tt * 132 + lane]; bi[tt] = bu[tt * 132 + 64 + lane]; }
#pragma unroll
                for (int tt = 0; tt < 16; ++tt) {
                    const float nr = lbr * hr - lbi * hi + br[tt], ni = lbr * hi + lbi * hr + bi[tt];
                    hr = nr; hi = ni;
                    if (PASS == 2) { hb[tt * 132 + lane] = hr; hb[tt * 132 + 64 + lane] = hi; }
                }
            } else
            for (int tt = 0; tt < nt; ++tt) {
                const float br = bu[tt * 132 + lane], bi = bu[tt * 132 + 64 + lane];
                const float nr = lbr * hr - lbi * hi + br, ni = lbr * hi + lbi * hr + bi;
                hr = nr; hi = ni;
                if (PASS == 2) { hb[tt * 132 + lane] = hr; hb[tt * 132 + 64 + lane] = hi; }
            }
            if (PASS == 2) {
                asm volatile("s_waitcnt lgkmcnt(0)" ::: "memory");
                f32x4 y = (f32x4){0.f, 0.f, 0.f, 0.f};
#pragma unroll
                for (int ks = 0; ks < 4; ++ks) { const LAS float* hp = hb + l15 * 132 + 32 * ks + 8 * lq;
                    const f32x4 h0 = *(const LAS f32x4*)hp, h1 = *(const LAS f32x4*)(hp + 4); bf16x8 ah, al; split8(h0, h1, ah, al);
                    y = MFMA16(ah, ch[ks], y); y = MFMA16(al, ch[ks], y); y = MFMA16(ah, cl[ks], y); }
#pragma unroll
                for (int rg = 0; rg < 4; ++rg) { const int tt = 4 * lq + rg;
                    if (tt < nt) { const int r = r0 + sb * 16 + tt; const float uv = ubuf[tt * 16 + l15];
                        const float s = gelu_tanh(y[rg] + dv[0] * uv);
                        SF[(size_t)r * SW + g * SG + l15] = s; SB[(size_t)r * SW + g * SG + l15] = (bf16)f2bf(s); } }
                asm volatile("s_waitcnt lgkmcnt(0)" ::: "memory");
            }
        }
        if (PASS == 1) { float* e = E + ((size_t)((b * NSG + g) * NCH + c) * 64 + lane) * 2; e[0] = hr; e[1] = hi; }
        else if (prompt) { if (c == NCH - 1) { p.out[O_SRE_P + (b * NSG + g) * SST + lane] = hr; p.out[O_SIM_P + (b * NSG + g) * SST + lane] = hi; } }
        else { p.out[O_SRE_S + (b * NSG + g) * SST + lane] = hr; p.out[O_SIM_S + (b * NSG + g) * SST + lane] = hi; }
    }
}

constexpr float NEGM = -1e30f;
constexpr int SA_TILE = 0;
constexpr int SA_MO = 8 * 16640;
constexpr int SA_ML = SA_MO + 8192;
constexpr int SA_PS = SA_ML + 256;
constexpr int SA_IMP = SA_PS + 1088 * 4;
constexpr int SA_SEL = SA_IMP + 320 * 4;
__device__ __forceinline__ void att_stage(const float* kp, int stride, int klo, int khi, LAS float* tile, int lane) {
#pragma unroll 1
    for (int u0 = 0; u0 < 64; u0 += 32) { float v[32];
#pragma unroll
        for (int u = 0; u < 32; ++u) v[u] = (u0 + u >= klo && u0 + u < khi) ? __builtin_nontemporal_load(kp + (ptrdiff_t)(u0 + u) * stride + lane) : 0.f;
#pragma unroll
        for (int u = 0; u < 32; ++u) tile[(u0 + u) * 65 + lane] = v[u]; }
}
__device__ __forceinline__ void att_qk(LAS float* tile, int lane, const float (&q)[4], float (&s)[4]) {
    asm volatile("s_waitcnt vmcnt(0) lgkmcnt(0)" ::: "memory");
    s[0] = 0.f; s[1] = 0.f; s[2] = 0.f; s[3] = 0.f;
#pragma unroll 8
    for (int d = 0; d < 64; ++d) { const float kv = tile[lane * 65 + d];
        s[0] += kv * rdlane(q[0], d); s[1] += kv * rdlane(q[1], d); s[2] += kv * rdlane(q[2], d); s[3] += kv * rdlane(q[3], d); }
    asm volatile("s_waitcnt lgkmcnt(0)" ::: "memory");
}
__device__ __forceinline__ void att_scores(const float* kp, int stride, int klo, int khi, LAS float* tile, int lane, const float (&q)[4], float (&s)[4]) {
    att_stage(kp, stride, klo, khi, tile, lane);
    att_qk(tile, lane, q, s);
}
__device__ __forceinline__ void att_tile(const float* kp, const float* vp, int stride, int klo, int khi, bool valid, LAS float* tile, int lane,
                                         const float (&q)[4], float (&m)[4], float (&l)[4], float (&o)[4]) {
    float s[4], pr[4];
    att_stage(kp, stride, klo, khi, tile, lane);
    float vr[64];
#pragma unroll
    for (int u = 0; u < 64; ++u) vr[u] = (u >= klo && u < khi) ? __builtin_nontemporal_load(vp + (ptrdiff_t)u * stride + lane) : 0.f;
    {
        asm volatile("s_waitcnt lgkmcnt(0)" ::: "memory");
        s[0] = 0.f; s[1] = 0.f; s[2] = 0.f; s[3] = 0.f;
#pragma unroll 8
        for (int d = 0; d < 64; ++d) { const float kv = tile[lane * 65 + d];
            s[0] += kv * rdlane(q[0], d); s[1] += kv * rdlane(q[1], d); s[2] += kv * rdlane(q[2], d); s[3] += kv * rdlane(q[3], d); }
    }
#pragma unroll
    for (int h = 0; h < 4; ++h) {
        const float sc = valid ? s[h] : NEGM;
        const float mn = fmaxf(m[h], wave_max(sc));
        const float pv = valid ? expf(sc - mn) : 0.f;
        const float al = expf(m[h] - mn);
        l[h] = l[h] * al + wave_sum(pv); o[h] *= al; m[h] = mn; pr[h] = pv;
    }
#pragma unroll
    for (int u = 0; u < 64; ++u) { o[0] += rdlane(pr[0], u) * vr[u]; o[1] += rdlane(pr[1], u) * vr[u]; o[2] += rdlane(pr[2], u) * vr[u]; o[3] += rdlane(pr[3], u) * vr[u]; }
}
__device__ __forceinline__ void sa_merge(LAS unsigned char* lds, int wave, int lane, const float (&m)[4], const float (&l)[4], const float (&o)[4], float gate, float& outv, float (&gm)[4], float (&gil)[4]) {
    LAS float* mo = (LAS float*)(lds + SA_MO); LAS float* ml = (LAS float*)(lds + SA_ML);
#pragma unroll
    for (int h = 0; h < 4; ++h) { mo[(wave * 4 + h) * 64 + lane] = o[h]; if (lane == 0) { ml[(wave * 4 + h) * 2] = m[h]; ml[(wave * 4 + h) * 2 + 1] = l[h]; } }
    __syncthreads();
#pragma unroll
    for (int h = 0; h < 4; ++h) { float M = NEGM;
#pragma unroll
        for (int w = 0; w < 8; ++w) M = fmaxf(M, ml[(w * 4 + h) * 2]);
        float L = 0.f;
#pragma unroll
        for (int w = 0; w < 8; ++w) L += ml[(w * 4 + h) * 2 + 1] * expf(ml[(w * 4 + h) * 2] - M);
        gm[h] = M; gil[h] = L > 0.f ? 1.0f / L : 0.f; }
    if (wave < 4) { float M = NEGM, il = 0.f;
#pragma unroll
        for (int h = 0; h < 4; ++h) if (h == wave) { M = gm[h]; il = gil[h]; }
        float acc = 0.f;
#pragma unroll
        for (int w = 0; w < 8; ++w) acc += mo[(w * 4 + wave) * 64 + lane] * expf(ml[(w * 4 + wave) * 2] - M);
        outv += gate * acc * il; }
    __syncthreads();
}

__device__ __forceinline__ void ph_attn_sample(const P& p, LAS unsigned char* lds) {
    const int tid = tid_now(), lane = tid & 63, wave = __builtin_amdgcn_readfirstlane(tid >> 6);
    LAS float* tile = (LAS float*)(lds + SA_TILE + wave * 16640);
    LAS float* psall = (LAS float*)(lds + SA_PS); LAS float* imp = (LAS float*)(lds + SA_IMP); LAS int* sel = (LAS int*)(lds + SA_SEL);
    const float* Q = (const float*)(p.ws + WS_Q); const float* KV3 = (const float*)(p.ws + WS_KV3); const float* GATES = (const float*)(p.ws + WS_GATES);
    const float* CK = (const float*)(p.ws + WS_CMPKV); float* ATTN = (float*)(p.ws + WS_ATTN);
    const float* KVS = KV3 + (size_t)MR * 256; const float* KVW = KV3 + (size_t)2 * MR * 256;
    for (int hw = blockIdx.x; hw < MS * 2; hw += gridDim.x) {
        const int cidx = (hw & 7) * 8 + ((hw >> 3) >> 2), qi = (hw >> 3) & 3, b = cidx >> 1, g = cidx & 1;
        const int r = MP + b * DSQ + qi, t = PAST + qi;
        float q[4];
#pragma unroll
        for (int h = 0; h < 4; ++h) q[h] = Q[(size_t)r * AW + (g * 4 + h) * 64 + lane] * 0.125f;
        const float* gt = GATES + (size_t)r * 24 + g * 12;
        float gc = 0.f, gs = 0.f, gw_ = 0.f;
        if (wave < 4) { gc = gt[wave * 3]; gs = gt[wave * 3 + 1]; gw_ = gt[wave * 3 + 2]; }
        float outv = 0.f, gm[4], gil[4], m[4], l[4], o[4];
        const float* kc = CK + (size_t)b * NC_S * 128 + g * 64; const float* vc = kc + CMPO;
#pragma unroll
        for (int h = 0; h < 4; ++h) { m[h] = NEGM; l[h] = 0.f; o[h] = 0.f; }
        for (int ti = wave; ti < 16; ti += 8) { const int khi = NC_S - 64 * ti < 64 ? NC_S - 64 * ti : 64;
            att_tile(kc + (size_t)ti * 64 * 128, vc + (size_t)ti * 64 * 128, 128, 0, khi, 64 * ti + lane < NC_S, tile, lane, q, m, l, o); }
        sa_merge(lds, wave, lane, m, l, o, gc, outv, gm, gil);
        for (int ti = wave; ti < 17; ti += 8) {
            float ps = 0.f;
            if (ti < 16) { const int khi = NC_S - 64 * ti < 64 ? NC_S - 64 * ti : 64; float s[4];
                att_scores(kc + (size_t)ti * 64 * 128, 128, 0, khi, tile, lane, q, s);
                if (64 * ti + lane < NC_S) {
#pragma unroll
                    for (int h = 0; h < 4; ++h) ps += expf(s[h] - gm[h]) * gil[h]; } }
            psall[ti * 64 + lane] = ps;
        }
        __syncthreads();
        const int cur = t >> 6;
        if (tid < 320) { float v = 0.f;
            if (tid < 257) { const int c4 = 4 * tid; v = psall[c4] + psall[c4 + 1] + psall[c4 + 2] + 0.5f * psall[c4 + 3] + (tid > 0 ? 0.5f * psall[c4 - 1] : 0.f); }
            imp[tid] = v; }
        __syncthreads();
        {
            unsigned key[5];
#pragma unroll
            for (int i = 0; i < 5; ++i) { const int j = lane + 64 * i; key[i] = 0u;
                if (j < 257) key[i] = j > cur ? 1u : (j == 0 || j == cur || j == cur - 1) ? 0x7F000000u : __float_as_uint(fmaxf(imp[j], 0.f)) + 2u; }
            unsigned T = 0u;
            for (int bit = 30; bit >= 0; --bit) { const unsigned tr = T | (1u << bit); int cnt = 0;
#pragma unroll
                for (int i = 0; i < 5; ++i) cnt += __popcll(__ballot(key[i] >= tr));
                if (cnt >= 16) T = tr; }
            int ngt = 0;
#pragma unroll
            for (int i = 0; i < 5; ++i) ngt += __popcll(__ballot(key[i] > T));
            const int need = 16 - ngt; const unsigned long long below = (1ull << lane) - 1ull;
            int eqbefore = 0, rank = 0;
#pragma unroll
            for (int i = 0; i < 5; ++i) { const unsigned long long eqm = __ballot(key[i] == T);
                const bool take = key[i] > T || (key[i] == T && eqbefore + __popcll(eqm & below) < need);
                const unsigned long long tm = __ballot(take);
                if (take && wave == 0) sel[rank + __popcll(tm & below)] = lane + 64 * i;
                rank += __popcll(tm); eqbefore += __popcll(eqm); }
        }
        __syncthreads();
#pragma unroll
        for (int h = 0; h < 4; ++h) { m[h] = NEGM; l[h] = 0.f; o[h] = 0.f; }
        for (int k = wave; k < 16; k += 8) {
            const int j = __builtin_amdgcn_readfirstlane(sel[k]);
            if (j < 256) { const int page = p.pt[b * NPG + (j >> 1)]; const float* kp = p.cache_s + ((size_t)page * PAGE + (j & 1) * 64) * 256 + g * 64;
                att_tile(kp, kp + 128, 256, 0, 64, true, tile, lane, q, m, l, o); }
            else { const float* kp = KVS + (size_t)(MP + b * DSQ) * 256 + g * 64;
                att_tile(kp, kp + 128, 256, 0, DSQ, lane <= qi, tile, lane, q, m, l, o); }
        }
        sa_merge(lds, wave, lane, m, l, o, gs, outv, gm, gil);
#pragma unroll
        for (int h = 0; h < 4; ++h) { m[h] = NEGM; l[h] = 0.f; o[h] = 0.f; }
        { const float* kp = p.cache_w + ((size_t)(b * 512 + 64 * wave)) * 256 + g * 64;
          att_tile(kp, kp + 128, 256, 0, 64, 64 * wave + lane >= qi, tile, lane, q, m, l, o); }
        if (wave == 0) { const float* kp = KVW + (size_t)(MP + b * DSQ) * 256 + g * 64;
            att_tile(kp, kp + 128, 256, 0, DSQ, lane <= qi, tile, lane, q, m, l, o); }
        sa_merge(lds, wave, lane, m, l, o, gw_, outv, gm, gil);
        if (wave < 4) ATTN[(size_t)r * AW + (g * 4 + wave) * 64 + lane] = outv;
    }
}

__device__ __forceinline__ void ph_mixin(const P& p) {
    const int tid = tid_now(), lane = tid & 63, wave = tid >> 6, gw = blockIdx.x * 8 + wave, NGW = gridDim.x * 8;
    const float* ATTN = (const float*)(p.ws + WS_ATTN); const float* S2 = (const float*)(p.ws + WS_S2); bf16* MIX = (bf16*)(p.ws + WS_MIX);
    f32x4 gn[2][2];
#pragma unroll
    for (int part = 0; part < 2; ++part)
#pragma unroll
        for (int j = 0; j < 2; ++j) gn[part][j] = *(const f32x4*)((part ? p.ssm_g : p.attn_g) + 4 * (lane + 64 * j));
    for (int r0 = gw; r0 < MR; r0 += 4 * NGW) {
        f32x4 v[4][2][2];
#pragma unroll
        for (int w = 0; w < 4; ++w) { const int r = r0 + w * NGW < MR ? r0 + w * NGW : r0;
#pragma unroll
            for (int part = 0; part < 2; ++part) { const float* src = (part ? S2 : ATTN) + (size_t)r * 512;
#pragma unroll
                for (int j = 0; j < 2; ++j) v[w][part][j] = *(const f32x4*)(src + 4 * (lane + 64 * j)); } }
#pragma unroll
        for (int w = 0; w < 4; ++w) { const int r = r0 + w * NGW; if (r >= MR) break;
#pragma unroll
            for (int part = 0; part < 2; ++part) { float ss = 0.f;
#pragma unroll
                for (int j = 0; j < 2; ++j) { const f32x4 x = v[w][part][j]; ss += (x.x * x.x + x.y * x.y) + (x.z * x.z + x.w * x.w); }
                const float rstd = 1.0f / sqrtf(wave_sum(ss) * (1.0f / 512.0f) + EPS);
#pragma unroll
                for (int j = 0; j < 2; ++j) { const int c = 4 * (lane + 64 * j); const f32x4 y = v[w][part][j] * rstd * gn[part][j];
                    u32x2 o; o.x = pk2(y.x, y.y); o.y = pk2(y.z, y.w); *(u32x2*)(MIX + (size_t)r * D + part * 512 + c) = o; } } }
    }
}

struct EpiCmp {
    static constexpr bool PERM = false, AFTER_DRAIN = false;
    float* C;
    __device__ __forceinline__ void operator()(const pg8::f32x4 (&acc)[2][2][4][2], const pg8::Unit& u, int wr, int wc, int fr, int fq) const {
        const int row0 = u.pm * 256 + wr * 64 + fr, col0 = wc * 32 + 4 * fq;
#pragma unroll
        for (int ai = 0; ai < 2; ++ai)
#pragma unroll
            for (int m = 0; m < 4; ++m) { float* rowp = C + (size_t)(row0 + ai * 128 + m * 16) * 256 + col0;
#pragma unroll
                for (int bj = 0; bj < 2; ++bj)
#pragma unroll
                    for (int n = 0; n < 2; ++n) *(pg8::f32x4*)(rowp + bj * 128 + n * 16) = acc[ai][bj][m][n]; }
    }
};
struct CmpOrder {
    int G, c;
    __device__ bool next(int i, pg8::Unit& u) const { const int L = i * G + c; if (L >= 2 * (CMP_ROWS / 256)) return false; u.pm = L; u.pn = L >= CMP_ROWS / 256 ? 1 : 0; return true; }
    __device__ __forceinline__ void a_ready(const pg8::Unit&) const {}
    __device__ __forceinline__ void done(const pg8::Unit&) const {}
};
struct EpiGlu {
    static constexpr bool PERM = false, AFTER_DRAIN = false;
    const float* SF; float* S2; const float* bias;
    __device__ __forceinline__ void operator()(const pg8::f32x4 (&acc)[2][2][4][2], const pg8::Unit& u, int wr, int wc, int fr, int fq) const {
        const int row0 = u.pm * 256 + wr * 64 + fr, col0 = u.pn * 256 + wc * 32 + 4 * fq;
#pragma unroll
        for (int ai = 0; ai < 2; ++ai)
#pragma unroll
            for (int m = 0; m < 4; ++m) { const size_t ro = (size_t)(row0 + ai * 128 + m * 16) * 512 + col0;
#pragma unroll
                for (int bj = 0; bj < 2; ++bj)
#pragma unroll
                    for (int n = 0; n < 2; ++n) { const int co = bj * 128 + n * 16; const pg8::f32x4 s = *(const pg8::f32x4*)(SF + ro + co); const pg8::f32x4 bv = *(const pg8::f32x4*)(bias + col0 + co);
                        const pg8::f32x4 t = acc[ai][bj][m][n] + bv; pg8::f32x4 o;
                        o[0] = s[0] * sigmoid_f(t[0]); o[1] = s[1] * sigmoid_f(t[1]); o[2] = s[2] * sigmoid_f(t[2]); o[3] = s[3] * sigmoid_f(t[3]);
                        *(pg8::f32x4*)(S2 + ro + co) = o; } }
    }
};
struct EpiOut {
    static constexpr bool PERM = false, AFTER_DRAIN = false;
    const float *xp, *xs, *ADA; float* X1;
    __device__ __forceinline__ void operator()(const pg8::f32x4 (&acc)[2][2][4][2], const pg8::Unit& u, int wr, int wc, int fr, int fq) const {
        const int row0 = u.pm * 256 + wr * 64 + fr, col0 = u.pn * 256 + wc * 32 + 4 * fq;
#pragma unroll
        for (int ai = 0; ai < 2; ++ai)
#pragma unroll
            for (int m = 0; m < 4; ++m) { const int r = row0 + ai * 128 + m * 16;
                if (r < MR) { const float* xr = (r < MP ? xp + (size_t)r * D : xs + (size_t)(r - MP) * D) + col0; const float* gr = ADA + (size_t)ada_row(r) * 6144 + 2 * D + col0;
#pragma unroll
                    for (int bj = 0; bj < 2; ++bj)
#pragma unroll
                        for (int n = 0; n < 2; ++n) { const int co = bj * 128 + n * 16;
                            *(pg8::f32x4*)(X1 + (size_t)r * D + col0 + co) = *(const pg8::f32x4*)(xr + co) + *(const pg8::f32x4*)(gr + co) * acc[ai][bj][m][n]; } } }
    }
};
struct EpiUp {
    static constexpr bool PERM = true, AFTER_DRAIN = false;
    bf16* FF;
    __device__ __forceinline__ void operator()(const pg8::f32x4 (&acc)[2][2][4][2], const pg8::Unit& u, int wr, int wc, int fr, int fq) const {
        const int row0 = u.pm * 256 + wr * 64 + fr, col0 = u.pn * 128 + wc * 32 + 8 * fq;
#pragma unroll
        for (int ai = 0; ai < 2; ++ai)
#pragma unroll
            for (int m = 0; m < 4; ++m) { bf16* rowp = FF + (size_t)(row0 + ai * 128 + m * 16) * DFF + col0;
                const pg8::f32x4 g0 = acc[ai][0][m][0], g1 = acc[ai][0][m][1], u0 = acc[ai][1][m][0], u1 = acc[ai][1][m][1];
                pg8::u32x4 w; w.x = pk2(silu_f(g0[0]) * u0[0], silu_f(g0[1]) * u0[1]); w.y = pk2(silu_f(g0[2]) * u0[2], silu_f(g0[3]) * u0[3]);
                w.z = pk2(silu_f(g1[0]) * u1[0], silu_f(g1[1]) * u1[1]); w.w = pk2(silu_f(g1[2]) * u1[2], silu_f(g1[3]) * u1[3]);
                *(pg8::u32x4*)rowp = w; }
    }
};
struct EpiDown {
    static constexpr bool PERM = false, AFTER_DRAIN = false;
    const float *X1, *ADA; float* out;
    __device__ __forceinline__ void operator()(const pg8::f32x4 (&acc)[2][2][4][2], const pg8::Unit& u, int wr, int wc, int fr, int fq) const {
        const int row0 = u.pm * 256 + wr * 64 + fr, col0 = u.pn * 256 + wc * 32 + 4 * fq;
#pragma unroll
        for (int ai = 0; ai < 2; ++ai)
#pragma unroll
            for (int m = 0; m < 4; ++m) { const int r = row0 + ai * 128 + m * 16;
                if (r < MR) { const float* xr = X1 + (size_t)r * D + col0; const float* gr = ADA + (size_t)ada_row(r) * 6144 + 5 * D + col0;
                    float* orow = (r < MP ? out + O_YP + (size_t)r * D : out + O_YS + (size_t)(r - MP) * D) + col0;
#pragma unroll
                    for (int bj = 0; bj < 2; ++bj)
#pragma unroll
                        for (int n = 0; n < 2; ++n) { const int co = bj * 128 + n * 16;
                            *(pg8::f32x4*)(orow + co) = *(const pg8::f32x4*)(xr + co) + *(const pg8::f32x4*)(gr + co) * acc[ai][bj][m][n]; } } }
    }
};


constexpr int CF_ABYTES = 258 * 128, CF_A0 = 0, CF_A1 = CF_ABYTES, CF_B0 = 2 * CF_ABYTES, CF_BBYTES = 256 * 128, CF_B1 = CF_B0 + CF_BBYTES;
constexpr int CF_HID = 0, CF_W2 = 66048;
__device__ __forceinline__ int cf_off(int row, int q) { return row * 128 + ((q ^ ((row >> 1) & 7)) << 4); }
__device__ __forceinline__ int cf_off2(int row, int q) { return row * 256 + ((q ^ ((row >> 1) & 7)) << 4); }

template <int PART>
__device__ __forceinline__ void ph_cmpf(const P& p, LAS unsigned char* lds) {
    const int tid = tid_now(), lane = tid & 63, wave = __builtin_amdgcn_readfirstlane(tid >> 6), fr = lane & 15, fq = lane >> 4, wr = wave >> 1, wc = wave & 1;
    const float* KVC = p.out + O_KVC_P; const bf16* WC1 = (const bf16*)(p.ws + WS_WC1_T); const float* PEB = (const float*)(p.ws + WS_PEB);
    float* CK = (float*)(p.ws + WS_CMPKV); bf16* KCB = (bf16*)(p.ws + WS_KCB);
    constexpr int NU = PART ? 16 : 512, NCH_B = PART ? 512 : 1024, NC = PART ? NC_P : NC_S;
    const int lh = lane >> 5, pc = lane & 31, ag = pc >> 4, ad = 4 * (pc & 15);
    for (int u = blockIdx.x; u < NU; u += (PART ? 16 : (int)gridDim.x)) {
        const int kv = PART ? (u >> 3) : (u >> 8), b = PART ? ((u >> 2) & 1) : ((u >> 3) & 31), c0 = (PART ? (u & 3) : (u & 7)) * 128;
        const float* abase0; const float* abase1; const float* esrc = nullptr; const bool ext = c0 + 128 < NCH_B;
        if (PART == 0) { const int pg0 = p.pt[b * NPG + ((c0 + 16 * wave) >> 3)], pg1 = p.pt[b * NPG + ((c0 + 16 * wave) >> 3) + 1];
            abase0 = p.cache_c + ((size_t)pg0 * PAGE + lh * 16) * 256 + kv * 128 + 4 * pc; abase1 = p.cache_c + ((size_t)pg1 * PAGE + lh * 16) * 256 + kv * 128 + 4 * pc;
            if (ext && tid < 32) { const int ce = c0 + 128; const int pg = p.pt[b * NPG + (ce >> 3)]; esrc = p.cache_c + ((size_t)pg * PAGE + (ce & 7) * 16) * 256 + kv * 128 + 4 * tid; } }
        else { abase0 = KVC + ((size_t)b * SEQ + (size_t)(c0 + 16 * wave + lh) * 16) * 256 + kv * 128 + 4 * pc; abase1 = abase0 + (size_t)8 * 16 * 256;
            if (ext && tid < 32) esrc = KVC + ((size_t)b * SEQ + (size_t)(c0 + 128) * 16) * 256 + kv * 128 + 4 * tid; }
        const bf16* wsrc = WC1 + ((size_t)kv * 256 + (tid >> 3)) * 1024 + (tid & 7) * 8;
        f32x4 av[8], ev; u32x4 wv[4];
        ev = (f32x4){0.f, 0.f, 0.f, 0.f};
#define CF_LOAD(tok) do { _Pragma("unroll") for (int j = 0; j < 8; ++j) av[j] = __builtin_nontemporal_load((const f32x4*)((j < 4 ? abase0 : abase1) + (size_t)(2 * (j & 3)) * 16 * 256 + (size_t)(tok) * 256)); \
            if (esrc) ev = *(const f32x4*)(esrc + (size_t)(tok) * 256); \
            _Pragma("unroll") for (int i = 0; i < 4; ++i) wv[i] = *(const u32x4*)(wsrc + (size_t)i * 64 * 1024 + (tok) * 64); } while (0)
#define CF_STORE(abuf, bbuf) do { \
            _Pragma("unroll") for (int j = 0; j < 8; ++j) { const int row_ = 2 * (16 * wave + 2 * j + lh) + ag; u32x2 o_; o_.x = pk2(av[j].x, av[j].y); o_.y = pk2(av[j].z, av[j].w); \
                *(LAS u32x2*)(lds + (abuf) + cf_off(row_, ad >> 3) + ((ad >> 2) & 1) * 8) = o_; } \
            if (tid < 32) { u32x2 o_; o_.x = pk2(ev.x, ev.y); o_.y = pk2(ev.z, ev.w); *(LAS u32x2*)(lds + (abuf) + cf_off(256 + (tid >> 4), (tid & 15) >> 1) + (tid & 1) * 8) = o_; } \
            _Pragma("unroll") for (int i = 0; i < 4; ++i) *(LAS u32x4*)(lds + (bbuf) + cf_off((tid >> 3) + 64 * i, tid & 7)) = wv[i]; } while (0)
        f32x4 acc[4][4];
#pragma unroll
        for (int m = 0; m < 4; ++m)
#pragma unroll
            for (int n = 0; n < 4; ++n) acc[m][n] = (f32x4){0.f, 0.f, 0.f, 0.f};
        CF_LOAD(0); CF_STORE(CF_A0, CF_B0);
        __syncthreads();
#pragma unroll 1
        for (int tok = 0; tok < 16; ++tok) {
            const int ab = (tok & 1) ? CF_A1 : CF_A0, bb = (tok & 1) ? CF_B1 : CF_B0;
            if (tok + 1 < 16) CF_LOAD(tok + 1);
#pragma unroll
            for (int half = 0; half < 2; ++half)
#pragma unroll
                for (int ks = 0; ks < 2; ++ks) {
                    bf16x8 a[4], bw[4];
#pragma unroll
                    for (int m = 0; m < 4; ++m) a[m] = *(const LAS bf16x8*)(lds + ab + cf_off(64 * wr + 16 * m + fr + 2 * half, 4 * ks + fq));
#pragma unroll
                    for (int n = 0; n < 4; ++n) bw[n] = *(const LAS bf16x8*)(lds + bb + cf_off(128 * half + 64 * wc + 16 * n + fr, 4 * ks + fq));
#pragma unroll
                    for (int m = 0; m < 4; ++m)
#pragma unroll
                        for (int n = 0; n < 4; ++n) acc[m][n] = MFMA16(bw[n], a[m], acc[m][n]);
                }
            if (tok + 1 < 16) { if (tok & 1) CF_STORE(CF_A0, CF_B0); else CF_STORE(CF_A1, CF_B1); }
            __syncthreads();
        }
#undef CF_LOAD
#undef CF_STORE
#pragma unroll
        for (int n = 0; n < 4; ++n) { const int col = 64 * wc + 16 * n + 4 * fq; const f32x4 bias = peb_load(PEB, kv, col);
#pragma unroll
            for (int m = 0; m < 4; ++m) { const int row = 64 * wr + 16 * m + fr; const f32x4 v = acc[m][n] + bias;
                u32x2 o; o.x = pk2(gelu_tanh(v.x), gelu_tanh(v.y)); o.y = pk2(gelu_tanh(v.z), gelu_tanh(v.w));
                *(LAS u32x2*)(lds + CF_HID + cf_off2(row, col >> 3) + (col & 7) * 2) = o; } }
        { const float* w2 = kv ? p.w2_v : p.w2_k; const int n = tid & 63, kb = tid >> 6; float x[16];
#pragma unroll
          for (int j = 0; j < 16; ++j) x[j] = w2[(size_t)(16 * kb + j) * 64 + n];
#pragma unroll
          for (int h2 = 0; h2 < 2; ++h2) { u32x4 o; o.x = pk2(x[8 * h2], x[8 * h2 + 1]); o.y = pk2(x[8 * h2 + 2], x[8 * h2 + 3]); o.z = pk2(x[8 * h2 + 4], x[8 * h2 + 5]); o.w = pk2(x[8 * h2 + 6], x[8 * h2 + 7]);
              *(LAS u32x4*)(lds + CF_W2 + cf_off2(n, 2 * kb + h2)) = o; } }
        __syncthreads();
        f32x4 acc2[2][4];
#pragma unroll
        for (int m = 0; m < 2; ++m)
#pragma unroll
            for (int n = 0; n < 4; ++n) acc2[m][n] = (f32x4){0.f, 0.f, 0.f, 0.f};
#pragma unroll
        for (int ks = 0; ks < 4; ++ks) { bf16x8 a[2], bw[4];
#pragma unroll
            for (int m = 0; m < 2; ++m) a[m] = *(const LAS bf16x8*)(lds + CF_HID + cf_off2(32 * wave + 16 * m + fr, 4 * ks + fq));
#pragma unroll
            for (int n = 0; n < 4; ++n) bw[n] = *(const LAS bf16x8*)(lds + CF_W2 + cf_off2(16 * n + fr, 4 * ks + fq));
#pragma unroll
            for (int m = 0; m < 2; ++m)
#pragma unroll
                for (int n = 0; n < 4; ++n) acc2[m][n] = MFMA16(bw[n], a[m], acc2[m][n]); }
#pragma unroll
        for (int m = 0; m < 2; ++m) { const int row = 32 * wave + 16 * m + fr, i = c0 + (row >> 1), g = row & 1;
            if (i < NC) {
                float* dst = CK + (size_t)kv * CMPO + (PART ? (size_t)CMPO_S : 0) + ((size_t)(b * NC + i) * 2 + g) * 64 + 4 * fq;
#pragma unroll
                for (int n = 0; n < 4; ++n) *(f32x4*)(dst + 16 * n) = acc2[m][n];
                if (PART) { bf16* kd = KCB + ((size_t)((kv * NBP + b) * 2 + g) * 512 + i) * 64 + 4 * fq;
#pragma unroll
                    for (int n = 0; n < 4; ++n) { u32x2 o; o.x = pk2(acc2[m][n].x, acc2[m][n].y); o.y = pk2(acc2[m][n].z, acc2[m][n].w); *(u32x2*)(kd + 16 * n) = o;
                        if (i == 0) *(u32x2*)(kd + (size_t)511 * 64 + 16 * n) = (u32x2){0u, 0u}; } }
            } }
        __syncthreads();
    }
}


constexpr int CS_A0 = 0, CS_ABYTES = 66 * 128, CS_A1 = CS_ABYTES, CS_B0 = 2 * CS_ABYTES, CS_B1 = CS_B0 + 32768;
constexpr int CS_HID = 0, CS_W2 = CS_B0;
__device__ __forceinline__ void ph_cmpf_small(const P& p, LAS unsigned char* lds, int u) {
    const int tid = tid_now(), lane = tid & 63, wave = __builtin_amdgcn_readfirstlane(tid >> 6), fr = lane & 15, fq = lane >> 4;
    const float* KVC = p.out + O_KVC_P; const bf16* WC1 = (const bf16*)(p.ws + WS_WC1_T); const float* PEB = (const float*)(p.ws + WS_PEB);
    float* CK = (float*)(p.ws + WS_CMPKV); bf16* KCB = (bf16*)(p.ws + WS_KCB);
    const int kv = u >> 5, b = (u >> 4) & 1, c0 = (u & 15) * 32; const bool ext = c0 + 32 < 512;
    const int pc = tid & 31, ch0 = tid >> 5, ag = pc >> 4, ad = 4 * (pc & 15);
    const float* abase = KVC + ((size_t)b * SEQ + (size_t)(c0 + ch0) * 16) * 256 + kv * 128 + 4 * pc;
    const float* esrc = (ext && tid < 32) ? KVC + ((size_t)b * SEQ + (size_t)(c0 + 32) * 16) * 256 + kv * 128 + 4 * tid : nullptr;
    const bf16* wsrc = WC1 + ((size_t)kv * 256 + (tid >> 3)) * 1024 + (tid & 7) * 8;
    f32x4 aA0, aA1, aB0, aB1, eA, eB; u32x4 wA[4], wB[4];
    eA = (f32x4){0.f, 0.f, 0.f, 0.f}; eB = eA;
#define CS_LOAD(a0, a1, EV, WV, tok) do { a0 = *(const f32x4*)(abase + (size_t)(tok) * 256); a1 = *(const f32x4*)(abase + (size_t)16 * 16 * 256 + (size_t)(tok) * 256); \
        if (esrc) EV = *(const f32x4*)(esrc + (size_t)(tok) * 256); \
        _Pragma("unroll") for (int i = 0; i < 4; ++i) WV[i] = *(const u32x4*)(wsrc + (size_t)i * 64 * 1024 + (tok) * 64); } while (0)
#define CS_STORE(a0, a1, EV, WV, abuf, bbuf) do { \
        { u32x2 o_; o_.x = pk2(a0.x, a0.y); o_.y = pk2(a0.z, a0.w); *(LAS u32x2*)(lds + (abuf) + cf_off(2 * ch0 + ag, ad >> 3) + ((ad >> 2) & 1) * 8) = o_; } \
        { u32x2 o_; o_.x = pk2(a1.x, a1.y); o_.y = pk2(a1.z, a1.w); *(LAS u32x2*)(lds + (abuf) + cf_off(2 * (ch0 + 16) + ag, ad >> 3) + ((ad >> 2) & 1) * 8) = o_; } \
        if (tid < 32) { u32x2 o_; o_.x = pk2(EV.x, EV.y); o_.y = pk2(EV.z, EV.w); *(LAS u32x2*)(lds + (abuf) + cf_off(64 + (tid >> 4), (tid & 15) >> 1) + (tid & 1) * 8) = o_; } \
        _Pragma("unroll") for (int i = 0; i < 4; ++i) *(LAS u32x4*)(lds + (bbuf) + cf_off((tid >> 3) + 64 * i, tid & 7)) = WV[i]; } while (0)
    const int sA0 = (fr >> 1) & 7, sA1 = ((fr >> 1) + 1) & 7;
    const int aoff00 = fr * 128 + ((fq ^ sA0) << 4), aoff01 = fr * 128 + (((4 + fq) ^ sA0) << 4);
    const int aoff10 = (fr + 2) * 128 + ((fq ^ sA1) << 4), aoff11 = (fr + 2) * 128 + (((4 + fq) ^ sA1) << 4);
    const int woff0 = (16 * wave + fr) * 128 + ((fq ^ sA0) << 4), woff1 = (16 * wave + fr) * 128 + (((4 + fq) ^ sA0) << 4);
    f32x4 acc[4];
#pragma unroll
    for (int m = 0; m < 4; ++m) acc[m] = (f32x4){0.f, 0.f, 0.f, 0.f};
#define CS_STEP(ab, bb, AO, WO, HALF) do { const bf16x8 bw = *(const LAS bf16x8*)(lds + (bb) + (WO) + (HALF) * 16384); \
        _Pragma("unroll") for (int m = 0; m < 4; ++m) { const bf16x8 a = *(const LAS bf16x8*)(lds + (ab) + (AO) + m * 2048); acc[m] = MFMA16(bw, a, acc[m]); } } while (0)
#define CS_COMPUTE(ab, bb) do { CS_STEP(ab, bb, aoff00, woff0, 0); CS_STEP(ab, bb, aoff01, woff1, 0); CS_STEP(ab, bb, aoff10, woff0, 1); CS_STEP(ab, bb, aoff11, woff1, 1); } while (0)
    CS_LOAD(aA0, aA1, eA, wA, 0); CS_LOAD(aB0, aB1, eB, wB, 1);
    CS_STORE(aA0, aA1, eA, wA, CS_A0, CS_B0);
    CS_LOAD(aA0, aA1, eA, wA, 2);
    __syncthreads();
#pragma unroll 1
    for (int tok = 0; tok < 16; tok += 2) {
        CS_COMPUTE(CS_A0, CS_B0);
        CS_STORE(aB0, aB1, eB, wB, CS_A1, CS_B1);
        if (tok + 3 < 16) CS_LOAD(aB0, aB1, eB, wB, tok + 3);
        __syncthreads();
        CS_COMPUTE(CS_A1, CS_B1);
        if (tok + 2 < 16) CS_STORE(aA0, aA1, eA, wA, CS_A0, CS_B0);
        if (tok + 4 < 16) CS_LOAD(aA0, aA1, eA, wA, tok + 4);
        __syncthreads();
    }
#undef CS_LOAD
#undef CS_STORE
#undef CS_STEP
#undef CS_COMPUTE
    { const int col = 16 * wave + 4 * fq; const f32x4 bias = peb_load(PEB, kv, col);
#pragma unroll
      for (int m = 0; m < 4; ++m) { const int row = 16 * m + fr; const f32x4 v = acc[m] + bias;
          u32x2 o; o.x = pk2(gelu_tanh(v.x), gelu_tanh(v.y)); o.y = pk2(gelu_tanh(v.z), gelu_tanh(v.w));
          *(LAS u32x2*)(lds + CS_HID + cf_off2(row, col >> 3) + (col & 7) * 2) = o; } }
    { const float* w2 = kv ? p.w2_v : p.w2_k; const int n = tid & 63, kb = tid >> 6; float x[16];
#pragma unroll
      for (int j = 0; j < 16; ++j) x[j] = w2[(size_t)(16 * kb + j) * 64 + n];
#pragma unroll
      for (int h2 = 0; h2 < 2; ++h2) { u32x4 o; o.x = pk2(x[8 * h2], x[8 * h2 + 1]); o.y = pk2(x[8 * h2 + 2], x[8 * h2 + 3]); o.z = pk2(x[8 * h2 + 4], x[8 * h2 + 5]); o.w = pk2(x[8 * h2 + 6], x[8 * h2 + 7]);
          *(LAS u32x4*)(lds + CS_W2 + cf_off2(n, 2 * kb + h2)) = o; } }
    __syncthreads();
    { const int m = wave & 3, n0 = 2 * (wave >> 2);
      f32x4 acc2[2]; acc2[0] = (f32x4){0.f, 0.f, 0.f, 0.f}; acc2[1] = acc2[0];
#pragma unroll
      for (int ks = 0; ks < 4; ++ks) { const bf16x8 a = *(const LAS bf16x8*)(lds + CS_HID + cf_off2(16 * m + fr, 4 * ks + fq));
#pragma unroll
          for (int j = 0; j < 2; ++j) { const bf16x8 bw = *(const LAS bf16x8*)(lds + CS_W2 + cf_off2(16 * (n0 + j) + fr, 4 * ks + fq)); acc2[j] = MFMA16(bw, a, acc2[j]); } }
      const int row = 16 * m + fr, i = c0 + (row >> 1), g = row & 1;
      if (i < NC_P) {
          float* dst = CK + (size_t)kv * CMPO + (size_t)CMPO_S + ((size_t)(b * NC_P + i) * 2 + g) * 64 + 4 * fq;
          bf16* kd = KCB + ((size_t)((kv * NBP + b) * 2 + g) * 512 + i) * 64 + 4 * fq;
#pragma unroll
          for (int j = 0; j < 2; ++j) { *(f32x4*)(dst + 16 * (n0 + j)) = acc2[j];
              u32x2 o; o.x = pk2(acc2[j].x, acc2[j].y); o.y = pk2(acc2[j].z, acc2[j].w); *(u32x2*)(kd + 16 * (n0 + j)) = o;
              if (i == 0) *(u32x2*)(kd + (size_t)511 * 64 + 16 * (n0 + j)) = (u32x2){0u, 0u}; }
      } }
    __syncthreads();
}

typedef short s16x4 __attribute__((ext_vector_type(4)));
typedef float f32x16 __attribute__((ext_vector_type(16)));
#define MFMA32(a, b, c) __builtin_amdgcn_mfma_f32_32x32x16_bf16(a, b, c, 0, 0, 0)
constexpr int AT_STG = 16384;
constexpr int AT_IMP = 2 * AT_STG;
constexpr int AT_SEL = AT_IMP + 8 * 4096;
constexpr int AT_QM = AT_SEL + 1024;
constexpr int AT_LS = AT_QM + 1024;
constexpr int AT_ACC = 68 * 1024;
constexpr int AT_ROW = 68;
constexpr int AT_QL = AT_ACC + 256 * AT_ROW * 4;
constexpr float AT_MASKED = -1e30f, AT_MINIT = -1e20f;

__device__ __forceinline__ int crow(int r, int hi) { return (r & 3) + 8 * (r >> 2) + 4 * hi; }
__device__ __forceinline__ unsigned cvtpk(float lo, float hi) { unsigned r; asm("v_cvt_pk_bf16_f32 %0, %1, %2" : "=v"(r) : "v"(lo), "v"(hi)); return r; }
__device__ __forceinline__ float xmax32(float v) { const auto rr = __builtin_amdgcn_permlane32_swap(__float_as_uint(v), __float_as_uint(v), false, false); return fmaxf(__uint_as_float(rr[0]), __uint_as_float(rr[1])); }
__device__ __forceinline__ float xsum32(float v) { const auto rr = __builtin_amdgcn_permlane32_swap(__float_as_uint(v), __float_as_uint(v), false, false); return __uint_as_float(rr[0]) + __uint_as_float(rr[1]); }
__device__ __forceinline__ float xget32(float v, int hi) { const auto rr = __builtin_amdgcn_permlane32_swap(__float_as_uint(v), __float_as_uint(v), false, false); return __uint_as_float(hi ? rr[0] : rr[1]); }
__device__ __forceinline__ s16x4 vtr(LAS const unsigned char* p) { typedef short v4i16_t __attribute__((ext_vector_type(4)));
    return __builtin_bit_cast(s16x4, __builtin_amdgcn_ds_read_tr16_b64_v4i16((LAS v4i16_t*)p)); }

struct AtStage { u32x4 k, v; };
template <bool NEEDV> __device__ __forceinline__ AtStage at_load(const bf16* ksrc, const bf16* vsrc, int tid) {
    AtStage s; const size_t off = (size_t)(tid >> 3) * 64 + (tid & 7) * 8;
    s.k = *(const u32x4*)(ksrc + off); if (NEEDV) s.v = *(const u32x4*)(vsrc + off); else s.v = (u32x4){0u, 0u, 0u, 0u};
    return s;
}
template <bool NEEDV> __device__ __forceinline__ void at_store(LAS unsigned char* buf, const AtStage& s, int tid) {
    const int key = tid >> 3, ch = tid & 7;
    *(LAS u32x4*)(buf + ch * 1024 + key * 16) = s.k;
    if (NEEDV) *(LAS u32x4*)(buf + 8192 + (ch >> 2) * 4096 + key * 64 + (ch & 3) * 16) = s.v;
}
__device__ __forceinline__ void at_scores(LAS const unsigned char* buf, const bf16x8 (&qf)[4], f32x16& s0, f32x16& s1, int lane) {
    LAS const unsigned char* kp = buf + (lane >> 5) * 1024 + (lane & 31) * 16;
    s0 = f32x16{}; s1 = f32x16{};
#pragma unroll
    for (int d0 = 0; d0 < 4; ++d0) { const bf16x8 ka = *(LAS const bf16x8*)(kp + d0 * 2048), kb = *(LAS const bf16x8*)(kp + d0 * 2048 + 512);
        s0 = MFMA32(ka, qf[d0], s0); s1 = MFMA32(kb, qf[d0], s1); }
}
__device__ __forceinline__ void at_softmax_pv(LAS const unsigned char* buf, f32x16& s0, f32x16& s1, f32x16 (&o)[2], float& m, float& l, int lane, bool lane_on) {
    float mx = fmaxf(s0[0], s1[0]);
#pragma unroll
    for (int r = 1; r < 16; r += 1) mx = __builtin_fmaxf(__builtin_fmaxf(mx, s0[r]), s1[r]);
    mx = xmax32(mx);
    mx = lane_on ? mx : AT_MASKED;
    const float mn = fmaxf(m, mx), al = __builtin_amdgcn_exp2f(m - mn);
    m = mn;
    const float off = lane_on ? mn : 1e30f;
    float rs = 0.f;
#pragma unroll
    for (int r = 0; r < 16; ++r) { s0[r] = __builtin_amdgcn_exp2f(s0[r] - off); s1[r] = __builtin_amdgcn_exp2f(s1[r] - off); rs += s0[r] + s1[r]; }
    l = l * al + rs;
    if (__ballot(al != 1.0f) != 0ull) {
#pragma unroll
        for (int r = 0; r < 16; ++r) { o[0][r] *= al; o[1][r] *= al; } }
    u32x4 pw[4];
    pw[0] = (u32x4){cvtpk(s0[0], s0[1]), cvtpk(s0[2], s0[3]), cvtpk(s0[4], s0[5]), cvtpk(s0[6], s0[7])};
    pw[1] = (u32x4){cvtpk(s0[8], s0[9]), cvtpk(s0[10], s0[11]), cvtpk(s0[12], s0[13]), cvtpk(s0[14], s0[15])};
    pw[2] = (u32x4){cvtpk(s1[0], s1[1]), cvtpk(s1[2], s1[3]), cvtpk(s1[4], s1[5]), cvtpk(s1[6], s1[7])};
    pw[3] = (u32x4){cvtpk(s1[8], s1[9]), cvtpk(s1[10], s1[11]), cvtpk(s1[12], s1[13]), cvtpk(s1[14], s1[15])};
    const int hi = lane >> 5;
    LAS const unsigned char* vp = buf + 8192 + ((lane >> 4) & 1) * 32 + (lane & 3) * 8 + (4 * hi + ((lane & 15) >> 2)) * 64;
#pragma unroll
    for (int k = 0; k < 4; ++k) {
        const bf16x8 pf = __builtin_bit_cast(bf16x8, pw[k]);
#pragma unroll
        for (int dh = 0; dh < 2; ++dh) { const s16x4 lo = vtr(vp + dh * 4096 + k * 1024), hh = vtr(vp + dh * 4096 + k * 1024 + 512);
            const bf16x8 vf = (bf16x8){lo[0], lo[1], lo[2], lo[3], hh[0], hh[1], hh[2], hh[3]};
            o[dh] = MFMA32(vf, pf, o[dh]); }
    }
}

__device__ __forceinline__ void at_softmax_pv_fixed(LAS const unsigned char* buf, f32x16& s0, f32x16& s1, f32x16 (&o)[2], float& l, int lane, float coff) {
    if (coff != 0.f) {
#pragma unroll
        for (int r = 0; r < 16; ++r) { s0[r] -= coff; s1[r] -= coff; } }
    float rs = 0.f;
#pragma unroll
    for (int r = 0; r < 16; ++r) { s0[r] = __builtin_amdgcn_exp2f(s0[r]); s1[r] = __builtin_amdgcn_exp2f(s1[r]); rs += s0[r] + s1[r]; }
    l += rs;
    u32x4 pw[4];
    pw[0] = (u32x4){cvtpk(s0[0], s0[1]), cvtpk(s0[2], s0[3]), cvtpk(s0[4], s0[5]), cvtpk(s0[6], s0[7])};
    pw[1] = (u32x4){cvtpk(s0[8], s0[9]), cvtpk(s0[10], s0[11]), cvtpk(s0[12], s0[13]), cvtpk(s0[14], s0[15])};
    pw[2] = (u32x4){cvtpk(s1[0], s1[1]), cvtpk(s1[2], s1[3]), cvtpk(s1[4], s1[5]), cvtpk(s1[6], s1[7])};
    pw[3] = (u32x4){cvtpk(s1[8], s1[9]), cvtpk(s1[10], s1[11]), cvtpk(s1[12], s1[13]), cvtpk(s1[14], s1[15])};
    const int hi = lane >> 5;
    LAS const unsigned char* vp = buf + 8192 + ((lane >> 4) & 1) * 32 + (lane & 3) * 8 + (4 * hi + ((lane & 15) >> 2)) * 64;
#pragma unroll
    for (int k = 0; k < 4; ++k) {
        const bf16x8 pf = __builtin_bit_cast(bf16x8, pw[k]);
#pragma unroll
        for (int dh = 0; dh < 2; ++dh) { const s16x4 lo = vtr(vp + dh * 4096 + k * 1024), hh = vtr(vp + dh * 4096 + k * 1024 + 512);
            const bf16x8 vf = (bf16x8){lo[0], lo[1], lo[2], lo[3], hh[0], hh[1], hh[2], hh[3]};
            o[dh] = MFMA32(vf, pf, o[dh]); }
    }
}

template <int MODE>
__device__ __forceinline__ void at_branch(const bf16* ksrc, const bf16* vsrc, int key0, int nst, LAS unsigned char* lds, const bf16x8 (&qf)[4], f32x16 (&o)[2], float& m, float& l,
                                          int t, unsigned long long sel_lo, unsigned long long sel_hi, int wlo, int whi, LAS float* impw, int tid, int lane, float coff = 0.f) {
    constexpr bool NEEDV = MODE != 3;
    const int hi = lane >> 5;
    float carry = 0.f;
    AtStage st = at_load<NEEDV>(ksrc, vsrc, tid);
    at_store<NEEDV>(lds, st, tid);
    __syncthreads();
    for (int s = 0; s < nst; ++s) {
        LAS unsigned char* buf = lds + (s & 1) * AT_STG;
        if (s + 1 < nst) st = at_load<NEEDV>(ksrc + (size_t)(s + 1) * 64 * 64, vsrc + (size_t)(s + 1) * 64 * 64, tid);
        const int kb = key0 + 64 * s;
        bool active = true;
        bool chosen = true;
        if (MODE == 1) { const int j = kb >> 6; const unsigned long long w = j < 64 ? sel_lo : sel_hi; chosen = (w >> (j & 63)) & 1ull; active = __ballot(chosen) != 0ull; }
        if (MODE == 2) active = (kb + 63 >= wlo - 512) && (kb <= whi);
        if (MODE == 0 || MODE == 3) active = 16 * kb + 31 <= whi;
        if (active) {
            f32x16 s0, s1;
            at_scores(buf, qf, s0, s1, lane);
            bool edge;
            if (MODE == 0 || MODE == 3) edge = 16 * (kb + 63) + 31 > wlo;
            else if (MODE == 1) edge = kb + 63 > wlo;
            else edge = (kb + 63 > wlo) || (kb < whi - 512);
            if (edge || MODE == 3) {
#pragma unroll
                for (int r = 0; r < 16; ++r) { const int k0 = kb + crow(r, hi), k1 = k0 + 32; bool v0, v1;
                    if (MODE == 0 || MODE == 3) { v0 = 16 * k0 + 31 <= t; v1 = 16 * k1 + 31 <= t; }
                    else if (MODE == 1) { v0 = k0 <= t; v1 = k1 <= t; }
                    else { v0 = k0 <= t && k0 >= t - 512; v1 = k1 <= t && k1 >= t - 512; }
                    if (MODE != 3) { s0[r] = v0 ? s0[r] : AT_MASKED; s1[r] = v1 ? s1[r] : AT_MASKED; }
                    else { s0[r] = v0 ? __builtin_amdgcn_exp2f(s0[r] - m) * l : 0.f; s1[r] = v1 ? __builtin_amdgcn_exp2f(s1[r] - m) * l : 0.f; } }
            }
            if (MODE == 2) at_softmax_pv_fixed(buf, s0, s1, o, l, lane, coff);
            else if (MODE != 3) at_softmax_pv(buf, s0, s1, o, m, l, lane, chosen);
            else {
#pragma unroll
                for (int n = 0; n < 2; ++n) { const f32x16& pp = n ? s1 : s0; const int jb0 = (kb >> 2) + 8 * n;
                    float own[4], sp[4], rc[4];
#pragma unroll
                    for (int G = 0; G < 4; ++G) { sp[G] = 0.5f * pp[4 * G + 3]; own[G] = pp[4 * G] + pp[4 * G + 1] + pp[4 * G + 2] + sp[G]; rc[G] = xget32(sp[G], hi); }
                    float val[4];
                    if (hi) { val[0] = own[0] + rc[0]; val[1] = own[1] + rc[1]; val[2] = own[2] + rc[2]; val[3] = own[3] + rc[3]; }
                    else { val[0] = own[0] + carry; val[1] = own[1] + rc[0]; val[2] = own[2] + rc[1]; val[3] = own[3] + rc[2]; }
                    carry = rc[3];
#pragma unroll
                    for (int G = 0; G < 4; ++G) { val[G] += dpp_mov<0xB1>(val[G]); val[G] += dpp_mov<0x4E>(val[G]);

                        if ((lane & 3) == 0) impw[((lane & 31) >> 2) * 128 + jb0 + 2 * G + hi] = val[G]; }
                }
            }
        } else if (MODE == 3) carry = 0.f;
        if (s + 1 < nst) at_store<NEEDV>(lds + ((s + 1) & 1) * AT_STG, st, tid);
        __syncthreads();
    }
}

__device__ __forceinline__ void at_slc_tile(LAS unsigned char* lds, LAS const unsigned char* buf, bool diag, int myq, float coff, f32x16 (&o)[2], float& rs, int lane) {
    const int hi = lane >> 5, col = lane & 31, head = col & 3;
    LAS const unsigned char* qimg = lds + AT_IMP;
    const int colg = myq * 4 + head;
    bf16x8 qf[4];
#pragma unroll
    for (int d0 = 0; d0 < 4; ++d0) qf[d0] = *(LAS const bf16x8*)(qimg + colg * 128 + (((d0 * 2 + hi) ^ (colg & 7)) << 4));
    f32x16 s0, s1;
    { LAS const unsigned char* kp = buf + hi * 1024 + col * 16;
      bf16x8 kf[8];
#pragma unroll
      for (int i = 0; i < 8; ++i) kf[i] = *(LAS const bf16x8*)(kp + (i >> 1) * 2048 + (i & 1) * 512);
      asm volatile("" ::: "memory");
      s0 = f32x16{}; s1 = f32x16{};
#pragma unroll
      for (int d0 = 0; d0 < 4; ++d0) { s0 = MFMA32(kf[2 * d0], qf[d0], s0); s1 = MFMA32(kf[2 * d0 + 1], qf[d0], s1); } }
    LAS const unsigned char* vp = buf + 8192 + ((lane >> 4) & 1) * 32 + (lane & 3) * 8 + (4 * hi + ((lane & 15) >> 2)) * 64;
    s16x4 vlo[4][2], vhi[4][2];
#pragma unroll
    for (int k = 0; k < 4; ++k)
#pragma unroll
        for (int dh = 0; dh < 2; ++dh) { vlo[k][dh] = vtr(vp + dh * 4096 + k * 1024); vhi[k][dh] = vtr(vp + dh * 4096 + k * 1024 + 512); }
    asm volatile("" ::: "memory");
    if (diag) {
#pragma unroll
        for (int r = 0; r < 16; ++r) { const int k0 = crow(r, hi); s0[r] = k0 <= myq ? s0[r] : AT_MASKED; s1[r] = k0 + 32 <= myq ? s1[r] : AT_MASKED; } }
    if (coff != 0.f) {
#pragma unroll
        for (int r = 0; r < 16; ++r) { s0[r] -= coff; s1[r] -= coff; } }
    rs = 0.f;
#pragma unroll
    for (int r = 0; r < 16; ++r) { s0[r] = __builtin_amdgcn_exp2f(s0[r]); s1[r] = __builtin_amdgcn_exp2f(s1[r]); rs += s0[r] + s1[r]; }
    u32x4 pw[4];
    pw[0] = (u32x4){cvtpk(s0[0], s0[1]), cvtpk(s0[2], s0[3]), cvtpk(s0[4], s0[5]), cvtpk(s0[6], s0[7])};
    pw[1] = (u32x4){cvtpk(s0[8], s0[9]), cvtpk(s0[10], s0[11]), cvtpk(s0[12], s0[13]), cvtpk(s0[14], s0[15])};
    pw[2] = (u32x4){cvtpk(s1[0], s1[1]), cvtpk(s1[2], s1[3]), cvtpk(s1[4], s1[5]), cvtpk(s1[6], s1[7])};
    pw[3] = (u32x4){cvtpk(s1[8], s1[9]), cvtpk(s1[10], s1[11]), cvtpk(s1[12], s1[13]), cvtpk(s1[14], s1[15])};
    o[0] = f32x16{}; o[1] = f32x16{};
#pragma unroll
    for (int k = 0; k < 4; ++k) {
        const bf16x8 pf = __builtin_bit_cast(bf16x8, pw[k]);
#pragma unroll
        for (int dh = 0; dh < 2; ++dh) { const s16x4 lo = vlo[k][dh], hh = vhi[k][dh];
            const bf16x8 vf = (bf16x8){lo[0], lo[1], lo[2], lo[3], hh[0], hh[1], hh[2], hh[3]};
            o[dh] = MFMA32(vf, pf, o[dh]); }
    }
    rs = xsum32(rs);
}
__device__ __forceinline__ void at_slc_merge(LAS unsigned char* lds, int myq, bool on, const f32x16 (&o)[2], float rs, int lane) {
    const int hi = lane >> 5, colg = myq * 4 + (lane & 3);
    LAS float* ap = (LAS float*)(lds + AT_ACC) + colg * AT_ROW + 4 * hi;
    LAS float* ls = (LAS float*)(lds + AT_LS);
    if (on) {
        f32x4 a4[2][4];
#pragma unroll
        for (int dh = 0; dh < 2; ++dh)
#pragma unroll
            for (int rg = 0; rg < 4; ++rg) a4[dh][rg] = *(LAS const f32x4*)(ap + dh * 32 + 8 * rg);
        asm volatile("" ::: "memory");
        if (hi == 0) ls[colg] += rs;
#pragma unroll
        for (int dh = 0; dh < 2; ++dh)
#pragma unroll
            for (int rg = 0; rg < 4; ++rg) *(LAS f32x4*)(ap + dh * 32 + 8 * rg) = (f32x4){a4[dh][rg][0] + o[dh][4 * rg], a4[dh][rg][1] + o[dh][4 * rg + 1], a4[dh][rg][2] + o[dh][4 * rg + 2], a4[dh][rg][3] + o[dh][4 * rg + 3]};
    }
}
__device__ __forceinline__ void at_slc(const bf16* ksrc, const bf16* vsrc, int jq, LAS unsigned char* lds, float coff, int tid, int lane, int wave) {
    const int col = lane & 31, w4 = wave & 3, side = wave >> 2;
    LAS const int* qcnt = (LAS const int*)(lds + AT_QM);
    LAS const unsigned char* qlist = lds + AT_QL;
    AtStage sa = at_load<true>(ksrc, vsrc, tid), sb = sa;
    if (jq >= 1) sb = at_load<true>(ksrc + 64 * 64, vsrc + 64 * 64, tid);
    at_store<true>(lds, sa, tid);
    if (jq >= 1) at_store<true>(lds + AT_STG, sb, tid);
    __syncthreads();
#pragma unroll 1
    for (int j0 = 0; j0 <= jq; j0 += 2) {
        const bool more_a = j0 + 2 <= jq, more_b = j0 + 3 <= jq;
        if (more_a) sa = at_load<true>(ksrc + (size_t)(j0 + 2) * 64 * 64, vsrc + (size_t)(j0 + 2) * 64 * 64, tid);
        if (more_b) sb = at_load<true>(ksrc + (size_t)(j0 + 3) * 64 * 64, vsrc + (size_t)(j0 + 3) * 64 * 64, tid);
        const int na = __builtin_amdgcn_readfirstlane(qcnt[j0]), nb = j0 + 1 <= jq ? __builtin_amdgcn_readfirstlane(qcnt[j0 + 1]) : 0;
        const int rounds = (na > 32 || nb > 32) ? 2 : 1;
        const int j = j0 + side, n = side ? nb : na;
#pragma unroll 1
        for (int rd = 0; rd < rounds; ++rd) {
            const int tile = w4 + 4 * rd; const bool have = 8 * tile < n;
            f32x16 o[2]; float rs = 0.f; int myq = 0;
            if (have) { myq = qlist[j * 64 + 8 * tile + (col >> 2)];
                at_slc_tile(lds, lds + side * AT_STG, j == jq, myq, coff, o, rs, lane);
                if (side == 0) at_slc_merge(lds, myq, 8 * tile + (col >> 2) < n, o, rs, lane); }
            __syncthreads();
            if (have && side == 1) at_slc_merge(lds, myq, 8 * tile + (col >> 2) < n, o, rs, lane);
            if (rd == rounds - 1) { if (more_a) at_store<true>(lds, sa, tid);
                                    if (more_b) at_store<true>(lds + AT_STG, sb, tid); }
            __syncthreads();
        }
    }
}

__device__ __forceinline__ void ph_attn_prompt(const P& p, LAS unsigned char* lds) {
    const int tid = tid_now(), lane = tid & 63, wave = __builtin_amdgcn_readfirstlane(tid >> 6), hi = lane >> 5;
    const bf16* QB = (const bf16*)(p.ws + WS_QB); const bf16* KB = (const bf16*)(p.ws + WS_KB); const bf16* VB = (const bf16*)(p.ws + WS_VB); const bf16* KCB = (const bf16*)(p.ws + WS_KCB);
    const float* GATES = (const float*)(p.ws + WS_GATES); float* ATTN = (float*)(p.ws + WS_ATTN);
    LAS float* impw = (LAS float*)(lds + AT_IMP + wave * 4096);
    LAS unsigned* selw = (LAS unsigned*)(lds + AT_SEL + wave * 128);
    float coff, coffw; { const float gq = wave_max(fabsf(p.q_g[lane])), gk = wave_max(fabsf(p.k_g[64 + lane])), gw = wave_max(fabsf(p.k_g[128 + lane]));
        coff = fmaxf(0.f, 8.0f * 1.4426950408889634f * 1.01f * gq * gk - 100.f); coffw = fmaxf(0.f, 8.0f * 1.4426950408889634f * 1.01f * gq * gw - 100.f); }
    for (int hw = blockIdx.x; hw < 256; hw += gridDim.x) {
        const int pr = ((hw & 7) >> 1) * 64 + (hw & 1) * 32 + (hw >> 3);
        const int bg = pr >> 6, b = bg >> 1, g = bg & 1;
#pragma unroll 1
        for (int half = 0; half < 2; ++half) {
            const int jq = half ? 127 - (pr & 63) : (pr & 63);
            const int t0 = 64 * jq, col = lane & 31, qi = col >> 2, head = col & 3, t = t0 + 8 * wave + qi;
            const int wlo = t0 + 8 * wave, whi = wlo + 7;
            bf16x8 qf[4];
            { const bf16* qp = QB + ((size_t)bg * SEQ + wlo) * 256 + (size_t)col * 64 + hi * 8;
#pragma unroll
              for (int d0 = 0; d0 < 4; ++d0) qf[d0] = *(const bf16x8*)(qp + d0 * 16); }
            const float* gp = GATES + (size_t)(b * SEQ + t) * 24 + (g * 4 + head) * 3;
            const float g_c = gp[0], g_s = gp[1], g_w = gp[2];
            f32x16 o[2]; float m, l;
            const int ncu = 4 * jq + 3 < NC_P ? 4 * jq + 3 : NC_P;
            const int nstc = (ncu + 63) >> 6;
            const bf16* kc = KCB + (size_t)bg * 512 * 64; const bf16* vc = kc + (size_t)NBP * 2 * 512 * 64;
            o[0] = f32x16{}; o[1] = f32x16{}; m = AT_MINIT; l = 0.f;
            at_branch<0>(kc, vc, 0, nstc, lds, qf, o, m, l, t, 0ull, 0ull, wlo, whi, impw, tid, lane);
            float lt = xsum32(l), il = lt > 0.f ? 1.0f / lt : 0.f;
            float* op = ATTN + (size_t)(b * SEQ + t) * AW + (g * 4 + head) * 64 + 4 * hi;
            { const float sc = g_c * il;
#pragma unroll
              for (int dh = 0; dh < 2; ++dh)
#pragma unroll
                for (int rg = 0; rg < 4; ++rg) *(f32x4*)(op + 32 * dh + 8 * rg) = (f32x4){sc * o[dh][4 * rg], sc * o[dh][4 * rg + 1], sc * o[dh][4 * rg + 2], sc * o[dh][4 * rg + 3]}; }
            if (jq >= 16) {
                for (int i = lane; i < 1024; i += 64) impw[i] = 0.f;
                asm volatile("s_waitcnt lgkmcnt(0)" ::: "memory");
                at_branch<3>(kc, vc, 0, nstc, lds, qf, o, m, il, t, 0ull, 0ull, wlo, whi, impw, tid, lane);
                asm volatile("s_waitcnt lgkmcnt(0)" ::: "memory");
                const int cur = jq;
                for (int q8 = 0; q8 < 8; q8 += 2) {
                    const float v0 = impw[q8 * 128 + lane], v1 = impw[q8 * 128 + 64 + lane], u0 = impw[q8 * 128 + 128 + lane], u1 = impw[q8 * 128 + 192 + lane];
                    const int j0 = lane, j1 = lane + 64;
                    const bool f0 = j0 == 0 || j0 == cur || j0 == cur - 1, f1 = j1 == cur || j1 == cur - 1;
                    const unsigned k0 = j0 > cur ? 0u : f0 ? 0x7F000000u : __float_as_uint(fmaxf(v0, 0.f)) + 1u, k1 = j1 > cur ? 0u : f1 ? 0x7F000000u : __float_as_uint(fmaxf(v1, 0.f)) + 1u;
                    const unsigned h0 = j0 > cur ? 0u : f0 ? 0x7F000000u : __float_as_uint(fmaxf(u0, 0.f)) + 1u, h1 = j1 > cur ? 0u : f1 ? 0x7F000000u : __float_as_uint(fmaxf(u1, 0.f)) + 1u;
                    unsigned T = 0u, U = 0u;
                    for (int bit = 30; bit >= 0; --bit) { const unsigned tr = T | (1u << bit), ur = U | (1u << bit);
                        const int cnt = __popcll(__ballot(k0 >= tr)) + __popcll(__ballot(k1 >= tr)), cnu = __popcll(__ballot(h0 >= ur)) + __popcll(__ballot(h1 >= ur));
                        if (cnt >= 16) T = tr;
                        if (cnu >= 16) U = ur; }
                    const unsigned long long below = (1ull << lane) - 1ull;
                    { const unsigned long long gt0 = __ballot(k0 > T), gt1 = __ballot(k1 > T), eq0 = __ballot(k0 == T), eq1 = __ballot(k1 == T);
                      const int need = 16 - (__popcll(gt0) + __popcll(gt1));
                      const int pre0 = __popcll(eq0 & below), pre1 = __popcll(eq0) + __popcll(eq1 & below);
                      const unsigned long long s0m = __ballot(k0 > T || (k0 == T && pre0 < need)), s1m = __ballot(k1 > T || (k1 == T && pre1 < need));
                      if (lane == 0) { selw[q8 * 4 + 0] = (unsigned)s0m; selw[q8 * 4 + 1] = (unsigned)(s0m >> 32); selw[q8 * 4 + 2] = (unsigned)s1m; selw[q8 * 4 + 3] = (unsigned)(s1m >> 32); } }
                    { const unsigned long long gt0 = __ballot(h0 > U), gt1 = __ballot(h1 > U), eq0 = __ballot(h0 == U), eq1 = __ballot(h1 == U);
                      const int need = 16 - (__popcll(gt0) + __popcll(gt1));
                      const int pre0 = __popcll(eq0 & below), pre1 = __popcll(eq0) + __popcll(eq1 & below);
                      const unsigned long long s0m = __ballot(h0 > U || (h0 == U && pre0 < need)), s1m = __ballot(h1 > U || (h1 == U && pre1 < need));
                      if (lane == 0) { selw[q8 * 4 + 4] = (unsigned)s0m; selw[q8 * 4 + 5] = (unsigned)(s0m >> 32); selw[q8 * 4 + 6] = (unsigned)s1m; selw[q8 * 4 + 7] = (unsigned)(s1m >> 32); } }
                }
            }
            asm volatile("s_waitcnt lgkmcnt(0)" ::: "memory");
            __syncthreads();
            for (int j = wave; j <= jq; j += 8) {
                unsigned long long mk = ~0ull;
                if (jq >= 16) { const unsigned wsel = *(LAS const unsigned*)(lds + AT_SEL + (lane >> 3) * 128 + (lane & 7) * 16 + (j >> 5) * 4); mk = __ballot((wsel >> (j & 31)) & 1u); }
                const unsigned mlo = (unsigned)mk, mhi = (unsigned)(mk >> 32);
                const int n = __popcll(mk), rk = (int)__builtin_amdgcn_mbcnt_hi(mhi, __builtin_amdgcn_mbcnt_lo(mlo, 0u));
                *(LAS unsigned char*)(lds + AT_QL + j * 64 + (((mk >> lane) & 1ull) ? rk : n + (lane - rk))) = (unsigned char)lane;
                if (lane == 0) *(LAS int*)(lds + AT_QM + j * 4) = n;
            }
#ifndef PROBE_SLC2
#define PROBE_SLC2 1
#endif
#ifdef PROBE_LIVE
            __syncthreads();
            if (hw == 0 && half == 1 && wave == 0) {
                int cnt = 0;
                for (int j = lane; j <= jq; j += 64) { const int n = *(LAS const int*)(lds + AT_QM + j * 4); cnt += PROBE_LIVE == 0 ? (n > 0 ? 1 : 0) : (n + 7) >> 3; }
                cnt = (int)wave_sum((float)cnt);
                const unsigned long long t_end = __builtin_amdgcn_s_memrealtime() + (unsigned long long)cnt * (PROBE_LIVE == 0 ? 100ull : 100ull / PROBE_LIVE);
                while (__builtin_amdgcn_s_memrealtime() < t_end) __builtin_amdgcn_s_sleep(8);
            }
#endif
#pragma unroll 1
            for (int rep = 0; rep < PROBE_SLC2; ++rep) {
            { const int colg = 32 * wave + col;
#pragma unroll
              for (int d0 = 0; d0 < 4; ++d0) *(LAS bf16x8*)(lds + AT_IMP + colg * 128 + (((d0 * 2 + hi) ^ (colg & 7)) << 4)) = qf[d0];
              for (int i = tid; i < 256 * AT_ROW / 4; i += 512) *(LAS f32x4*)(lds + AT_ACC + i * 16) = (f32x4){0.f, 0.f, 0.f, 0.f};
              if (tid < 256) *(LAS float*)(lds + AT_LS + tid * 4) = 0.f; }
            at_slc(KB + (size_t)bg * SEQ * 64, VB + (size_t)bg * SEQ * 64, jq, lds, coff, tid, lane, wave);
            }
            { const float lt2 = *(LAS const float*)(lds + AT_LS + (32 * wave + col) * 4);
              const float sc = g_s * (lt2 > 0.f ? 1.0f / lt2 : 0.f);
              LAS float* ap = (LAS float*)(lds + AT_ACC) + (32 * wave + col) * AT_ROW + 4 * hi;
#pragma unroll
              for (int dh = 0; dh < 2; ++dh)
#pragma unroll
                for (int rg = 0; rg < 4; ++rg) { const f32x4 c4 = *(const f32x4*)(op + 32 * dh + 8 * rg);
                    LAS f32x4* a1 = (LAS f32x4*)(ap + dh * 32 + 8 * rg); const f32x4 s4 = *a1; *a1 = c4 + sc * s4; } }
            const int kw0 = t0 >= 512 ? t0 - 512 : 0;
            o[0] = f32x16{}; o[1] = f32x16{}; m = AT_MINIT; l = 0.f;
            at_branch<2>(KB + ((size_t)(4 + bg) * SEQ + kw0) * 64, VB + ((size_t)(4 + bg) * SEQ + kw0) * 64, kw0, (t0 + 64 - kw0) >> 6, lds, qf, o, m, l, t, 0ull, 0ull, wlo, whi, impw, tid, lane, coffw);
            lt = xsum32(l); il = lt > 0.f ? 1.0f / lt : 0.f;
            { const float sc = g_w * il;
              LAS const float* ap = (LAS const float*)(lds + AT_ACC) + (32 * wave + col) * AT_ROW + 4 * hi;
#pragma unroll
              for (int dh = 0; dh < 2; ++dh)
#pragma unroll
                for (int rg = 0; rg < 4; ++rg) { const f32x4 a4 = *(LAS const f32x4*)(ap + dh * 32 + 8 * rg);
                    o[dh][4 * rg] = a4[0] + sc * o[dh][4 * rg]; o[dh][4 * rg + 1] = a4[1] + sc * o[dh][4 * rg + 1]; o[dh][4 * rg + 2] = a4[2] + sc * o[dh][4 * rg + 2]; o[dh][4 * rg + 3] = a4[3] + sc * o[dh][4 * rg + 3]; } }
#pragma unroll
            for (int dh = 0; dh < 2; ++dh)
#pragma unroll
                for (int rg = 0; rg < 4; ++rg) *(f32x4*)(op + 32 * dh + 8 * rg) = (f32x4){o[dh][4 * rg], o[dh][4 * rg + 1], o[dh][4 * rg + 2], o[dh][4 * rg + 3]};
        }
    }
}

enum { SK_Z = 0, SK_GLU, SK_OUT, SK_UP, SK_DOWN };
template <int EP, int K>
__device__ __forceinline__ void skinny_gemm(const P& p, LAS unsigned char* lds, const bf16* A  , const bf16* Bt, int ncolblk, int first_wg) {
    const int tid = tid_now(), lane = tid & 63, wave = __builtin_amdgcn_readfirstlane(tid >> 6), fr = lane & 15, fq = lane >> 4;
    constexpr int KW = K / 8, NKS = KW / 32;
    static_assert(KW % 32 == 0, "K / 8 must be a multiple of 32");
    LAS float* part = (LAS float*)lds;
    const int nwg = (int)gridDim.x - first_wg;
    if ((int)blockIdx.x < first_wg) return;
    for (int u = (int)blockIdx.x - first_wg; u < 4 * ncolblk; u += nwg) {
        const int rb = u & 3, cb = u >> 2;
        const bf16* ap = A + (size_t)(32 * rb + fr) * K + wave * KW + 8 * fq;
        const bf16* bp[4];
#pragma unroll
        for (int n = 0; n < 4; ++n) { int brow;
            if (EP == SK_UP) brow = (cb >> 2) * 256 + (cb & 3) * 32 + (n >> 1) * 128 + (n & 1) * 16 + fr;
            else brow = cb * 64 + 16 * n + fr;
            bp[n] = Bt + (size_t)brow * K + wave * KW + 8 * fq; }
        f32x4 acc[2][4];
#pragma unroll
        for (int m = 0; m < 2; ++m)
#pragma unroll
            for (int n = 0; n < 4; ++n) acc[m][n] = (f32x4){0.f, 0.f, 0.f, 0.f};
#pragma unroll 1
        for (int k0 = 0; k0 < NKS; k0 += 4) {
            bf16x8 a[4][2], bw[4][4];
#pragma unroll
            for (int s = 0; s < 4; ++s) if (k0 + s < NKS) {
#pragma unroll
                for (int m = 0; m < 2; ++m) a[s][m] = *(const bf16x8*)(ap + (size_t)(16 * m) * K + 32 * (k0 + s));
#pragma unroll
                for (int n = 0; n < 4; ++n) bw[s][n] = *(const bf16x8*)(bp[n] + 32 * (k0 + s)); }
#pragma unroll
            for (int s = 0; s < 4; ++s) if (k0 + s < NKS) {
#pragma unroll
                for (int m = 0; m < 2; ++m)
#pragma unroll
                    for (int n = 0; n < 4; ++n) acc[m][n] = MFMA16(bw[s][n], a[s][m], acc[m][n]); }
        }
#pragma unroll
        for (int m = 0; m < 2; ++m)
#pragma unroll
            for (int n = 0; n < 4; ++n) *(LAS f32x4*)(part + wave * 2048 + (16 * m + fr) * 64 + 16 * n + 4 * fq) = acc[m][n];
        __syncthreads();
        {
            const int row = tid >> 4, c4 = tid & 15, r = MP + 32 * rb + row;
            f32x4 v = (f32x4){0.f, 0.f, 0.f, 0.f}, v2 = (f32x4){0.f, 0.f, 0.f, 0.f};
#pragma unroll
            for (int w = 0; w < 8; ++w) { v += *(const LAS f32x4*)(part + w * 2048 + row * 64 + 4 * c4); if (EP == SK_UP) v2 += *(const LAS f32x4*)(part + w * 2048 + row * 64 + ((4 * c4 + 32) & 63)); }
            const float* ADA = (const float*)(p.ws + WS_ADA) + (size_t)ada_row(r) * 6144;
            if (EP == SK_Z) { *(f32x4*)((float*)(p.ws + WS_Z) + (size_t)r * INP + cb * 64 + 4 * c4) = v; }
            if (EP == SK_GLU) { const int col = cb * 64 + 4 * c4; const f32x4 s = *(const f32x4*)((const float*)(p.ws + WS_SF) + (size_t)r * 512 + col); const f32x4 bv = *(const f32x4*)(p.b_glu + col);
                f32x4 o; o.x = s.x * sigmoid_f(v.x + bv.x); o.y = s.y * sigmoid_f(v.y + bv.y); o.z = s.z * sigmoid_f(v.z + bv.z); o.w = s.w * sigmoid_f(v.w + bv.w);
                *(f32x4*)((float*)(p.ws + WS_S2) + (size_t)r * 512 + col) = o; }
            if (EP == SK_OUT) { const int col = cb * 64 + 4 * c4;
                *(f32x4*)((float*)(p.ws + WS_X1) + (size_t)r * D + col) = *(const f32x4*)(p.xs + (size_t)(r - MP) * D + col) + *(const f32x4*)(ADA + 2 * D + col) * v; }
            if (EP == SK_UP) { if (c4 < 8) { u32x2 o; o.x = pk2(silu_f(v.x) * v2.x, silu_f(v.y) * v2.y); o.y = pk2(silu_f(v.z) * v2.z, silu_f(v.w) * v2.w);
                *(u32x2*)((bf16*)(p.ws + WS_FF) + (size_t)r * DFF + cb * 32 + 4 * c4) = o; } }
            if (EP == SK_DOWN) { const int col = cb * 64 + 4 * c4;
                *(f32x4*)(p.out + O_YS + (size_t)(r - MP) * D + col) = *(const f32x4*)((const float*)(p.ws + WS_X1) + (size_t)r * D + col) + *(const f32x4*)(ADA + 5 * D + col) * v; }
        }
        __syncthreads();
    }
}

struct EpiInproj {
    static constexpr bool PERM = false, AFTER_DRAIN = false;
    float* out; bf16 *QB, *KB, *VB; float *GATES, *U; const float *ROPE, *q_g, *k_g; LAS float* red;
    __device__ __forceinline__ void operator()(const pg8::f32x4 (&acc)[2][2][4][2], const pg8::Unit& u, int wr, int wc, int fr, int fq) const {
        const int pn = u.pn, row0 = u.pm * 256 + wr * 64 + fr;
        if (pn >= 5) {
#pragma unroll
            for (int ai = 0; ai < 2; ++ai)
#pragma unroll
                for (int m = 0; m < 4; ++m) { const int r = row0 + ai * 128 + m * 16;
#pragma unroll
                    for (int bj = 0; bj < 2; ++bj)
#pragma unroll
                        for (int n = 0; n < 2; ++n) { const int zc = pn * 256 + bj * 128 + wc * 32 + n * 16 + 4 * fq; const pg8::f32x4 v = acc[ai][bj][m][n];
                            if (zc < O3) { pg8::f32x4 g; g[0] = sigmoid_f(v[0]); g[1] = sigmoid_f(v[1]); g[2] = sigmoid_f(v[2]); g[3] = sigmoid_f(v[3]); *(pg8::f32x4*)(GATES + (size_t)r * 24 + (zc - O2)) = g; }
                            else if (zc < INC) *(pg8::f32x4*)(U + (size_t)r * SW + (zc - O3)) = v; } }
            return;
        }
        const bool qtile = pn < 2; const int br = pn - 2;
        LAS float* rw = red + (wr * 64 + fr) * 8 + wc; LAS float* rx = red + (wr * 64 + fr) * 8 + (wc ^ 1);
#pragma unroll
        for (int ai = 0; ai < 2; ++ai)
#pragma unroll
            for (int m = 0; m < 4; ++m)
#pragma unroll
                for (int bj = 0; bj < 2; ++bj) { if (bj == 1 && !qtile) continue;
                    const pg8::f32x4 a = acc[ai][bj][m][0], c = acc[ai][bj][m][1];
                    float s = (a[0] * a[0] + a[1] * a[1]) + (a[2] * a[2] + a[3] * a[3]) + (c[0] * c[0] + c[1] * c[1]) + (c[2] * c[2] + c[3] * c[3]);
                    s += __shfl_xor(s, 16); s += __shfl_xor(s, 32);
                    if (fq == 0) rw[(ai * 128 + m * 16) * 8 + bj * 4] = s; }
        asm volatile("s_waitcnt lgkmcnt(0)" ::: "memory"); __builtin_amdgcn_s_barrier(); asm volatile("" ::: "memory");
        const int hc = 32 * (wc & 1) + 4 * fq;
        const int b = (u.pm * 256) / SEQ;
        const float* gp = qtile ? q_g : k_g + br * 64;
        const pg8::f32x4 g0 = *(const pg8::f32x4*)(gp + hc), g1 = *(const pg8::f32x4*)(gp + hc + 16);
        const bool rot = (wc & 1) == 0;
        pg8::f32x4 csn = {0.f, 0.f, 0.f, 0.f}, snn = {0.f, 0.f, 0.f, 0.f};
        if (rot) { const int t0r = (u.pm * 256 + wr * 64 + fr) % SEQ; csn = *(const pg8::f32x4*)(ROPE + (size_t)t0r * 16 + 4 * (fq & 1)); snn = *(const pg8::f32x4*)(ROPE + (size_t)t0r * 16 + 8 + 4 * (fq & 1)); }
#pragma unroll
        for (int ai = 0; ai < 2; ++ai)
#pragma unroll
            for (int m = 0; m < 4; ++m) {
                const int rl = ai * 128 + wr * 64 + m * 16 + fr, r = u.pm * 256 + rl, t = r % SEQ;
                const pg8::f32x4 cs = csn, sn = snn;
                if (rot && (ai * 4 + m) < 7) { const int itn = ai * 4 + m + 1, tn = (u.pm * 256 + (itn >> 2) * 128 + wr * 64 + (itn & 3) * 16 + fr) % SEQ;
                    csn = *(const pg8::f32x4*)(ROPE + (size_t)tn * 16 + 4 * (fq & 1)); snn = *(const pg8::f32x4*)(ROPE + (size_t)tn * 16 + 8 + 4 * (fq & 1)); }
#pragma unroll
                for (int bj = 0; bj < 2; ++bj) {
                    pg8::f32x4 y0 = acc[ai][bj][m][0], y1 = acc[ai][bj][m][1];
                    const bool normed = qtile || bj == 0;
                    if (normed) {
                        const float ss = rw[(ai * 128 + m * 16) * 8 + bj * 4] + rx[(ai * 128 + m * 16) * 8 + bj * 4];
                        const float rstd = 1.0f / sqrtf(ss * (1.0f / 64.0f) + EPS);
                        y0 = y0 * rstd * g0; y1 = y1 * rstd * g1;
                        if (rot) {
#pragma unroll
                            for (int j = 0; j < 4; ++j) { const float own = y0[j];
                                const auto rr = __builtin_amdgcn_permlane32_swap(__float_as_uint(own), __float_as_uint(own), false, false);
                                const float pr = __uint_as_float(fq >= 2 ? rr[0] : rr[1]);
                                y0[j] = fq < 2 ? own * cs[j] - pr * sn[j] : pr * sn[j] + own * cs[j]; }
                        }
                    }
                    if (qtile) {
                        const float qs = 0.125f * 1.4426950408889634f;
                        bf16* qp = QB + ((size_t)(b * 2 + pn) * SEQ + t) * 256 + (2 * bj + (wc >> 1)) * 64 + hc;
                        u32x2 o0, o1; o0.x = pk2(y0[0] * qs, y0[1] * qs); o0.y = pk2(y0[2] * qs, y0[3] * qs); o1.x = pk2(y1[0] * qs, y1[1] * qs); o1.y = pk2(y1[2] * qs, y1[3] * qs);
                        *(u32x2*)qp = o0; *(u32x2*)(qp + 16) = o1;
                    } else {
                        const int kc = bj * 128 + (wc >> 1) * 64 + hc;
                        float* op = br == 0 ? out + O_KVC_P + (size_t)r * 256 : br == 1 ? out + O_KVS_P + (size_t)r * 256 : (t >= SEQ - 512 ? out + O_KVW_P + (size_t)(b * 512 + t - (SEQ - 512)) * 256 : nullptr);
                        if (op) { *(pg8::f32x4*)(op + kc) = y0; *(pg8::f32x4*)(op + kc + 16) = y1; }
                        if (br > 0) { bf16* kp = (bj ? VB : KB) + ((size_t)(((br - 1) * NBP + b) * 2 + (wc >> 1)) * SEQ + t) * 64 + hc;
                            u32x2 o0, o1; o0.x = pk2(y0[0], y0[1]); o0.y = pk2(y0[2], y0[3]); o1.x = pk2(y1[0], y1[1]); o1.y = pk2(y1[2], y1[3]);
                            *(u32x2*)kp = o0; *(u32x2*)(kp + 16) = o1; }
                    }
                }
                asm volatile("" ::: "memory");
            }
    }
};

enum { PH_PREP = 0, PH_H, PH_INPROJ, PH_SSM1, PH_CMPGEMM, PH_ATTN, PH_MIXIN, PH_OUT, PH_H2, PH_UP, PH_DOWN, PH_N };
constexpr int BAR_LDS_OFF = 148 * 1024;
constexpr int CW_BAR = 4096;

template <int PH>
__device__ __forceinline__ void run_phase(const P& p, LAS unsigned char* lds) {
    unsigned char* ws = p.ws;
    if constexpr (PH == PH_PREP) ph_prep(p, lds);
    if constexpr (PH == PH_H) { ph_normmod<0>(p); ph_cmpf<0>(p, lds); }
    if constexpr (PH == PH_INPROJ) { pg8::Gemm g{(const bf16*)(ws + WS_H), (const bf16*)(ws + WS_WIN_T), MP, INP, D}; pg8::StaticOrder S; S.init(MP, INP, gridDim.x, blockIdx.x);
        EpiInproj E{p.out, (bf16*)(ws + WS_QB), (bf16*)(ws + WS_KB), (bf16*)(ws + WS_VB), (float*)(ws + WS_GATES), (float*)(ws + WS_U), (const float*)(ws + WS_ROPE), p.q_g, p.k_g, (LAS float*)(lds + 132 * 1024)};
        pg8::gemm_phase<EpiInproj, pg8::StaticOrder>(lds, g, S, E, nullptr);
        skinny_gemm<SK_Z, 1024>(p, lds, (const bf16*)(ws + WS_H) + (size_t)MP * D, (const bf16*)(ws + WS_WIN_T), 29, 0); }
    if constexpr (PH == PH_SSM1) { ph_split(p, lds); __syncthreads(); ph_ssm<1>(p, lds, 0, (int)gridDim.x, 0, NBP * NSG * NCH, 1 << 30, 0); }
    if constexpr (PH == PH_CMPGEMM) {
        constexpr int NP = NBP * NSG * NCH, NS = DB * NSG;
        if (gridDim.x == 256) {
            if (blockIdx.x < 64) { ph_cmpf_small(p, lds, blockIdx.x); __syncthreads(); ph_ssm<2>(p, lds, 0, 64, NP - 512, NP, 1 << 30, 0); }
            else ph_ssm<2>(p, lds, 64, 256, 0, NP - 512 + NS, NP - 512, 512);
        } else { for (int u = blockIdx.x; u < 64; u += gridDim.x) { ph_cmpf_small(p, lds, u); } __syncthreads(); ph_ssm<2>(p, lds, 0, (int)gridDim.x, 0, NP + NS, 1 << 30, 0); } }
    if constexpr (PH == PH_ATTN) { ph_attn_prompt(p, lds); __syncthreads(); ph_attn_sample(p, lds); __syncthreads();
        { pg8::Gemm g{(const bf16*)(ws + WS_SB), (const bf16*)(ws + WS_WGLU_T), MP, 512, 512}; pg8::StaticOrder S; S.init(MP, 512, gridDim.x, blockIdx.x);
        EpiGlu E{(const float*)(ws + WS_SF), (float*)(ws + WS_S2), p.b_glu}; pg8::gemm_phase<EpiGlu, pg8::StaticOrder>(lds, g, S, E, nullptr);
        skinny_gemm<SK_GLU, 512>(p, lds, (const bf16*)(ws + WS_SB) + (size_t)MP * 512, (const bf16*)(ws + WS_WGLU_T), 8, (int)gridDim.x / 2); }
        __syncthreads();
        ph_late_transposes(p, lds, (int)gridDim.x / 2, (int)gridDim.x); }
    if constexpr (PH == PH_MIXIN) ph_mixin(p);
    if constexpr (PH == PH_OUT) { pg8::Gemm g{(const bf16*)(ws + WS_MIX), (const bf16*)(ws + WS_WOUT_T), MP, D, D}; pg8::StaticOrder S; S.init(MP, D, gridDim.x, blockIdx.x);
        EpiOut E{p.xp, p.xs, (const float*)(ws + WS_ADA), (float*)(ws + WS_X1)}; pg8::gemm_phase<EpiOut, pg8::StaticOrder>(lds, g, S, E, nullptr);
        skinny_gemm<SK_OUT, 1024>(p, lds, (const bf16*)(ws + WS_MIX) + (size_t)MP * D, (const bf16*)(ws + WS_WOUT_T), 16, 0); }
    if constexpr (PH == PH_H2) ph_normmod<1>(p);
    if constexpr (PH == PH_UP) { pg8::Gemm g{(const bf16*)(ws + WS_H2), (const bf16*)(ws + WS_WUP_T), MP, 2 * DFF, D}; pg8::StaticOrder S; S.init(MP, 2 * DFF, gridDim.x, blockIdx.x);
        EpiUp E{(bf16*)(ws + WS_FF)}; pg8::gemm_phase<EpiUp, pg8::StaticOrder>(lds, g, S, E, nullptr);
        skinny_gemm<SK_UP, 1024>(p, lds, (const bf16*)(ws + WS_H2) + (size_t)MP * D, (const bf16*)(ws + WS_WUP_T), 88, (int)gridDim.x / 2); }
    if constexpr (PH == PH_DOWN) { pg8::Gemm g{(const bf16*)(ws + WS_FF), (const bf16*)(ws + WS_WDN_T), MP, D, DFF}; pg8::StaticOrder S; S.init(MP, D, gridDim.x, blockIdx.x);
        EpiDown E{(const float*)(ws + WS_X1), (const float*)(ws + WS_ADA), p.out}; pg8::gemm_phase<EpiDown, pg8::StaticOrder>(lds, g, S, E, nullptr);
        skinny_gemm<SK_DOWN, 2816>(p, lds, (const bf16*)(ws + WS_FF) + (size_t)MP * DFF, (const bf16*)(ws + WS_WDN_T), 16, 0); }
}

#ifndef REPMASK
#define REPMASK 0u
#endif
template <int PH, int HI>
__device__ __forceinline__ void run_from(const P& p, LAS unsigned char* lds, const XcdBarrier& bar) {
    run_phase<PH>(p, lds);
    if constexpr (((REPMASK) >> PH) & 1u) { xcd_barrier(bar); run_phase<PH>(p, lds); }
    if constexpr (PH + 1 < HI) { xcd_barrier(bar); run_from<PH + 1, HI>(p, lds, bar); }
}

template <int LO, int HI>
__global__ void __launch_bounds__(512, 2) k_fwd(P p) {
    extern __shared__ __attribute__((aligned(16))) unsigned char lds_raw[];
    LAS unsigned char* lds = (LAS unsigned char*)lds_raw;
    if (threadIdx.x < 4) ((LAS unsigned*)(lds + BAR_LDS_OFF))[threadIdx.x] = 0u;
    __syncthreads();
    XcdBarrier bar; bar.bar = (unsigned*)(p.ws + WS_CTL) + CW_BAR; bar.x = 0; bar.st = (volatile LAS unsigned*)(lds + BAR_LDS_OFF);
    if constexpr (HI - LO > 1) bar = xcd_barrier_post((unsigned*)(p.ws + WS_CTL) + CW_BAR, (volatile LAS unsigned*)(lds + BAR_LDS_OFF));
    run_from<LO, HI>(p, lds, bar);
}

extern "C" void kernel_launch(void* const* d_in, const int* in_sizes, int n_in, void* d_out, int out_size, void* d_ws, size_t ws_size, hipStream_t stream) {
    if (n_in != 39 || (size_t)out_size != O_END || ws_size < WS_END) { fprintf(stderr, "kernel_launch: unexpected shapes (n_in %d out %d ws %zu need %zu)\n", n_in, out_size, ws_size, (size_t)WS_END); return; }
    static int grid = 0;
    if (grid == 0) {
        int dev = 0, cus = 0, per_cu = 0;
        if (hipGetDevice(&dev) != hipSuccess || hipDeviceGetAttribute(&cus, hipDeviceAttributeMultiprocessorCount, dev) != hipSuccess) { fprintf(stderr, "kernel_launch: device query failed\n"); grid = -1; return; }
        if (hipFuncSetAttribute((const void*)k_fwd<0, PH_N>, hipFuncAttributeMaxDynamicSharedMemorySize, LDS_BYTES) != hipSuccess) { fprintf(stderr, "kernel_launch: hipFuncSetAttribute failed\n"); grid = -1; return; }
        if (hipOccupancyMaxActiveBlocksPerMultiprocessor(&per_cu, (const void*)k_fwd<0, PH_N>, 512, LDS_BYTES) != hipSuccess || per_cu < 1) { fprintf(stderr, "kernel_launch: occupancy query says %d blocks per CU\n", per_cu); (void)hipGetLastError(); grid = -1; return; }
        grid = cus;
    }
    if (grid < 0) return;
    P p{};
    p.xp = (const float*)d_in[0]; p.xs = (const float*)d_in[1]; p.cache_c = (const float*)d_in[2]; p.cache_s = (const float*)d_in[3]; p.cache_w = (const float*)d_in[4];
    p.st_re = (const float*)d_in[5]; p.st_im = (const float*)d_in[6]; p.pt = (const int*)d_in[7]; p.cp = (const float*)d_in[8]; p.cs = (const float*)d_in[9];
    p.norm_mix_g = (const float*)d_in[10]; p.w_ada = (const float*)d_in[11]; p.b_ada = (const float*)d_in[12]; p.w_in = (const float*)d_in[13]; p.q_g = (const float*)d_in[14]; p.k_g = (const float*)d_in[15];
    p.pe_k = (const float*)d_in[16]; p.w1_k = (const float*)d_in[17]; p.w2_k = (const float*)d_in[18]; p.pe_v = (const float*)d_in[19]; p.w1_v = (const float*)d_in[20]; p.w2_v = (const float*)d_in[21];
    p.a_re = (const float*)d_in[22]; p.a_im = (const float*)d_in[23]; p.log_dt = (const float*)d_in[24]; p.b_re = (const float*)d_in[25]; p.b_im = (const float*)d_in[26]; p.c_re = (const float*)d_in[27]; p.c_im = (const float*)d_in[28];
    p.ssm_d = (const float*)d_in[29]; p.w_glu = (const float*)d_in[30]; p.b_glu = (const float*)d_in[31]; p.attn_g = (const float*)d_in[32]; p.ssm_g = (const float*)d_in[33]; p.w_out = (const float*)d_in[34];
    p.norm_ffn_g = (const float*)d_in[35]; p.w_gate = (const float*)d_in[36]; p.w_up = (const float*)d_in[37]; p.w_down = (const float*)d_in[38];
    p.out = (float*)d_out; p.ws = (unsigned char*)d_ws;
    if (hipMemsetAsync((char*)d_ws + WS_CTL, 0, (size_t)(CW_BAR + XCD_BAR_WORDS) * 4, stream) != hipSuccess) { fprintf(stderr, "kernel_launch: memset failed\n"); return; }
    hipLaunchKernelGGL((k_fwd<0, PH_N>), dim3(grid), dim3(512), LDS_BYTES, stream, p);
}
```

```cpp
#include <hip/hip_runtime.h>
#include <cstdio>
#include <cstdint>
#include <cstddef>

namespace pg8 {
#define PG8_LAS __attribute__((address_space(3)))
typedef unsigned short bf16_t;
typedef short bf16x8 __attribute__((ext_vector_type(8)));
typedef float f32x4 __attribute__((ext_vector_type(4)));
typedef unsigned u32x4 __attribute__((ext_vector_type(4)));
constexpr int BM = 256, BK = 64, HALF = 128, HTB = HALF * BK * 2  , STAGE_BYTES = 8 * HTB, NXCD = 8, WGM = 8;

__host__ __device__ __forceinline__ int lds_byte(int r, int c) { const int st = (r >> 4) * 2 + (c >> 5), rr = r & 15, cc = c & 31, ob = rr * 64 + cc * 2; return st * 1024 + (ob ^ (((ob >> 9) & 1) << 5)); }
__host__ __device__ __forceinline__ void stage_rc(int b, int& R, int& C) { const int st = b / 1024, sb = b % 1024, swz = sb ^ (((sb >> 9) & 1) << 5); R = (st >> 1) * 16 + swz / 64; C = (st & 1) * 32 + (swz % 64) / 2; }
__host__ __device__ __forceinline__ int perm32(int rho) { const int n = rho >> 4, i = rho & 15; return 8 * (i >> 2) + 4 * n + (i & 3); }

struct Unit { int pm, pn; };
struct Gemm { const bf16_t* A; const bf16_t* Bt; int M, N, K; };

struct StaticOrder {
    int nM, nN, nwg, G, c;
    __host__ __device__ void init(int M, int N, int G_, int c_) { nM = M / BM; nN = N / BM; nwg = nM * nN; G = G_; c = c_; }
    __host__ __device__ bool next(int i, Unit& u) const {
        const long L = (long)i * G + c; if (L >= nwg) return false;
        int wgid = (int)L; { const int q = nwg / NXCD, r = nwg % NXCD, xcd = wgid % NXCD, off = wgid / NXCD; wgid = (xcd < r ? xcd * (q + 1) : r * (q + 1) + (xcd - r) * q) + off; }
        const int nig = WGM * nN, gid = wgid / nig, fm = gid * WGM, gsz = (nM - fm) < WGM ? (nM - fm) : WGM;
        u.pm = fm + ((wgid % nig) % gsz); u.pn = (wgid % nig) / gsz; return true;
    }
    __device__ __forceinline__ void a_ready(const Unit&) const {}
    __device__ __forceinline__ void done(const Unit&) const {}
};
__device__ __forceinline__ unsigned cvt_pk_bf16(float lo, float hi) { unsigned r; asm volatile("v_cvt_pk_bf16_f32 %0, %1, %2" : "=v"(r) : "v"(lo), "v"(hi)); return r; }
typedef float f32x2 __attribute__((ext_vector_type(2)));
struct EpiF32 {
    static constexpr bool PERM = false, AFTER_DRAIN = false;
    float* C; int ldc; const float* bias;
    __device__ __forceinline__ void operator()(const f32x4 (&acc)[2][2][4][2], const Unit& u, int wr, int wc, int fr, int fq) const {
        const int row0 = u.pm * BM + wr * 64 + fr, col0 = u.pn * BM + wc * 32 + 4 * fq;
        f32x4 bv[2][2];
#pragma unroll
        for (int bj = 0; bj < 2; ++bj)
#pragma unroll
            for (int n = 0; n < 2; ++n) bv[bj][n] = bias ? *(const f32x4*)(bias + col0 + bj * HALF + n * 16) : (f32x4){0.f, 0.f, 0.f, 0.f};
#pragma unroll
        for (int ai = 0; ai < 2; ++ai)
#pragma unroll
            for (int m = 0; m < 4; ++m) { float* rowp = C + (size_t)(row0 + ai * HALF + m * 16) * ldc + col0;
#pragma unroll
                for (int bj = 0; bj < 2; ++bj)
#pragma unroll
                    for (int n = 0; n < 2; ++n) *(f32x4*)(rowp + bj * HALF + n * 16) = acc[ai][bj][m][n] + bv[bj][n]; }
    }
};
template <class Epi, class Sched, bool STAMP = false>
__device__ __forceinline__ void gemm_phase(PG8_LAS unsigned char* lds, const Gemm g, const Sched& S, const Epi& E, unsigned long long* stamps) {
    int tid_ = threadIdx.x; asm volatile("" : "+v"(tid_));
    const int tid = tid_, wid = __builtin_amdgcn_readfirstlane(tid >> 6), lane = tid & 63, wr = wid >> 2, wc = wid & 3, fr = lane & 15, fq = lane >> 4;
    const int K = g.K, nt = K / BK;
    int ts_lo = 0, ts_hi = 0, nts = 0; const unsigned long long rt_entry = STAMP ? (unsigned long long)wall_clock64() : 0ull;
#define PG8_STAMP() do { if (STAMP && wid == 0 && nts < 64) { const unsigned long long _c = (unsigned long long)clock64(); \
        ts_lo = (lane == nts) ? (int)(unsigned)_c : ts_lo; ts_hi = (lane == nts) ? (int)(unsigned)(_c >> 32) : ts_hi; ++nts; } } while (0)
    PG8_STAMP();
    unsigned voffA[2], voffB[2];
#pragma unroll
    for (int i = 0; i < 2; ++i) { int R, C; stage_rc(tid * 16 + i * 8192, R, C); const int Rb = Epi::PERM ? ((R & ~31) + perm32(R & 31)) : R;
        voffA[i] = (unsigned)(R * K + C) * 2u; voffB[i] = (unsigned)(Rb * K + C) * 2u; }
    const size_t kstep = (size_t)(BK * 2);
    const size_t hstep = (size_t)HALF * K * 2;
    const size_t tstep = 2 * hstep;
    const unsigned ldsw = (unsigned)wid * 1024u;
    const int aoff = lds_byte(wr * 64 + fr, fq * 8), boff = lds_byte(wc * 32 + fr, fq * 8);
#define PG8_SA(b, h) (((b) * 2 + (h)) * HTB)
#define PG8_SB(b, h) ((4 + (b) * 2 + (h)) * HTB)
#define PG8_STAGE(bufoff, gbase, voff) do { _Pragma("unroll") for (int _i = 0; _i < 2; ++_i) \
        __builtin_amdgcn_global_load_lds((const unsigned*)((const char*)(gbase) + (voff)[_i]), (PG8_LAS unsigned*)(lds + (bufoff) + ldsw + _i * 8192), 16, 0, 0); } while (0)
#define PG8_LDA(dst, b, h) do { _Pragma("unroll") for (int m = 0; m < 4; ++m) _Pragma("unroll") for (int k = 0; k < 2; ++k) dst[m][k] = *(const PG8_LAS bf16x8*)(lds + PG8_SA(b, h) + aoff + m * 2048 + k * 1024); } while (0)
#define PG8_LDB(dst, b, h) do { _Pragma("unroll") for (int n = 0; n < 2; ++n) _Pragma("unroll") for (int k = 0; k < 2; ++k) dst[n][k] = *(const PG8_LAS bf16x8*)(lds + PG8_SB(b, h) + boff + n * 2048 + k * 1024); } while (0)
#define PG8_MMA(ai, bj, At, Bt) do { __builtin_amdgcn_s_setprio(1); _Pragma("unroll") for (int m = 0; m < 4; ++m) _Pragma("unroll") for (int n = 0; n < 2; ++n) _Pragma("unroll") for (int k = 0; k < 2; ++k) \
        acc[ai][bj][m][n] = __builtin_amdgcn_mfma_f32_16x16x32_bf16(Bt[n][k], At[m][k], acc[ai][bj][m][n], 0, 0, 0); __builtin_amdgcn_s_setprio(0); } while (0)
#define PG8_WAIT_V(n) asm volatile("s_waitcnt vmcnt(" #n ")" ::: "memory")
#define PG8_WAIT_L(n) asm volatile("s_waitcnt lgkmcnt(" #n ")" ::: "memory")
#define PG8_BAR __builtin_amdgcn_s_barrier()
#define PG8_SCHED __builtin_amdgcn_sched_barrier(0)
    Unit cur, nxt; int ui = 0;
    if (!S.next(0, cur)) return;
    f32x4 acc[2][2][4][2];
#pragma unroll
    for (int a = 0; a < 2; ++a)
#pragma unroll
        for (int b = 0; b < 2; ++b)
#pragma unroll
            for (int m = 0; m < 4; ++m)
#pragma unroll
                for (int n = 0; n < 2; ++n) acc[a][b][m][n] = (f32x4){0.f, 0.f, 0.f, 0.f};
    bf16x8 At[4][2], B0[2][2], B1[2][2];
    const char* cA = (const char*)g.A + (size_t)cur.pm * tstep; const char* cB = (const char*)g.Bt + (size_t)cur.pn * tstep;
    S.a_ready(cur);
    PG8_STAGE(PG8_SB(0, 0), cB, voffB); PG8_STAGE(PG8_SA(0, 0), cA, voffA); PG8_STAGE(PG8_SB(0, 1), cB + hstep, voffB); PG8_STAGE(PG8_SA(0, 1), cA + hstep, voffA);
    if (wr == 1) PG8_BAR;
    PG8_WAIT_V(4); PG8_BAR;
    PG8_STAGE(PG8_SB(1, 0), cB + kstep, voffB); PG8_STAGE(PG8_SA(1, 0), cA + kstep, voffA); PG8_STAGE(PG8_SB(1, 1), cB + hstep + kstep, voffB);
    PG8_WAIT_V(6); PG8_BAR;
    PG8_STAMP();
    for (;;) {
        const bool has_next = S.next(ui + 1, nxt);
        const char* nA = has_next ? (const char*)g.A + (size_t)nxt.pm * tstep : cA; const char* nB = has_next ? (const char*)g.Bt + (size_t)nxt.pn * tstep : cB;
        for (int t = 0; t < nt; t += 2) {
            const bool last = (t == nt - 2);
            const char* a1 = cA + (size_t)(t + 1) * kstep;
            const char* a2 = last ? nA : cA + (size_t)(t + 2) * kstep; const char* b2 = last ? nB : cB + (size_t)(t + 2) * kstep;
            const char* a3 = a2 + kstep; const char* b3 = b2 + kstep;
            if (last && has_next) S.a_ready(nxt);
            PG8_LDB(B0, 0, 0); PG8_SCHED; PG8_LDA(At, 0, 0); PG8_STAGE(PG8_SA(1, 1), a1 + hstep, voffA);
            PG8_WAIT_L(8); PG8_BAR; PG8_WAIT_L(0); PG8_MMA(0, 0, At, B0); PG8_BAR; PG8_SCHED;
            PG8_LDB(B1, 0, 1); PG8_STAGE(PG8_SB(0, 0), b2, voffB);
            PG8_BAR; PG8_WAIT_L(0); PG8_MMA(0, 1, At, B1); PG8_BAR;
            PG8_LDA(At, 0, 1); PG8_STAGE(PG8_SA(0, 0), a2, voffA);
            PG8_BAR; PG8_WAIT_L(0); PG8_MMA(1, 0, At, B0); PG8_BAR; PG8_SCHED;
            PG8_STAGE(PG8_SB(0, 1), b2 + hstep, voffB);
            PG8_WAIT_V(6); PG8_BAR; PG8_MMA(1, 1, At, B1); PG8_BAR;
            PG8_LDB(B0, 1, 0); PG8_SCHED; PG8_LDA(At, 1, 0); PG8_STAGE(PG8_SA(0, 1), a2 + hstep, voffA);
            PG8_WAIT_L(8); PG8_BAR; PG8_WAIT_L(0); PG8_MMA(0, 0, At, B0); PG8_BAR; PG8_SCHED;
            PG8_LDB(B1, 1, 1); PG8_STAGE(PG8_SB(1, 0), b3, voffB);
            PG8_BAR; PG8_WAIT_L(0); PG8_MMA(0, 1, At, B1); PG8_BAR;
            PG8_LDA(At, 1, 1); PG8_STAGE(PG8_SA(1, 0), a3, voffA);
            PG8_BAR; PG8_WAIT_L(0); PG8_MMA(1, 0, At, B0); PG8_BAR; PG8_SCHED;
            PG8_STAGE(PG8_SB(1, 1), b3 + hstep, voffB);
            PG8_WAIT_V(6); PG8_BAR; PG8_MMA(1, 1, At, B1); PG8_BAR;
        }
        PG8_STAMP();
        if constexpr (!Epi::AFTER_DRAIN) { E(acc, cur, wr, wc, fr, fq); S.done(cur); }
        PG8_STAMP();
        if (!has_next) break;
#pragma unroll
        for (int a = 0; a < 2; ++a)
#pragma unroll
            for (int b = 0; b < 2; ++b)
#pragma unroll
                for (int m = 0; m < 4; ++m)
#pragma unroll
                    for (int n = 0; n < 2; ++n) acc[a][b][m][n] = (f32x4){0.f, 0.f, 0.f, 0.f};
        cur = nxt; cA = nA; cB = nB; ++ui;
    }
    PG8_WAIT_V(0);
    if (wr == 0) PG8_BAR;
    PG8_BAR;
    if constexpr (Epi::AFTER_DRAIN) { E.fused(acc, cur, wr, wc, fr, fq, lds, wid, lane); S.done(cur); }
    PG8_STAMP();
    if (STAMP && wid == 0) { stamps[lane] = lane < nts ? (((unsigned long long)(unsigned)ts_hi << 32) | (unsigned)ts_lo) : 0ull;
        if (lane == 62) stamps[62] = rt_entry; if (lane == 63) stamps[63] = (unsigned long long)wall_clock64(); }
#undef PG8_STAMP
#undef PG8_SA
#undef PG8_SB
#undef PG8_STAGE
#undef PG8_LDA
#undef PG8_LDB
#undef PG8_MMA
#undef PG8_WAIT_V
#undef PG8_WAIT_L
#undef PG8_BAR
#undef PG8_SCHED
}
}

#define LAS __attribute__((address_space(3)))
typedef unsigned short bf16;
typedef float f32x4 __attribute__((ext_vector_type(4)));
typedef unsigned u32x4 __attribute__((ext_vector_type(4)));
typedef unsigned u32x2 __attribute__((ext_vector_type(2)));

constexpr int D = 1024, SEQ = 8192, NBP = 2, MP = NBP * SEQ;
constexpr int DB = 32, DSQ = 4, MS = DB * DSQ, MR = MP + MS;
constexpr int MPAD = 16640;
constexpr int PAST = 16384, PAGE = 128, NPG = 128;
constexpr int HD = 64, AW = 512, NH = 8, GQ = 4, NKV = 2;
constexpr int SW = 512, SG = 16, NSG = 32, SST = 64;
constexpr int INC = 1816, INP = 2048, O1 = 512, O2 = 1280, O3 = 1304;
constexpr int DFF = 2816;
constexpr int NC_P = 511, NC_S = 1023;
constexpr int CMP_ROWS_S = DB * 1024 * 2, CMP_ROWS_P = NBP * 512 * 2, CMP_ROWS = CMP_ROWS_S + CMP_ROWS_P;
constexpr int CMPO_S = DB * NC_S * 2 * 64, CMPO_P = NBP * NC_P * 2 * 64, CMPO = CMPO_S + CMPO_P;
constexpr float EPS = 1e-6f;
constexpr int SCH = 128, NCH = SEQ / SCH;

constexpr size_t O_YP = 0, O_YS = 16777216, O_KVC_P = 16908288, O_KVS_P = 21102592, O_KVW_P = 25296896, O_SRE_P = 25559040, O_SIM_P = 25563136,
                 O_KVC_S = 25567232, O_KVS_S = 25600000, O_KVW_S = 25632768, O_SRE_S = 25665536, O_SIM_S = 25731072, O_END = 25796608;

constexpr size_t A256(size_t x) { return (x + 255) & ~(size_t)255; }
constexpr size_t WS_CTL    = 0;
constexpr size_t WS_ADA    = (size_t)1 << 20;
constexpr size_t WS_LB     = WS_ADA + A256((size_t)34 * 6144 * 4);
constexpr size_t WS_BBR    = WS_LB + A256(2048 * 2 * 4);
constexpr size_t WS_BBI    = WS_BBR + A256(2048 * 16 * 4);
constexpr size_t WS_PEB    = WS_BBI + A256(2048 * 16 * 4);
constexpr size_t WS_WIN_T  = WS_PEB + A256(2 * 8 * 128 * 4);
constexpr size_t WS_WGLU_T = WS_WIN_T + (size_t)2048 * 1024 * 2;
constexpr size_t WS_WOUT_T = WS_WGLU_T + (size_t)512 * 512 * 2;
constexpr size_t WS_WUP_T  = WS_WOUT_T + (size_t)1024 * 1024 * 2;
constexpr size_t WS_WDN_T  = WS_WUP_T + (size_t)5632 * 1024 * 2;
constexpr size_t WS_WC1_T  = WS_WDN_T + (size_t)1024 * 2816 * 2;
constexpr size_t WS_H      = WS_WC1_T + (size_t)2 * 256 * 1024 * 2;
constexpr size_t WS_Z      = WS_H + (size_t)MPAD * 1024 * 2;
constexpr size_t WS_Q      = WS_Z + (size_t)MPAD * 2048 * 4;
constexpr size_t WS_KV3    = WS_Q + (size_t)MR * 512 * 4;
constexpr size_t WS_GATES  = WS_KV3 + (size_t)3 * MR * 256 * 4;
constexpr size_t WS_U      = WS_GATES + A256((size_t)MR * 24 * 4);
constexpr size_t WS_ACMP   = WS_U + (size_t)MR * 512 * 4;
constexpr size_t WS_PC     = WS_ACMP + (size_t)2 * CMP_ROWS * 1024 * 2;
constexpr size_t WS_CMPKV  = WS_PC + (size_t)2 * CMP_ROWS * 256 * 4;
constexpr size_t WS_E      = WS_CMPKV + A256((size_t)2 * CMPO * 4);
constexpr size_t WS_SF     = WS_E + (size_t)NBP * NSG * NCH * 64 * 2 * 4;
constexpr size_t WS_SB     = WS_SF + (size_t)MPAD * 512 * 4;
constexpr size_t WS_ATTN   = WS_SB + (size_t)MPAD * 512 * 2;
constexpr size_t WS_S2     = WS_ATTN + (size_t)MR * 512 * 4;
constexpr size_t WS_MIX    = WS_S2 + (size_t)MPAD * 512 * 4;
constexpr size_t WS_X1     = WS_MIX + (size_t)MPAD * 1024 * 2;
constexpr size_t WS_FF     = WS_X1 + (size_t)MPAD * 1024 * 4;
constexpr size_t WS_QB     = WS_FF + (size_t)MPAD * 2816 * 2;
constexpr size_t WS_KB     = WS_QB + (size_t)NBP * 2 * SEQ * 256 * 2;
constexpr size_t WS_VB     = WS_KB + (size_t)2 * NBP * 2 * SEQ * 64 * 2;
constexpr size_t WS_KCB    = WS_VB + (size_t)2 * NBP * 2 * SEQ * 64 * 2;
constexpr size_t WS_ROPE   = WS_KCB + (size_t)2 * NBP * 2 * 512 * 64 * 2;
constexpr size_t WS_END    = WS_ROPE + (size_t)SEQ * 16 * 4;

constexpr int LDS_BYTES = 150 * 1024;

struct P {
    const float *xp, *xs, *cache_c, *cache_s, *cache_w, *st_re, *st_im; const int* pt;
    const float *cp, *cs, *norm_mix_g, *w_ada, *b_ada, *w_in, *q_g, *k_g, *pe_k, *w1_k, *w2_k, *pe_v, *w1_v, *w2_v;
    const float *a_re, *a_im, *log_dt, *b_re, *b_im, *c_re, *c_im, *ssm_d, *w_glu, *b_glu, *attn_g, *ssm_g, *w_out, *norm_ffn_g, *w_gate, *w_up, *w_down;
    float* out; unsigned char* ws;
};

__device__ __forceinline__ int tid_now() { int t = threadIdx.x; asm volatile("" : "+v"(t)); return t; }
__device__ __forceinline__ unsigned pk2(float lo, float hi) { unsigned r; asm("v_cvt_pk_bf16_f32 %0, %1, %2" : "=v"(r) : "v"(lo), "v"(hi)); return r; }
__device__ __forceinline__ unsigned f2bf(float f) { return pk2(f, 0.f) & 0xffffu; }
template <int CTRL> __device__ __forceinline__ float dpp_mov(float v) { return __int_as_float(__builtin_amdgcn_update_dpp(0, __float_as_int(v), CTRL, 0xF, 0xF, true)); }
__device__ __forceinline__ float wave_sum(float v) {
    v += dpp_mov<0xB1>(v); v += dpp_mov<0x4E>(v); v += dpp_mov<0x141>(v); v += dpp_mov<0x140>(v);
    const float a = __int_as_float(__builtin_amdgcn_readlane(__float_as_int(v), 0)), b = __int_as_float(__builtin_amdgcn_readlane(__float_as_int(v), 16));
    const float c = __int_as_float(__builtin_amdgcn_readlane(__float_as_int(v), 32)), d = __int_as_float(__builtin_amdgcn_readlane(__float_as_int(v), 48));
    return (a + b) + (c + d);
}
__device__ __forceinline__ float wave_max(float v) {
    v = fmaxf(v, dpp_mov<0xB1>(v)); v = fmaxf(v, dpp_mov<0x4E>(v)); v = fmaxf(v, dpp_mov<0x141>(v)); v = fmaxf(v, dpp_mov<0x140>(v));
    const float a = __int_as_float(__builtin_amdgcn_readlane(__float_as_int(v), 0)), b = __int_as_float(__builtin_amdgcn_readlane(__float_as_int(v), 16));
    const float c = __int_as_float(__builtin_amdgcn_readlane(__float_as_int(v), 32)), d = __int_as_float(__builtin_amdgcn_readlane(__float_as_int(v), 48));
    return fmaxf(fmaxf(a, b), fmaxf(c, d));
}
__device__ __forceinline__ float rdlane(float v, int l) { return __int_as_float(__builtin_amdgcn_readlane(__float_as_int(v), l)); }
__device__ __forceinline__ float sigmoid_f(float x) { return 1.0f / (1.0f + expf(-x)); }
__device__ __forceinline__ float silu_f(float x) { return x / (1.0f + expf(-x)); }
__device__ __forceinline__ float gelu_tanh(float x) {
    const float y = 0.7978845608028654f * (x + 0.044715f * x * x * x);
    const float t = 1.0f - 2.0f / (expf(2.0f * y) + 1.0f);
    return 0.5f * x * (1.0f + t);
}
__device__ __forceinline__ void sincos_d(double x, double& s, double& c) {
    const double k = rint(x * 0.63661977236758134308);
    double y = fma(-k, 1.57079632679489655800e+00, x);
    y = fma(-k, 6.12323399573676603587e-17, y);
    const double y2 = y * y;
    double sp = 1.0 / 355687428096000.0;
    sp = fma(sp, y2, -1.0 / 1307674368000.0); sp = fma(sp, y2, 1.0 / 6227020800.0); sp = fma(sp, y2, -1.0 / 39916800.0); sp = fma(sp, y2, 1.0 / 362880.0);
    sp = fma(sp, y2, -1.0 / 5040.0); sp = fma(sp, y2, 1.0 / 120.0); sp = fma(sp, y2, -1.0 / 6.0); sp = fma(sp, y2, 1.0);
    const double sy = sp * y;
    double cp = 1.0 / 20922789888000.0;
    cp = fma(cp, y2, -1.0 / 87178291200.0); cp = fma(cp, y2, 1.0 / 479001600.0); cp = fma(cp, y2, -1.0 / 3628800.0); cp = fma(cp, y2, 1.0 / 40320.0);
    cp = fma(cp, y2, -1.0 / 720.0); cp = fma(cp, y2, 1.0 / 24.0); cp = fma(cp, y2, -0.5); cp = fma(cp, y2, 1.0);
    const double cy = cp;
    const int q = (int)((long long)k & 3);
    s = (q == 0) ? sy : (q == 1) ? cy : (q == 2) ? -sy : -cy;
    c = (q == 0) ? cy : (q == 1) ? -sy : (q == 2) ? -cy : sy;
}
__device__ __forceinline__ const float* xrow_ptr(const P& p, int r) { return r < MP ? p.xp + (size_t)r * D : p.xs + (size_t)(r - MP) * D; }
__device__ __forceinline__ int ada_row(int r) { return r < MP ? r / SEQ : 2 + (r - MP) / DSQ; }

__device__ __forceinline__ void transpose_item(const float* W, int ldw, int nvalid, bf16* WT, int ldt, int kb, int nb, int rowmode, int rowoff, LAS float* scr, int lane) {
    const int k0 = 64 * kb, n0 = 32 * nb;
    { float v[32]; const int nn = n0 + (lane & 31);
#pragma unroll
      for (int i = 0; i < 32; ++i) v[i] = nn < nvalid ? __builtin_nontemporal_load(W + (size_t)(k0 + 2 * i + (lane >> 5)) * ldw + nn) : 0.f;
#pragma unroll
      for (int i = 0; i < 32; ++i) scr[(2 * i + (lane >> 5)) * 33 + (lane & 31)] = v[i]; }
    asm volatile("s_waitcnt lgkmcnt(0)" ::: "memory");
    const int c = lane & 7;
#pragma unroll
    for (int j = 0; j < 4; ++j) { const int n = (lane >> 3) + 8 * j, nn = n0 + n; const LAS float* s = scr + (8 * c) * 33 + n;
        u32x4 o; o.x = pk2(s[0 * 33], s[1 * 33]); o.y = pk2(s[2 * 33], s[3 * 33]); o.z = pk2(s[4 * 33], s[5 * 33]); o.w = pk2(s[6 * 33], s[7 * 33]);
        if (nn < nvalid) { const int drow = rowmode ? ((nn >> 7) * 256 + rowoff + (nn & 127)) : (rowoff + nn);
            *(u32x4*)(WT + (size_t)drow * ldt + k0 + 8 * c) = o; } }
    asm volatile("s_waitcnt lgkmcnt(0)" ::: "memory");
}

constexpr int PREP_JOBS = 224;
__device__ __forceinline__ f32x4 peb_load(const float* PEB, int kv, int col) {
    f32x4 s = *(const f32x4*)(PEB + (kv * 8) * 128 + col);
#pragma unroll
    for (int q = 1; q < 8; ++q) s += *(const f32x4*)(PEB + (kv * 8 + q) * 128 + col);
    return s;
}
__device__ __forceinline__ void ph_prep(const P& p, LAS unsigned char* lds) {
    const int tid = tid_now(), lane = tid & 63, wave = tid >> 6;
    unsigned char* ws = p.ws;
    for (int job = blockIdx.x; job < PREP_JOBS; job += gridDim.x) {
        if (job < 192) {
            LAS float* cbuf = (LAS float*)lds;
            { f32x4 cv[17];
#pragma unroll
              for (int it = 0; it < 17; ++it) { const int i = tid + it * 512, r = i >> 8, k4 = i & 255;
                  const float* src = r < 2 ? p.cp + r * D : p.cs + (r - 2) * D; cv[it] = *(const f32x4*)(src + k4 * 4); }
#pragma unroll
              for (int it = 0; it < 17; ++it) { const int i = tid + it * 512; f32x4 v = cv[it];
                  v.x = silu_f(v.x); v.y = silu_f(v.y); v.z = silu_f(v.z); v.w = silu_f(v.w);
                  *(LAS f32x4*)(cbuf + i * 4) = v; } }
            __syncthreads();
            const int c0 = job * 32, col = lane & 31, kh = lane >> 5, kbase = wave * 128 + kh * 64;
            float acc[34];
#pragma unroll
            for (int r = 0; r < 34; ++r) acc[r] = 0.f;
            const float* ub = p.w_ada + (size_t)(__builtin_amdgcn_readfirstlane(wave) * 128) * 6144 + c0;
            const unsigned voff = (unsigned)(kh * 64 * 6144 + col) * 4u;
            LAS const float* cb0 = cbuf + kbase; asm volatile("" : "+v"(cb0));
            LAS const float* cb1 = cb0 + 16 * D; asm volatile("" : "+v"(cb1));
            LAS const float* cb2 = cb0 + 32 * D; asm volatile("" : "+v"(cb2));
#pragma unroll
            for (int hb = 0; hb < 2; ++hb) {
                float wv[32];
#pragma unroll
                for (int k = 0; k < 32; ++k) wv[k] = __builtin_nontemporal_load((const float*)((const char*)(ub + (size_t)(hb * 32 + k) * 6144) + voff));
                asm volatile("" ::: "memory");
#pragma unroll
                for (int k4 = 0; k4 < 8; ++k4) {
#pragma unroll
                    for (int r = 0; r < 34; ++r) { const f32x4 cv = *(const LAS f32x4*)((r < 16 ? cb0 + r * D : r < 32 ? cb1 + (r - 16) * D : cb2 + (r - 32) * D) + hb * 32 + k4 * 4);
                        acc[r] += cv.x * wv[4 * k4] + cv.y * wv[4 * k4 + 1] + cv.z * wv[4 * k4 + 2] + cv.w * wv[4 * k4 + 3]; }
                    asm volatile("" ::: "memory");
                }
            }
            __syncthreads();
            LAS float* red = (LAS float*)lds;
#pragma unroll
            for (int r = 0; r < 34; ++r) red[((wave * 2 + kh) * 34 + r) * 32 + col] = acc[r];
            __syncthreads();
            float* ADA = (float*)(ws + WS_ADA);
            for (int o = tid; o < 34 * 32; o += 512) { const int r = o >> 5, c = o & 31; float s = p.b_ada[c0 + c];
#pragma unroll
                for (int w = 0; w < 16; ++w) s += red[(w * 34 + r) * 32 + c];
                ADA[(size_t)r * 6144 + c0 + c] = s; }
            __syncthreads();
        } else if (job < 208) {
            const int kv = (job - 192) >> 3, part = (job - 192) & 7; const float* pe = kv ? p.pe_v : p.pe_k; const float* w1 = kv ? p.w1_v : p.w1_k;
            float a0 = 0.f, a1 = 0.f;
#pragma unroll 1
            for (int kb = 0; kb < 2; ++kb) { const int k0 = part * 256 + wave * 32 + kb * 16; float x0[16], x1[16], pv[16];
#pragma unroll
                for (int u = 0; u < 16; ++u) { pv[u] = pe[k0 + u]; x0[u] = w1[(size_t)(k0 + u) * 128 + lane]; x1[u] = w1[(size_t)(k0 + u) * 128 + 64 + lane]; }
#pragma unroll
                for (int u = 0; u < 16; ++u) { a0 += pv[u] * x0[u]; a1 += pv[u] * x1[u]; } }
            LAS float* red = (LAS float*)lds;
            red[wave * 128 + lane] = a0; red[wave * 128 + 64 + lane] = a1;
            __syncthreads();
            if (tid < 128) { float s = 0.f;
#pragma unroll
                for (int w = 0; w < 8; ++w) s += red[w * 128 + tid];
                ((float*)(ws + WS_PEB))[(kv * 8 + part) * 128 + tid] = s; }
            __syncthreads();
        } else {
            const int sj = job - 208;
            float* LB = (float*)(ws + WS_LB); float* BBR = (float*)(ws + WS_BBR); float* BBI = (float*)(ws + WS_BBI);
            LAS double* fb = (LAS double*)lds;
            if (tid < 128) { const int idx = sj * 128 + tid, g = idx >> 6;
                const double dt = exp((double)p.log_dt[g]), are = (double)p.a_re[idx], aim = (double)p.a_im[idx];
                const double mag = exp(are * dt); double sn, cs; sincos_d(aim * dt, sn, cs);
                const double lbr = mag * cs, lbi = mag * sn, den = are * are + aim * aim, nre = lbr - 1.0;
                LB[idx * 2] = (float)lbr; LB[idx * 2 + 1] = (float)lbi;
                fb[tid * 2] = (nre * are + lbi * aim) / den; fb[tid * 2 + 1] = (lbi * are - nre * aim) / den; }
            __syncthreads();
#pragma unroll
            for (int it = 0; it < 4; ++it) { const int e = tid + it * 512, il = e >> 4, o = sj * 128 * SG + e;
                const double fre = fb[il * 2], fim = fb[il * 2 + 1], br = (double)p.b_re[o], bi = (double)p.b_im[o];
                BBR[o] = (float)(fre * br - fim * bi); BBI[o] = (float)(fre * bi + fim * br); }
            __syncthreads();
        }
    }
    __syncthreads();
    { float* ROPE = (float*)(ws + WS_ROPE);
      for (int idx = blockIdx.x * 512 + tid; idx < SEQ * 8; idx += gridDim.x * 512) { const int pos = idx >> 3, i = idx & 7;
          const double inv = exp(-(double)i * 1.640295422175541); double sd, cd; sincos_d((double)pos * inv, sd, cd);
          ROPE[pos * 16 + i] = (float)cd; ROPE[pos * 16 + 8 + i] = (float)sd; } }
    LAS float* scr = (LAS float*)(lds + wave * 8448);
    constexpr int I0 = 16 * 57, I1 = 8 * 16, I6 = 16 * 4;
    constexpr int NT = I0 + I1 + 4 * I6;
    const int it0 = (int)blockIdx.x * 8 + wave, step = (int)gridDim.x * 8, lim = NT;
    for (int it = it0; it < lim; it += step) {
        int r = it;
        if (r < I0) { transpose_item(p.w_in, INC, INC, (bf16*)(ws + WS_WIN_T), 1024, r / 57, r % 57, 0, 0, scr, lane); continue; } r -= I0;
        if (r < I1) { transpose_item(p.w_glu, 512, 512, (bf16*)(ws + WS_WGLU_T), 512, r / 16, r % 16, 0, 0, scr, lane); continue; } r -= I1;
        { const int m = r / I6, rr = r % I6, kv = m >> 1, half = m & 1; const float* w1 = kv ? p.w1_v : p.w1_k;
          transpose_item(w1 + (size_t)half * 1024 * 128, 128, 128, (bf16*)(ws + WS_WC1_T) + (size_t)kv * 256 * 1024, 1024, rr / 4, rr % 4, 0, half * 128, scr, lane); }
    }
}
__device__ __forceinline__ void ph_late_transposes(const P& p, LAS unsigned char* lds, int wg_lo, int wg_hi) {
    const int tid = tid_now(), lane = tid & 63, wave = tid >> 6;
    if ((int)blockIdx.x < wg_lo || (int)blockIdx.x >= wg_hi) return;
    unsigned char* ws = p.ws;
    LAS float* scr = (LAS float*)(lds + wave * 8448);
    constexpr int I2 = 16 * 32, I3 = 16 * 88, I5 = 44 * 32;
    constexpr int NT = I2 + 2 * I3 + I5;
    for (int it = ((int)blockIdx.x - wg_lo) * 8 + wave; it < NT; it += (wg_hi - wg_lo) * 8) {
        int r = it;
        if (r < I2) { transpose_item(p.w_out, 1024, 1024, (bf16*)(ws + WS_WOUT_T), 1024, r / 32, r % 32, 0, 0, scr, lane); continue; } r -= I2;
        if (r < I3) { transpose_item(p.w_gate, DFF, DFF, (bf16*)(ws + WS_WUP_T), 1024, r / 88, r % 88, 1, 0, scr, lane); continue; } r -= I3;
        if (r < I3) { transpose_item(p.w_up, DFF, DFF, (bf16*)(ws + WS_WUP_T), 1024, r / 88, r % 88, 1, 128, scr, lane); continue; } r -= I3;
        transpose_item(p.w_down, 1024, 1024, (bf16*)(ws + WS_WDN_T), DFF, r / 32, r % 32, 0, 0, scr, lane);
    }
}

template <int WHICH>
__device__ __forceinline__ void ph_normmod(const P& p) {
    const int tid = tid_now(), lane = tid & 63, wave = tid >> 6, gw = blockIdx.x * 8 + wave, NGW = gridDim.x * 8;
    const float* ADA = (const float*)(p.ws + WS_ADA); const float* gain = WHICH ? p.norm_ffn_g : p.norm_mix_g;
    bf16* H = (bf16*)(p.ws + WS_H);
    int cur = -1; f32x4 mul[4], add[4];
#pragma unroll
    for (int j = 0; j < 4; ++j) { mul[j] = (f32x4){0.f, 0.f, 0.f, 0.f}; add[j] = mul[j]; }
    for (int r0 = gw; r0 < MR; r0 += 4 * NGW) {
        f32x4 v[4][4];
#pragma unroll
        for (int i = 0; i < 4; ++i) { const int r = r0 + i * NGW < MR ? r0 + i * NGW : r0;
            const float* src = WHICH ? (const float*)(p.ws + WS_X1) + (size_t)r * D : xrow_ptr(p, r);
#pragma unroll
            for (int j = 0; j < 4; ++j) { if (WHICH == 0) v[i][j] = __builtin_nontemporal_load((const f32x4*)(src + 4 * (lane + 64 * j))); else v[i][j] = *(const f32x4*)(src + 4 * (lane + 64 * j)); } }
#pragma unroll
        for (int i = 0; i < 4; ++i) { const int r = r0 + i * NGW; if (r >= MR) break;
            const int arow = ada_row(r);
            if (arow != cur) { cur = arow; const float* ar = ADA + (size_t)arow * 6144; const float* sh = ar + (WHICH ? 3 : 0) * D; const float* sc = ar + (WHICH ? 4 : 1) * D;
#pragma unroll
                for (int j = 0; j < 4; ++j) { const int c = 4 * (lane + 64 * j); const f32x4 g = *(const f32x4*)(gain + c), s1 = *(const f32x4*)(sc + c); mul[j] = g * (s1 + 1.0f); add[j] = *(const f32x4*)(sh + c); } }
            float ss = 0.f;
#pragma unroll
            for (int j = 0; j < 4; ++j) ss += (v[i][j].x * v[i][j].x + v[i][j].y * v[i][j].y) + (v[i][j].z * v[i][j].z + v[i][j].w * v[i][j].w);
            const float rstd = 1.0f / sqrtf(wave_sum(ss) * (1.0f / D) + EPS);
#pragma unroll
            for (int j = 0; j < 4; ++j) { const int c = 4 * (lane + 64 * j);
                const f32x4 y = (v[i][j] * rstd) * mul[j] + add[j];
                u32x2 o; o.x = pk2(y.x, y.y); o.y = pk2(y.z, y.w);
                *(u32x2*)(H + (size_t)r * D + c) = o; } }
    }
}

__device__ __forceinline__ void ph_split(const P& p, LAS unsigned char* lds) {
    const int tid = tid_now(), lane = tid & 63, wave = tid >> 6, gw = blockIdx.x * 8 + wave, NGW = gridDim.x * 8;
    LAS float* zrow = (LAS float*)(lds + wave * 7424);
    const float* Z = (const float*)(p.ws + WS_Z); float* Q = (float*)(p.ws + WS_Q); float* KV3 = (float*)(p.ws + WS_KV3);
    float* GATES = (float*)(p.ws + WS_GATES); float* U = (float*)(p.ws + WS_U);
    bf16* QB = (bf16*)(p.ws + WS_QB); bf16* KB = (bf16*)(p.ws + WS_KB); bf16* VB = (bf16*)(p.ws + WS_VB);
    const float qg = p.q_g[lane];
    for (int tk = gw; tk < 4 * (MR - MP); tk += NGW) {
        const int r = MP + (tk >> 2), q4 = tk & 3;
        const float* zr = Z + (size_t)r * INP;
        for (int i = lane; i < INC / 4; i += 64) *(LAS f32x4*)(zrow + 4 * i) = *(const f32x4*)(zr + 4 * i);
        const int pos = r < MP ? (r % SEQ) : PAST + ((r - MP) % DSQ);
        float cs, sn;
        { const double inv = exp(-(double)(lane & 7) * 1.640295422175541); double sd, cd; sincos_d((double)pos * inv, sd, cd); cs = (float)cd; sn = (float)sd; }
        float *oc, *os, *ow;
        if (r < MP) { const int b = r / SEQ, t = r % SEQ; oc = p.out + O_KVC_P + (size_t)r * 256; os = p.out + O_KVS_P + (size_t)r * 256;
            ow = t >= SEQ - 512 ? p.out + O_KVW_P + (size_t)(b * 512 + t - (SEQ - 512)) * 256 : nullptr; }
        else { const int s = r - MP; oc = p.out + O_KVC_S + (size_t)s * 256; os = p.out + O_KVS_S + (size_t)s * 256; ow = p.out + O_KVW_S + (size_t)s * 256; }
        asm volatile("s_waitcnt lgkmcnt(0)" ::: "memory");
        for (int hh = q4; hh < 14; hh += 4) {
            int off; float gain;
            if (hh < 8) { off = hh * 64; gain = qg; }
            else { const int kk = hh - 8, br = kk >> 1, g = kk & 1; off = O1 + br * 256 + g * 64; gain = p.k_g[br * 64 + lane]; }
            const float v = zrow[off + lane];
            const float ss = wave_sum(v * v);
            float y = v * (1.0f / sqrtf(ss * (1.0f / 64.0f) + EPS)) * gain;
            const float pr = __shfl_xor(y, 8);
            if (lane < 8) y = y * cs - pr * sn; else if (lane < 16) y = pr * sn + y * cs;
            if (hh < 8) { if (r >= MP) Q[(size_t)r * AW + hh * 64 + lane] = y;
                if (r < MP) QB[((size_t)((r / SEQ) * 2 + (hh >> 2)) * SEQ + (r % SEQ)) * 256 + (hh & 3) * 64 + lane] = (bf16)f2bf(y * (0.125f * 1.4426950408889634f)); }
            else { const int kk = hh - 8, br = kk >> 1, g = kk & 1;
                if (r >= MP) KV3[((size_t)br * MR + r) * 256 + g * 64 + lane] = y;
                if (r < MP && br > 0) KB[((size_t)(((br - 1) * NBP + r / SEQ) * 2 + g) * SEQ + (r % SEQ)) * 64 + lane] = (bf16)f2bf(y);
                float* o = br == 0 ? oc : br == 1 ? os : ow; if (o) o[g * 64 + lane] = y; }
        }
#pragma unroll
        for (int br = 0; br < 3; ++br)
#pragma unroll
            for (int g = 0; g < 2; ++g) { if (((br * 2 + g) & 3) != q4) continue; const float v = zrow[O1 + br * 256 + 128 + g * 64 + lane];
                if (r >= MP) KV3[((size_t)br * MR + r) * 256 + 128 + g * 64 + lane] = v;
                if (r < MP && br > 0) VB[((size_t)(((br - 1) * NBP + r / SEQ) * 2 + g) * SEQ + (r % SEQ)) * 64 + lane] = (bf16)f2bf(v);
                float* o = br == 0 ? oc : br == 1 ? os : ow; if (o) o[128 + g * 64 + lane] = v; }
        if (q4 == 1 && lane < 24) GATES[(size_t)r * 24 + lane] = sigmoid_f(zrow[O2 + lane]);
        if (q4 == 3) for (int i = lane; i < SW / 4; i += 64) *(f32x4*)(U + (size_t)r * SW + 4 * i) = *(const LAS f32x4*)(zrow + O3 + 4 * i);
        asm volatile("s_waitcnt lgkmcnt(0)" ::: "memory");
    }
}

template <int PART> __device__ __forceinline__ void ph_cmp_build(const P& p) {
    const int tid = tid_now(), lane = tid & 63, wave = tid >> 6, gw = blockIdx.x * 8 + wave, NGW = gridDim.x * 8;
    bf16* A = (bf16*)(p.ws + WS_ACMP); const float* KVC = (const float*)(p.ws + WS_KV3);
    const int seg = lane >> 4, kvi = seg >> 1, g = seg & 1, d4 = (lane & 15) * 4;
    constexpr int NIS = DB * PAST / 64, NIP = MP / 64, NI = NIS + NIP;
    for (int it = (PART ? NIS : 0) + gw; it < (PART ? NI : NIS); it += NGW) {
        const float* src; size_t arow0;
        if (it < NIS) { const int b = it / (PAST / 64), h64 = it % (PAST / 64), t0 = h64 * 64; const int page = p.pt[b * NPG + t0 / PAGE];
            src = p.cache_c + ((size_t)page * PAGE + (t0 % PAGE)) * 256; arow0 = (size_t)(b * 1024 + t0 / 16) * 2; }
        else { const int r0 = (it - NIS) * 64, b = r0 / SEQ, t0 = r0 % SEQ; src = KVC + (size_t)r0 * 256; arow0 = (size_t)CMP_ROWS_S + (size_t)(b * 512 + t0 / 16) * 2; }
#pragma unroll 1
        for (int c = 0; c < 4; ++c) {
            f32x4 v[16];
#pragma unroll
            for (int tok = 0; tok < 16; ++tok) v[tok] = *(const f32x4*)(src + (size_t)(c * 16 + tok) * 256 + 4 * lane);
            bf16* dst = A + ((size_t)kvi * CMP_ROWS + arow0 + 2 * c + g) * 1024 + d4;
#pragma unroll
            for (int tok = 0; tok < 16; ++tok) { u32x2 o; o.x = pk2(v[tok].x, v[tok].y); o.y = pk2(v[tok].z, v[tok].w); *(u32x2*)(dst + tok * 64) = o; }
        }
    }
}

__device__ __forceinline__ void ph_cmp_out(const P& p, LAS unsigned char* lds) {
    const int tid = tid_now(), lane = tid & 63, wave = tid >> 6, gw = blockIdx.x * 8 + wave, NGW = gridDim.x * 8;
    LAS float* w2s = (LAS float*)lds;
    for (int i = tid; i < 2 * 128 * 64; i += 512) w2s[i] = i < 8192 ? p.w2_k[i] : p.w2_v[i - 8192];
    __syncthreads();
    const float* PC = (const float*)(p.ws + WS_PC); const float* PEB = (const float*)(p.ws + WS_PEB); float* CK = (float*)(p.ws + WS_CMPKV);
    bf16* KCB = (bf16*)(p.ws + WS_KCB);
    constexpr int NOS = DB * NC_S * 2, NOP = NBP * NC_P * 2, NO = NOS + NOP;
    auto srcrow = [&](int it, int& kv, int& o, size_t& dst) -> const float* {
        kv = it / NO; o = it % NO; size_t ra;
        if (o < NOS) { const int b = o / (NC_S * 2), rem = o % (NC_S * 2), i = rem >> 1, g = rem & 1; ra = (size_t)(b * 1024 + i) * 2 + g; dst = (size_t)o * 64; }
        else { const int o2 = o - NOS, b = o2 / (NC_P * 2), rem = o2 % (NC_P * 2), i = rem >> 1, g = rem & 1; ra = (size_t)CMP_ROWS_S + (size_t)(b * 512 + i) * 2 + g; dst = (size_t)CMPO_S + (size_t)o2 * 64; }
        return PC + ((size_t)kv * CMP_ROWS + ra) * 256; };
    float x0 = 0.f, x1 = 0.f, x2 = 0.f, x3 = 0.f;
    if (gw < 2 * NO) { int kv, o; size_t dst; const float* pa = srcrow(gw, kv, o, dst); x0 = pa[lane]; x1 = pa[512 + 128 + lane]; x2 = pa[64 + lane]; x3 = pa[512 + 192 + lane]; }
    for (int it = gw; it < 2 * NO; it += NGW) {
        int kv, o; size_t dst; (void)srcrow(it, kv, o, dst);
        const float h0 = gelu_tanh(x0 + x1 + PEB[kv * 128 + lane]);
        const float h1 = gelu_tanh(x2 + x3 + PEB[kv * 128 + 64 + lane]);
        if (it + NGW < 2 * NO) { int kv2, o2; size_t d2; const float* pa = srcrow(it + NGW, kv2, o2, d2); x0 = pa[lane]; x1 = pa[512 + 128 + lane]; x2 = pa[64 + lane]; x3 = pa[512 + 192 + lane]; }
        const LAS float* w2 = w2s + kv * 8192;
        float acc0 = 0.f, acc1 = 0.f;
#pragma unroll 8
        for (int n = 0; n < 64; ++n) { acc0 += rdlane(h0, n) * w2[n * 64 + lane]; acc1 += rdlane(h1, n) * w2[(64 + n) * 64 + lane]; }
        const float acc = acc0 + acc1;
        CK[(size_t)kv * CMPO + dst + lane] = acc;
        if (o >= NOS) { const int o2 = o - NOS, b = o2 / (NC_P * 2), rem = o2 % (NC_P * 2), i = rem >> 1, g = rem & 1;
            KCB[((size_t)((kv * NBP + b) * 2 + g) * 512 + i) * 64 + lane] = (bf16)f2bf(acc);
            if (i == 0) KCB[((size_t)((kv * NBP + b) * 2 + g) * 512 + 511) * 64 + lane] = (bf16)0; }
    }
}
#define XB_TMO      128
#define XB_XCNT(j)  (256  + 64 * (j))
#define XB_XSUB(j)  (1280 + 64 * (j))
#define XB_XGEN(j)  (2304 + 64 * (j))
#define XB_TOP      3328
#define XB_TOPGEN   3392
#define XCD_BAR_WORDS 3456
#define XB_SPIN_CAP (1u << 21)
__device__ __forceinline__ unsigned xb_ld(unsigned* p)              { return __hip_atomic_load(p, __ATOMIC_RELAXED, __HIP_MEMORY_SCOPE_AGENT); }
__device__ __forceinline__ unsigned xb_add(unsigned* p, unsigned v) { return __hip_atomic_fetch_add(p, v, __ATOMIC_RELAXED, __HIP_MEMORY_SCOPE_AGENT); }
__device__ __forceinline__ unsigned xb_xcc_id() { return (unsigned)__builtin_amdgcn_s_getreg((3 << 11) | 20) & 0xFu; }
#define XB_SPIN(cond, bar) do { unsigned _sp = 0; while (cond) { __builtin_amdgcn_s_sleep(1); \
    if ((++_sp & 255u) == 0u) { if (xb_ld(&(bar)[XB_TMO])) break; if (_sp > XB_SPIN_CAP) { atomicAdd(&(bar)[XB_TMO], 1u); break; } } } } while (0)

struct XcdBarrier {
    unsigned* bar; unsigned x;
    volatile LAS unsigned* st;
};

__device__ __forceinline__ XcdBarrier xcd_barrier_post(unsigned* bar, volatile LAS unsigned* st) {
    XcdBarrier b; b.bar = bar; b.x = xb_xcc_id(); b.st = st;
    if (threadIdx.x == 0) (void)xb_add(&bar[XB_XCNT(b.x)], 1u);
    return b;
}
__device__ __forceinline__ void xcd_barrier_complete(unsigned* bar, unsigned x, unsigned& nloc, unsigned& nx) {
    const unsigned G = gridDim.x * gridDim.y * gridDim.z;
    unsigned sum, cnt, mine, sp = 0u;
    for (;;) {
        sum = 0u; cnt = 0u; mine = 0u;
#pragma unroll
        for (unsigned j = 0; j < 16; ++j) { const unsigned c = xb_ld(&bar[XB_XCNT(j)]); sum += c; cnt += (c > 0u) ? 1u : 0u; mine = (j == x) ? c : mine; }
        if (sum == G) break;
        __builtin_amdgcn_s_sleep(1);
        if ((++sp & 255u) == 0u) { if (xb_ld(&bar[XB_TMO])) break; if (sp > XB_SPIN_CAP) { atomicAdd(&bar[XB_TMO], 1u); break; } }
    }
    nloc = mine > 0u ? mine : 1u; nx = cnt > 0u ? cnt : 1u;
}

__device__ __forceinline__ void xcd_barrier(const XcdBarrier& b) {
    asm volatile("s_waitcnt vmcnt(0)" ::: "memory");
    __syncthreads();
    if (threadIdx.x == 0) {
        unsigned* bar = b.bar;
        __builtin_amdgcn_s_waitcnt(0);
        unsigned nloc = b.st[0], nx = b.st[1];
        if (nloc == 0u) { xcd_barrier_complete(bar, b.x, nloc, nx); b.st[0] = nloc; b.st[1] = nx; }
        const unsigned old = xb_add(&bar[XB_XSUB(b.x)], 1u);
        const unsigned gen = old / nloc;
        if (old + 1u == (gen + 1u) * nloc) {
            __builtin_amdgcn_fence(__ATOMIC_RELEASE, "agent");
            asm volatile("s_waitcnt vmcnt(0)" ::: "memory");
            const unsigned og = xb_add(&bar[XB_TOP], 1u);
            const unsigned tg = og / nx;
            if (og + 1u == (tg + 1u) * nx) xb_add(&bar[XB_TOPGEN], 1u);
            else XB_SPIN(xb_ld(&bar[XB_TOPGEN]) == tg, bar);
            __builtin_amdgcn_fence(__ATOMIC_ACQUIRE, "agent");
            xb_add(&bar[XB_XGEN(b.x)], 1u);
            asm volatile("s_waitcnt vmcnt(0)" ::: "memory");
        } else {
            XB_SPIN(xb_ld(&bar[XB_XGEN(b.x)]) == gen, bar);
            __builtin_amdgcn_fence(__ATOMIC_ACQUIRE, "agent");
            asm volatile("s_waitcnt vmcnt(0)" ::: "memory");
        }
    }
    __syncthreads();
}

typedef short bf16x8 __attribute__((ext_vector_type(8)));
#define MFMA16(a, b, c) __builtin_amdgcn_mfma_f32_16x16x32_bf16(a, b, c, 0, 0, 0)
__device__ __forceinline__ unsigned cvtpk_bf16(float lo, float hi) { unsigned r; asm("v_cvt_pk_bf16_f32 %0, %1, %2" : "=v"(r) : "v"(lo), "v"(hi)); return r; }
__device__ __forceinline__ void split8(const f32x4& x0, const f32x4& x1, bf16x8& hi, bf16x8& lo) {
    u32x4 h, l;
    h.x = cvtpk_bf16(x0.x, x0.y); h.y = cvtpk_bf16(x0.z, x0.w); h.z = cvtpk_bf16(x1.x, x1.y); h.w = cvtpk_bf16(x1.z, x1.w);
    l.x = cvtpk_bf16(x0.x - __uint_as_float(h.x << 16), x0.y - __uint_as_float(h.x & 0xffff0000u)); l.y = cvtpk_bf16(x0.z - __uint_as_float(h.y << 16), x0.w - __uint_as_float(h.y & 0xffff0000u));
    l.z = cvtpk_bf16(x1.x - __uint_as_float(h.z << 16), x1.y - __uint_as_float(h.z & 0xffff0000u)); l.w = cvtpk_bf16(x1.z - __uint_as_float(h.w << 16), x1.w - __uint_as_float(h.w & 0xffff0000u));
    hi = __builtin_bit_cast(bf16x8, h); lo = __builtin_bit_cast(bf16x8, l);
}
template <int PASS>
__device__ __forceinline__ void ph_ssm(const P& p, LAS unsigned char* lds, int wg_lo, int wg_hi, int vlo, int vhi, int vsplit, int vshift) {
    const int tid = tid_now(), lane = tid & 63, wave = tid >> 6, gw = ((int)blockIdx.x - wg_lo) * 8 + wave, NGW = (wg_hi - wg_lo) * 8;
    const float* LB = (const float*)(p.ws + WS_LB); const float* BBR = (const float*)(p.ws + WS_BBR); const float* BBI = (const float*)(p.ws + WS_BBI);
    const float* U = (const float*)(p.ws + WS_U); float* E = (float*)(p.ws + WS_E);
    float* SF = (float*)(p.ws + WS_SF); bf16* SB = (bf16*)(p.ws + WS_SB);
    LAS float* bu = (LAS float*)(lds + wave * 17920);
    LAS float* hb = bu + 16 * 132;
    LAS float* ubuf = hb + 16 * 132;
    constexpr int NIT_P = NBP * NSG * NCH, NIT = PASS == 1 ? NIT_P : NIT_P + DB * NSG;
    const int l15 = lane & 15, lq = lane >> 4, ih = 8 * (lq & 1);
    for (int vit = vlo + gw; vit < vhi; vit += NGW) {
        const int it = vit >= vsplit ? vit + vshift : vit;
        if (it >= NIT) break;
        int b, g, c, r0, ntok; const bool prompt = it < NIT_P;
        if (prompt) { c = it % NCH; g = (it / NCH) % NSG; b = it / (NCH * NSG); r0 = b * SEQ + c * SCH; ntok = SCH; }
        else { const int i2 = it - NIT_P; c = 0; g = i2 % NSG; b = i2 / NSG; r0 = MP + b * DSQ; ntok = DSQ; }
        const int sp = g * SST + lane;
        bf16x8 b1[8], b2[8];
#pragma unroll
        for (int ct = 0; ct < 8; ++ct) { const int n = 16 * ct + l15; const float* src = (ct < 4 ? BBR : BBI) + (size_t)(g * SST + (n & 63)) * SG + ih;
            bf16x8 lo; split8(*(const f32x4*)src, *(const f32x4*)(src + 4), b1[ct], lo); b2[ct] = lane < 32 ? lo : (bf16x8){0, 0, 0, 0, 0, 0, 0, 0}; }
        const float lbr = LB[sp * 2], lbi = LB[sp * 2 + 1];
        float hr = 0.f, hi = 0.f;
        if (PASS == 2) {
            if (prompt) {
                float tr = lbr, ti = lbi;
#pragma unroll
                for (int q = 0; q < 7; ++q) { const float nr = tr * tr - ti * ti, ni = 2.0f * tr * ti; tr = nr; ti = ni; }
                const float* e = E + ((size_t)((b * NSG + g) * NCH) * 64 + lane) * 2;
                for (int c0 = 0; c0 < c; c0 += 16) { float er[16], ei[16];
#pragma unroll
                    for (int u = 0; u < 16; ++u) { const int cc = c0 + u < c ? c0 + u : c - 1; er[u] = e[(size_t)cc * 128]; ei[u] = e[(size_t)cc * 128 + 1]; }
#pragma unroll
                    for (int u = 0; u < 16; ++u) if (c0 + u < c) { const float nr = tr * hr - ti * hi + er[u], ni = tr * hi + ti * hr + ei[u]; hr = nr; hi = ni; } }
            } else { hr = p.st_re[(b * NSG + g) * SST + lane]; hi = p.st_im[(b * NSG + g) * SST + lane]; }
        }
        bf16x8 ch[4], cl[4];
        f32x4 dv = (f32x4){0.f, 0.f, 0.f, 0.f};
        if (PASS == 2) {
#pragma unroll
            for (int ks = 0; ks < 4; ++ks) { const float* src = (ks < 2 ? p.c_re : p.c_im) + (size_t)(g * SG + l15) * SST + (32 * ks + 8 * lq) % 64;
                f32x4 x0 = *(const f32x4*)src, x1 = *(const f32x4*)(src + 4);
                if (ks >= 2) { x0 = -x0; x1 = -x1; }
                split8(x0, x1, ch[ks], cl[ks]); }
            dv[0] = p.ssm_d[g * SG + l15];
        }
        const int nsb = (ntok + 15) >> 4;
        for (int sb = 0; sb < nsb; ++sb) {
            const int nt = ntok - sb * 16 < 16 ? ntok - sb * 16 : 16;
            bf16x8 ua;
            { const int tl = l15 < nt ? l15 : 0; const float* up = U + (size_t)(r0 + sb * 16 + tl) * SW + g * SG + ih;
              const f32x4 x0 = *(const f32x4*)up, x1 = *(const f32x4*)(up + 4);
              bf16x8 uh, ul; split8(x0, x1, uh, ul); ua = lane < 32 ? uh : ul;
              if (PASS == 2 && lane < 32) { *(LAS f32x4*)(ubuf + l15 * 16 + ih) = x0; *(LAS f32x4*)(ubuf + l15 * 16 + ih + 4) = x1; } }
#pragma unroll
            for (int ct = 0; ct < 8; ++ct) { f32x4 d = (f32x4){0.f, 0.f, 0.f, 0.f}; d = MFMA16(ua, b1[ct], d); d = MFMA16(ua, b2[ct], d);
#pragma unroll
                for (int rg = 0; rg < 4; ++rg) bu[(4 * lq + rg) * 132 + 16 * ct + l15] = d[rg]; }
            asm volatile("s_waitcnt lgkmcnt(0)" ::: "memory");
            if (nt == 16) {
                float br[16], bi[16];
#pragma unroll
                for (int tt = 0; tt < 16; ++tt) { br[tt] = bu[tt * 132 + lane]; bi[tt] = bu[tt * 132 + 64 + lane]; }
#pragma unroll
                for (int tt = 0; tt < 16; ++tt) {
                    const float nr = lbr * hr - lbi * hi + br[tt], ni = lbr * hi + lbi * hr + bi[tt];
                    hr = nr; hi = ni;
                    if (PASS == 2) { hb[tt * 132 + lane] = hr; hb[tt * 132 + 64 + lane] = hi; }
                }
            } else
            for (int tt = 0; tt < nt; ++tt) {
                const float br = bu[tt * 132 + lane], bi = bu[tt * 132 + 64 + lane];
                const float nr = lbr * hr - lbi * hi + br, ni = lbr * hi + lbi * hr + bi;
                hr = nr; hi = ni;
                if (PASS == 2) { hb[tt * 132 + lane] = hr; hb[tt * 132 + 64 + lane] = hi; }
            }
            if (PASS == 2) {
                asm volatile("s_waitcnt lgkmcnt(0)" ::: "memory");
                f32x4 y = (f32x4){0.f, 0.f, 0.f, 0.f};
#pragma unroll
                for (int ks = 0; ks < 4; ++ks) { const LAS float* hp = hb + l15 * 132 + 32 * ks + 8 * lq;
                    const f32x4 h0 = *(const LAS f32x4*)hp, h1 = *(const LAS f32x4*)(hp + 4); bf16x8 ah, al; split8(h0, h1, ah, al);
                    y = MFMA16(ah, ch[ks], y); y = MFMA16(al, ch[ks], y); y = MFMA16(ah, cl[ks], y); }
#pragma unroll
                for (int rg = 0; rg < 4; ++rg) { const int tt = 4 * lq + rg;
                    if (tt < nt) { const int r = r0 + sb * 16 + tt; const float uv = ubuf[tt * 16 + l15];
                        const float s = gelu_tanh(y[rg] + dv[0] * uv);
                        SF[(size_t)r * SW + g * SG + l15] = s; SB[(size_t)r * SW + g * SG + l15] = (bf16)f2bf(s); } }
                asm volatile("s_waitcnt lgkmcnt(0)" ::: "memory");
            }
        }
        if (PASS == 1) { float* e = E + ((size_t)((b * NSG + g) * NCH + c) * 64 + lane) * 2; e[0] = hr; e[1] = hi; }
        else if (prompt) { if (c == NCH - 1) { p.out[O_SRE_P + (b * NSG + g) * SST + lane] = hr; p.out[O_SIM_P + (b * NSG + g) * SST + lane] = hi; } }
        else { p.out[O_SRE_S + (b * NSG + g) * SST + lane] = hr; p.out[O_SIM_S + (b * NSG + g) * SST + lane] = hi; }
    }
}

constexpr float NEGM = -1e30f;
constexpr int SA_TILE = 0;
constexpr int SA_MO = 8 * 16640;
constexpr int SA_ML = SA_MO + 8192;
constexpr int SA_PS = SA_ML + 256;
constexpr int SA_IMP = SA_PS + 1088 * 4;
constexpr int SA_SEL = SA_IMP + 320 * 4;
__device__ __forceinline__ void att_stage(const float* kp, int stride, int klo, int khi, LAS float* tile, int lane) {
#pragma unroll 1
    for (int u0 = 0; u0 < 64; u0 += 32) { float v[32];
#pragma unroll
        for (int u = 0; u < 32; ++u) v[u] = (u0 + u >= klo && u0 + u < khi) ? __builtin_nontemporal_load(kp + (ptrdiff_t)(u0 + u) * stride + lane) : 0.f;
#pragma unroll
        for (int u = 0; u < 32; ++u) tile[(u0 + u) * 65 + lane] = v[u]; }
}
__device__ __forceinline__ void att_qk(LAS float* tile, int lane, const float (&q)[4], float (&s)[4]) {
    asm volatile("s_waitcnt vmcnt(0) lgkmcnt(0)" ::: "memory");
    s[0] = 0.f; s[1] = 0.f; s[2] = 0.f; s[3] = 0.f;
#pragma unroll 8
    for (int d = 0; d < 64; ++d) { const float kv = tile[lane * 65 + d];
        s[0] += kv * rdlane(q[0], d); s[1] += kv * rdlane(q[1], d); s[2] += kv * rdlane(q[2], d); s[3] += kv * rdlane(q[3], d); }
    asm volatile("s_waitcnt lgkmcnt(0)" ::: "memory");
}
__device__ __forceinline__ void att_scores(const float* kp, int stride, int klo, int khi, LAS float* tile, int lane, const float (&q)[4], float (&s)[4]) {
    att_stage(kp, stride, klo, khi, tile, lane);
    att_qk(tile, lane, q, s);
}
__device__ __forceinline__ void att_tile(const float* kp, const float* vp, int stride, int klo, int khi, bool valid, LAS float* tile, int lane,
                                         const float (&q)[4], float (&m)[4], float (&l)[4], float (&o)[4], float (&s)[4]) {
    float pr[4];
    att_stage(kp, stride, klo, khi, tile, lane);
    float vr[64];
#pragma unroll
    for (int u = 0; u < 64; ++u) vr[u] = (u >= klo && u < khi) ? __builtin_nontemporal_load(vp + (ptrdiff_t)u * stride + lane) : 0.f;
    {
        asm volatile("s_waitcnt lgkmcnt(0)" ::: "memory");
        s[0] = 0.f; s[1] = 0.f; s[2] = 0.f; s[3] = 0.f;
#pragma unroll 8
        for (int d = 0; d < 64; ++d) { const float kv = tile[lane * 65 + d];
            s[0] += kv * rdlane(q[0], d); s[1] += kv * rdlane(q[1], d); s[2] += kv * rdlane(q[2], d); s[3] += kv * rdlane(q[3], d); }
    }
#pragma unroll
    for (int h = 0; h < 4; ++h) {
        const float sc = valid ? s[h] : NEGM;
        const float mn = fmaxf(m[h], wave_max(sc));
        const float pv = valid ? expf(sc - mn) : 0.f;
        const float al = expf(m[h] - mn);
        l[h] = l[h] * al + wave_sum(pv); o[h] *= al; m[h] = mn; pr[h] = pv;
    }
#pragma unroll
    for (int u = 0; u < 64; ++u) { o[0] += rdlane(pr[0], u) * vr[u]; o[1] += rdlane(pr[1], u) * vr[u]; o[2] += rdlane(pr[2], u) * vr[u]; o[3] += rdlane(pr[3], u) * vr[u]; }
}
__device__ __forceinline__ void sa_merge(LAS unsigned char* lds, int wave, int lane, const float (&m)[4], const float (&l)[4], const float (&o)[4], float gate, float& outv, float (&gm)[4], float (&gil)[4]) {
    LAS float* mo = (LAS float*)(lds + SA_MO); LAS float* ml = (LAS float*)(lds + SA_ML);
#pragma unroll
    for (int h = 0; h < 4; ++h) { mo[(wave * 4 + h) * 64 + lane] = o[h]; if (lane == 0) { ml[(wave * 4 + h) * 2] = m[h]; ml[(wave * 4 + h) * 2 + 1] = l[h]; } }
    __syncthreads();
#pragma unroll
    for (int h = 0; h < 4; ++h) { float M = NEGM;
#pragma unroll
        for (int w = 0; w < 8; ++w) M = fmaxf(M, ml[(w * 4 + h) * 2]);
        float L = 0.f;
#pragma unroll
        for (int w = 0; w < 8; ++w) L += ml[(w * 4 + h) * 2 + 1] * expf(ml[(w * 4 + h) * 2] - M);
        gm[h] = M; gil[h] = L > 0.f ? 1.0f / L : 0.f; }
    if (wave < 4) { float M = NEGM, il = 0.f;
#pragma unroll
        for (int h = 0; h < 4; ++h) if (h == wave) { M = gm[h]; il = gil[h]; }
        float acc = 0.f;
#pragma unroll
        for (int w = 0; w < 8; ++w) acc += mo[(w * 4 + wave) * 64 + lane] * expf(ml[(w * 4 + wave) * 2] - M);
        outv += gate * acc * il; }
    __syncthreads();
}

__device__ __forceinline__ void ph_attn_sample(const P& p, LAS unsigned char* lds) {
    const int tid = tid_now(), lane = tid & 63, wave = __builtin_amdgcn_readfirstlane(tid >> 6);
    LAS float* tile = (LAS float*)(lds + SA_TILE + wave * 16640);
    LAS float* psall = (LAS float*)(lds + SA_PS); LAS float* imp = (LAS float*)(lds + SA_IMP); LAS int* sel = (LAS int*)(lds + SA_SEL);
    const float* Q = (const float*)(p.ws + WS_Q); const float* KV3 = (const float*)(p.ws + WS_KV3); const float* GATES = (const float*)(p.ws + WS_GATES);
    const float* CK = (const float*)(p.ws + WS_CMPKV); float* ATTN = (float*)(p.ws + WS_ATTN);
    const float* KVS = KV3 + (size_t)MR * 256; const float* KVW = KV3 + (size_t)2 * MR * 256;
    for (int hw = blockIdx.x; hw < MS * 2; hw += gridDim.x) {
        const int cidx = (hw & 7) * 8 + ((hw >> 3) >> 2), qi = (hw >> 3) & 3, b = cidx >> 1, g = cidx & 1;
        const int r = MP + b * DSQ + qi, t = PAST + qi;
        float q[4];
#pragma unroll
        for (int h = 0; h < 4; ++h) q[h] = Q[(size_t)r * AW + (g * 4 + h) * 64 + lane] * 0.125f;
        const float* gt = GATES + (size_t)r * 24 + g * 12;
        float gc = 0.f, gs = 0.f, gw_ = 0.f;
        if (wave < 4) { gc = gt[wave * 3]; gs = gt[wave * 3 + 1]; gw_ = gt[wave * 3 + 2]; }
        float outv = 0.f, gm[4], gil[4], m[4], l[4], o[4];
        const float* kc = CK + (size_t)b * NC_S * 128 + g * 64; const float* vc = kc + CMPO;
#pragma unroll
        for (int h = 0; h < 4; ++h) { m[h] = NEGM; l[h] = 0.f; o[h] = 0.f; }
        float sc2[2][4];
#pragma unroll 1
        for (int ix = 0; ix < 2; ++ix) { const int ti = wave + 8 * ix, khi = NC_S - 64 * ti < 64 ? NC_S - 64 * ti : 64; float st[4];
            att_tile(kc + (size_t)ti * 64 * 128, vc + (size_t)ti * 64 * 128, 128, 0, khi, 64 * ti + lane < NC_S, tile, lane, q, m, l, o, st);
#pragma unroll
            for (int h = 0; h < 4; ++h) { sc2[0][h] = ix == 0 ? st[h] : sc2[0][h]; sc2[1][h] = st[h]; } }
        sa_merge(lds, wave, lane, m, l, o, gc, outv, gm, gil);
#pragma unroll
        for (int ix = 0; ix < 2; ++ix) { const int ti = wave + 8 * ix;
            float ps = 0.f;
            if (64 * ti + lane < NC_S) {
#pragma unroll
                for (int h = 0; h < 4; ++h) ps += expf(sc2[ix][h] - gm[h]) * gil[h]; }
            psall[ti * 64 + lane] = ps;
        }
        if (wave == 0) psall[16 * 64 + lane] = 0.f;
        __syncthreads();
        const int cur = t >> 6;
        if (tid < 320) { float v = 0.f;
            if (tid < 257) { const int c4 = 4 * tid; v = psall[c4] + psall[c4 + 1] + psall[c4 + 2] + 0.5f * psall[c4 + 3] + (tid > 0 ? 0.5f * psall[c4 - 1] : 0.f); }
            imp[tid] = v; }
        __syncthreads();
        {
            unsigned key[5];
#pragma unroll
            for (int i = 0; i < 5; ++i) { const int j = lane + 64 * i; key[i] = 0u;
                if (j < 257) key[i] = j > cur ? 1u : (j == 0 || j == cur || j == cur - 1) ? 0x7F000000u : __float_as_uint(fmaxf(imp[j], 0.f)) + 2u; }
            unsigned T = 0u;
            for (int bit = 30; bit >= 0; --bit) { const unsigned tr = T | (1u << bit); int cnt = 0;
#pragma unroll
                for (int i = 0; i < 5; ++i) cnt += __popcll(__ballot(key[i] >= tr));
                if (cnt >= 16) T = tr; }
            int ngt = 0;
#pragma unroll
            for (int i = 0; i < 5; ++i) ngt += __popcll(__ballot(key[i] > T));
            const int need = 16 - ngt; const unsigned long long below = (1ull << lane) - 1ull;
            int eqbefore = 0, rank = 0;
#pragma unroll
            for (int i = 0; i < 5; ++i) { const unsigned long long eqm = __ballot(key[i] == T);
                const bool take = key[i] > T || (key[i] == T && eqbefore + __popcll(eqm & below) < need);
                const unsigned long long tm = __ballot(take);
                if (take && wave == 0) sel[rank + __popcll(tm & below)] = lane + 64 * i;
                rank += __popcll(tm); eqbefore += __popcll(eqm); }
        }
        __syncthreads();
        float sdump[4];
#pragma unroll
        for (int h = 0; h < 4; ++h) { m[h] = NEGM; l[h] = 0.f; o[h] = 0.f; }
        for (int k = wave; k < 16; k += 8) {
            const int j = __builtin_amdgcn_readfirstlane(sel[k]);
            if (j < 256) { const int page = p.pt[b * NPG + (j >> 1)]; const float* kp = p.cache_s + ((size_t)page * PAGE + (j & 1) * 64) * 256 + g * 64;
                att_tile(kp, kp + 128, 256, 0, 64, true, tile, lane, q, m, l, o, sdump); }
            else { const float* kp = KVS + (size_t)(MP + b * DSQ) * 256 + g * 64;
                att_tile(kp, kp + 128, 256, 0, DSQ, lane <= qi, tile, lane, q, m, l, o, sdump); }
        }
        sa_merge(lds, wave, lane, m, l, o, gs, outv, gm, gil);
#pragma unroll
        for (int h = 0; h < 4; ++h) { m[h] = NEGM; l[h] = 0.f; o[h] = 0.f; }
        { const float* kp = p.cache_w + ((size_t)(b * 512 + 64 * wave)) * 256 + g * 64;
          att_tile(kp, kp + 128, 256, 0, 64, 64 * wave + lane >= qi, tile, lane, q, m, l, o, sdump); }
        if (wave == 0) { const float* kp = KVW + (size_t)(MP + b * DSQ) * 256 + g * 64;
            att_tile(kp, kp + 128, 256, 0, DSQ, lane <= qi, tile, lane, q, m, l, o, sdump); }
        sa_merge(lds, wave, lane, m, l, o, gw_, outv, gm, gil);
        if (wave < 4) ATTN[(size_t)r * AW + (g * 4 + wave) * 64 + lane] = outv;
    }
}

__device__ __forceinline__ void ph_mixin(const P& p) {
    const int tid = tid_now(), lane = tid & 63, wave = tid >> 6, gw = blockIdx.x * 8 + wave, NGW = gridDim.x * 8;
    const float* ATTN = (const float*)(p.ws + WS_ATTN); const float* S2 = (const float*)(p.ws + WS_S2); bf16* MIX = (bf16*)(p.ws + WS_MIX);
    f32x4 gn[2][2];
#pragma unroll
    for (int part = 0; part < 2; ++part)
#pragma unroll
        for (int j = 0; j < 2; ++j) gn[part][j] = *(const f32x4*)((part ? p.ssm_g : p.attn_g) + 4 * (lane + 64 * j));
    for (int r0 = gw; r0 < MR; r0 += 4 * NGW) {
        f32x4 v[4][2][2];
#pragma unroll
        for (int w = 0; w < 4; ++w) { const int r = r0 + w * NGW < MR ? r0 + w * NGW : r0;
#pragma unroll
            for (int part = 0; part < 2; ++part) { const float* src = (part ? S2 : ATTN) + (size_t)r * 512;
#pragma unroll
                for (int j = 0; j < 2; ++j) v[w][part][j] = *(const f32x4*)(src + 4 * (lane + 64 * j)); } }
#pragma unroll
        for (int w = 0; w < 4; ++w) { const int r = r0 + w * NGW; if (r >= MR) break;
#pragma unroll
            for (int part = 0; part < 2; ++part) { float ss = 0.f;
#pragma unroll
                for (int j = 0; j < 2; ++j) { const f32x4 x = v[w][part][j]; ss += (x.x * x.x + x.y * x.y) + (x.z * x.z + x.w * x.w); }
                const float rstd = 1.0f / sqrtf(wave_sum(ss) * (1.0f / 512.0f) + EPS);
#pragma unroll
                for (int j = 0; j < 2; ++j) { const int c = 4 * (lane + 64 * j); const f32x4 y = v[w][part][j] * rstd * gn[part][j];
                    u32x2 o; o.x = pk2(y.x, y.y); o.y = pk2(y.z, y.w); *(u32x2*)(MIX + (size_t)r * D + part * 512 + c) = o; } } }
    }
}

struct EpiCmp {
    static constexpr bool PERM = false, AFTER_DRAIN = false;
    float* C;
    __device__ __forceinline__ void operator()(const pg8::f32x4 (&acc)[2][2][4][2], const pg8::Unit& u, int wr, int wc, int fr, int fq) const {
        const int row0 = u.pm * 256 + wr * 64 + fr, col0 = wc * 32 + 4 * fq;
#pragma unroll
        for (int ai = 0; ai < 2; ++ai)
#pragma unroll
            for (int m = 0; m < 4; ++m) { float* rowp = C + (size_t)(row0 + ai * 128 + m * 16) * 256 + col0;
#pragma unroll
                for (int bj = 0; bj < 2; ++bj)
#pragma unroll
                    for (int n = 0; n < 2; ++n) *(pg8::f32x4*)(rowp + bj * 128 + n * 16) = acc[ai][bj][m][n]; }
    }
};
struct CmpOrder {
    int G, c;
    __device__ bool next(int i, pg8::Unit& u) const { const int L = i * G + c; if (L >= 2 * (CMP_ROWS / 256)) return false; u.pm = L; u.pn = L >= CMP_ROWS / 256 ? 1 : 0; return true; }
    __device__ __forceinline__ void a_ready(const pg8::Unit&) const {}
    __device__ __forceinline__ void done(const pg8::Unit&) const {}
};
struct EpiGlu {
    static constexpr bool PERM = false, AFTER_DRAIN = false;
    const float* SF; float* S2; const float* bias;
    __device__ __forceinline__ void operator()(const pg8::f32x4 (&acc)[2][2][4][2], const pg8::Unit& u, int wr, int wc, int fr, int fq) const {
        const int row0 = u.pm * 256 + wr * 64 + fr, col0 = u.pn * 256 + wc * 32 + 4 * fq;
#pragma unroll
        for (int ai = 0; ai < 2; ++ai)
#pragma unroll
            for (int m = 0; m < 4; ++m) { const size_t ro = (size_t)(row0 + ai * 128 + m * 16) * 512 + col0;
#pragma unroll
                for (int bj = 0; bj < 2; ++bj)
#pragma unroll
                    for (int n = 0; n < 2; ++n) { const int co = bj * 128 + n * 16; const pg8::f32x4 s = *(const pg8::f32x4*)(SF + ro + co); const pg8::f32x4 bv = *(const pg8::f32x4*)(bias + col0 + co);
                        const pg8::f32x4 t = acc[ai][bj][m][n] + bv; pg8::f32x4 o;
                        o[0] = s[0] * sigmoid_f(t[0]); o[1] = s[1] * sigmoid_f(t[1]); o[2] = s[2] * sigmoid_f(t[2]); o[3] = s[3] * sigmoid_f(t[3]);
                        *(pg8::f32x4*)(S2 + ro + co) = o; } }
    }
};
struct EpiOut {
    static constexpr bool PERM = false, AFTER_DRAIN = false;
    const float *xp, *xs, *ADA; float* X1;
    __device__ __forceinline__ void operator()(const pg8::f32x4 (&acc)[2][2][4][2], const pg8::Unit& u, int wr, int wc, int fr, int fq) const {
        const int row0 = u.pm * 256 + wr * 64 + fr, col0 = u.pn * 256 + wc * 32 + 4 * fq;
#pragma unroll
        for (int ai = 0; ai < 2; ++ai)
#pragma unroll
            for (int m = 0; m < 4; ++m) { const int r = row0 + ai * 128 + m * 16;
                if (r < MR) { const float* xr = (r < MP ? xp + (size_t)r * D : xs + (size_t)(r - MP) * D) + col0; const float* gr = ADA + (size_t)ada_row(r) * 6144 + 2 * D + col0;
#pragma unroll
                    for (int bj = 0; bj < 2; ++bj)
#pragma unroll
                        for (int n = 0; n < 2; ++n) { const int co = bj * 128 + n * 16;
                            *(pg8::f32x4*)(X1 + (size_t)r * D + col0 + co) = *(const pg8::f32x4*)(xr + co) + *(const pg8::f32x4*)(gr + co) * acc[ai][bj][m][n]; } } }
    }
};
struct EpiUp {
    static constexpr bool PERM = true, AFTER_DRAIN = false;
    bf16* FF;
    __device__ __forceinline__ void operator()(const pg8::f32x4 (&acc)[2][2][4][2], const pg8::Unit& u, int wr, int wc, int fr, int fq) const {
        const int row0 = u.pm * 256 + wr * 64 + fr, col0 = u.pn * 128 + wc * 32 + 8 * fq;
#pragma unroll
        for (int ai = 0; ai < 2; ++ai)
#pragma unroll
            for (int m = 0; m < 4; ++m) { bf16* rowp = FF + (size_t)(row0 + ai * 128 + m * 16) * DFF + col0;
                const pg8::f32x4 g0 = acc[ai][0][m][0], g1 = acc[ai][0][m][1], u0 = acc[ai][1][m][0], u1 = acc[ai][1][m][1];
                pg8::u32x4 w; w.x = pk2(silu_f(g0[0]) * u0[0], silu_f(g0[1]) * u0[1]); w.y = pk2(silu_f(g0[2]) * u0[2], silu_f(g0[3]) * u0[3]);
                w.z = pk2(silu_f(g1[0]) * u1[0], silu_f(g1[1]) * u1[1]); w.w = pk2(silu_f(g1[2]) * u1[2], silu_f(g1[3]) * u1[3]);
                *(pg8::u32x4*)rowp = w; }
    }
};
struct EpiDown {
    static constexpr bool PERM = false, AFTER_DRAIN = false;
    const float *X1, *ADA; float* out;
    __device__ __forceinline__ void operator()(const pg8::f32x4 (&acc)[2][2][4][2], const pg8::Unit& u, int wr, int wc, int fr, int fq) const {
        const int row0 = u.pm * 256 + wr * 64 + fr, col0 = u.pn * 256 + wc * 32 + 4 * fq;
#pragma unroll
        for (int ai = 0; ai < 2; ++ai)
#pragma unroll
            for (int m = 0; m < 4; ++m) { const int r = row0 + ai * 128 + m * 16;
                if (r < MR) { const float* xr = X1 + (size_t)r * D + col0; const float* gr = ADA + (size_t)ada_row(r) * 6144 + 5 * D + col0;
                    float* orow = (r < MP ? out + O_YP + (size_t)r * D : out + O_YS + (size_t)(r - MP) * D) + col0;
#pragma unroll
                    for (int bj = 0; bj < 2; ++bj)
#pragma unroll
                        for (int n = 0; n < 2; ++n) { const int co = bj * 128 + n * 16;
                            *(pg8::f32x4*)(orow + co) = *(const pg8::f32x4*)(xr + co) + *(const pg8::f32x4*)(gr + co) * acc[ai][bj][m][n]; } } }
    }
};


constexpr int CF_ABYTES = 258 * 128, CF_A0 = 0, CF_A1 = CF_ABYTES, CF_B0 = 2 * CF_ABYTES, CF_BBYTES = 256 * 128, CF_B1 = CF_B0 + CF_BBYTES;
constexpr int CF_HID = 0, CF_W2 = 66048;
__device__ __forceinline__ int cf_off(int row, int q) { return row * 128 + ((q ^ ((row >> 1) & 7)) << 4); }
__device__ __forceinline__ int cf_off2(int row, int q) { return row * 256 + ((q ^ ((row >> 1) & 7)) << 4); }

template <int PART>
__device__ __forceinline__ void ph_cmpf(const P& p, LAS unsigned char* lds) {
    const int tid = tid_now(), lane = tid & 63, wave = __builtin_amdgcn_readfirstlane(tid >> 6), fr = lane & 15, fq = lane >> 4, wr = wave >> 1, wc = wave & 1;
    const float* KVC = p.out + O_KVC_P; const bf16* WC1 = (const bf16*)(p.ws + WS_WC1_T); const float* PEB = (const float*)(p.ws + WS_PEB);
    float* CK = (float*)(p.ws + WS_CMPKV); bf16* KCB = (bf16*)(p.ws + WS_KCB);
    constexpr int NU = PART ? 16 : 512, NCH_B = PART ? 512 : 1024, NC = PART ? NC_P : NC_S;
    const int lh = lane >> 5, pc = lane & 31, ag = pc >> 4, ad = 4 * (pc & 15);
    for (int u = blockIdx.x; u < NU; u += (PART ? 16 : (int)gridDim.x)) {
        const int kv = PART ? (u >> 3) : (u >> 8), b = PART ? ((u >> 2) & 1) : ((u >> 3) & 31), c0 = (PART ? (u & 3) : (u & 7)) * 128;
        const float* abase0; const float* abase1; const float* esrc = nullptr; const bool ext = c0 + 128 < NCH_B;
        if (PART == 0) { const int pg0 = p.pt[b * NPG + ((c0 + 16 * wave) >> 3)], pg1 = p.pt[b * NPG + ((c0 + 16 * wave) >> 3) + 1];
            abase0 = p.cache_c + ((size_t)pg0 * PAGE + lh * 16) * 256 + kv * 128 + 4 * pc; abase1 = p.cache_c + ((size_t)pg1 * PAGE + lh * 16) * 256 + kv * 128 + 4 * pc;
            if (ext && tid < 32) { const int ce = c0 + 128; const int pg = p.pt[b * NPG + (ce >> 3)]; esrc = p.cache_c + ((size_t)pg * PAGE + (ce & 7) * 16) * 256 + kv * 128 + 4 * tid; } }
        else { abase0 = KVC + ((size_t)b * SEQ + (size_t)(c0 + 16 * wave + lh) * 16) * 256 + kv * 128 + 4 * pc; abase1 = abase0 + (size_t)8 * 16 * 256;
            if (ext && tid < 32) esrc = KVC + ((size_t)b * SEQ + (size_t)(c0 + 128) * 16) * 256 + kv * 128 + 4 * tid; }
        const bf16* wsrc = WC1 + ((size_t)kv * 256 + (tid >> 3)) * 1024 + (tid & 7) * 8;
        f32x4 av[8], ev; u32x4 wv[4];
        ev = (f32x4){0.f, 0.f, 0.f, 0.f};
#define CF_LOAD(tok) do { _Pragma("unroll") for (int j = 0; j < 8; ++j) av[j] = __builtin_nontemporal_load((const f32x4*)((j < 4 ? abase0 : abase1) + (size_t)(2 * (j & 3)) * 16 * 256 + (size_t)(tok) * 256)); \
            if (esrc) ev = *(const f32x4*)(esrc + (size_t)(tok) * 256); \
            _Pragma("unroll") for (int i = 0; i < 4; ++i) wv[i] = *(const u32x4*)(wsrc + (size_t)i * 64 * 1024 + (tok) * 64); } while (0)
#define CF_STORE(abuf, bbuf) do { \
            _Pragma("unroll") for (int j = 0; j < 8; ++j) { const int row_ = 2 * (16 * wave + 2 * j + lh) + ag; u32x2 o_; o_.x = pk2(av[j].x, av[j].y); o_.y = pk2(av[j].z, av[j].w); \
                *(LAS u32x2*)(lds + (abuf) + cf_off(row_, ad >> 3) + ((ad >> 2) & 1) * 8) = o_; } \
            if (tid < 32) { u32x2 o_; o_.x = pk2(ev.x, ev.y); o_.y = pk2(ev.z, ev.w); *(LAS u32x2*)(lds + (abuf) + cf_off(256 + (tid >> 4), (tid & 15) >> 1) + (tid & 1) * 8) = o_; } \
            _Pragma("unroll") for (int i = 0; i < 4; ++i) *(LAS u32x4*)(lds + (bbuf) + cf_off((tid >> 3) + 64 * i, tid & 7)) = wv[i]; } while (0)
        f32x4 acc[4][4];
#pragma unroll
        for (int m = 0; m < 4; ++m)
#pragma unroll
            for (int n = 0; n < 4; ++n) acc[m][n] = (f32x4){0.f, 0.f, 0.f, 0.f};
        CF_LOAD(0); CF_STORE(CF_A0, CF_B0);
        __syncthreads();
#pragma unroll 1
        for (int tok = 0; tok < 16; ++tok) {
            const int ab = (tok & 1) ? CF_A1 : CF_A0, bb = (tok & 1) ? CF_B1 : CF_B0;
            if (tok + 1 < 16) CF_LOAD(tok + 1);
#pragma unroll
            for (int half = 0; half < 2; ++half)
#pragma unroll
                for (int ks = 0; ks < 2; ++ks) {
                    bf16x8 a[4], bw[4];
#pragma unroll
                    for (int m = 0; m < 4; ++m) a[m] = *(const LAS bf16x8*)(lds + ab + cf_off(64 * wr + 16 * m + fr + 2 * half, 4 * ks + fq));
#pragma unroll
                    for (int n = 0; n < 4; ++n) bw[n] = *(const LAS bf16x8*)(lds + bb + cf_off(128 * half + 64 * wc + 16 * n + fr, 4 * ks + fq));
#pragma unroll
                    for (int m = 0; m < 4; ++m)
#pragma unroll
                        for (int n = 0; n < 4; ++n) acc[m][n] = MFMA16(bw[n], a[m], acc[m][n]);
                }
            if (tok + 1 < 16) { if (tok & 1) CF_STORE(CF_A0, CF_B0); else CF_STORE(CF_A1, CF_B1); }
            __syncthreads();
        }
#undef CF_LOAD
#undef CF_STORE
#pragma unroll
        for (int n = 0; n < 4; ++n) { const int col = 64 * wc + 16 * n + 4 * fq; const f32x4 bias = peb_load(PEB, kv, col);
#pragma unroll
            for (int m = 0; m < 4; ++m) { const int row = 64 * wr + 16 * m + fr; const f32x4 v = acc[m][n] + bias;
                u32x2 o; o.x = pk2(gelu_tanh(v.x), gelu_tanh(v.y)); o.y = pk2(gelu_tanh(v.z), gelu_tanh(v.w));
                *(LAS u32x2*)(lds + CF_HID + cf_off2(row, col >> 3) + (col & 7) * 2) = o; } }
        { const float* w2 = kv ? p.w2_v : p.w2_k; const int n = tid & 63, kb = tid >> 6; float x[16];
#pragma unroll
          for (int j = 0; j < 16; ++j) x[j] = w2[(size_t)(16 * kb + j) * 64 + n];
#pragma unroll
          for (int h2 = 0; h2 < 2; ++h2) { u32x4 o; o.x = pk2(x[8 * h2], x[8 * h2 + 1]); o.y = pk2(x[8 * h2 + 2], x[8 * h2 + 3]); o.z = pk2(x[8 * h2 + 4], x[8 * h2 + 5]); o.w = pk2(x[8 * h2 + 6], x[8 * h2 + 7]);
              *(LAS u32x4*)(lds + CF_W2 + cf_off2(n, 2 * kb + h2)) = o; } }
        __syncthreads();
        f32x4 acc2[2][4];
#pragma unroll
        for (int m = 0; m < 2; ++m)
#pragma unroll
            for (int n = 0; n < 4; ++n) acc2[m][n] = (f32x4){0.f, 0.f, 0.f, 0.f};
#pragma unroll
        for (int ks = 0; ks < 4; ++ks) { bf16x8 a[2], bw[4];
#pragma unroll
            for (int m = 0; m < 2; ++m) a[m] = *(const LAS bf16x8*)(lds + CF_HID + cf_off2(32 * wave + 16 * m + fr, 4 * ks + fq));
#pragma unroll
            for (int n = 0; n < 4; ++n) bw[n] = *(const LAS bf16x8*)(lds + CF_W2 + cf_off2(16 * n + fr, 4 * ks + fq));
#pragma unroll
            for (int m = 0; m < 2; ++m)
#pragma unroll
                for (int n = 0; n < 4; ++n) acc2[m][n] = MFMA16(bw[n], a[m], acc2[m][n]); }
#pragma unroll
        for (int m = 0; m < 2; ++m) { const int row = 32 * wave + 16 * m + fr, i = c0 + (row >> 1), g = row & 1;
            if (i < NC) {
                float* dst = CK + (size_t)kv * CMPO + (PART ? (size_t)CMPO_S : 0) + ((size_t)(b * NC + i) * 2 + g) * 64 + 4 * fq;
#pragma unroll
                for (int n = 0; n < 4; ++n) *(f32x4*)(dst + 16 * n) = acc2[m][n];
                if (PART) { bf16* kd = KCB + ((size_t)((kv * NBP + b) * 2 + g) * 512 + i) * 64 + 4 * fq;
#pragma unroll
                    for (int n = 0; n < 4; ++n) { u32x2 o; o.x = pk2(acc2[m][n].x, acc2[m][n].y); o.y = pk2(acc2[m][n].z, acc2[m][n].w); *(u32x2*)(kd + 16 * n) = o;
                        if (i == 0) *(u32x2*)(kd + (size_t)511 * 64 + 16 * n) = (u32x2){0u, 0u}; } }
            } }
        __syncthreads();
    }
}


constexpr int CS_A0 = 0, CS_ABYTES = 66 * 128, CS_A1 = CS_ABYTES, CS_B0 = 2 * CS_ABYTES, CS_B1 = CS_B0 + 32768;
constexpr int CS_HID = 0, CS_W2 = CS_B0;
__device__ __forceinline__ void ph_cmpf_small(const P& p, LAS unsigned char* lds, int u) {
    const int tid = tid_now(), lane = tid & 63, wave = __builtin_amdgcn_readfirstlane(tid >> 6), fr = lane & 15, fq = lane >> 4;
    const float* KVC = p.out + O_KVC_P; const bf16* WC1 = (const bf16*)(p.ws + WS_WC1_T); const float* PEB = (const float*)(p.ws + WS_PEB);
    float* CK = (float*)(p.ws + WS_CMPKV); bf16* KCB = (bf16*)(p.ws + WS_KCB);
    const int kv = u >> 5, b = (u >> 4) & 1, c0 = (u & 15) * 32; const bool ext = c0 + 32 < 512;
    const int pc = tid & 31, ch0 = tid >> 5, ag = pc >> 4, ad = 4 * (pc & 15);
    const float* abase = KVC + ((size_t)b * SEQ + (size_t)(c0 + ch0) * 16) * 256 + kv * 128 + 4 * pc;
    const float* esrc = (ext && tid < 32) ? KVC + ((size_t)b * SEQ + (size_t)(c0 + 32) * 16) * 256 + kv * 128 + 4 * tid : nullptr;
    const bf16* wsrc = WC1 + ((size_t)kv * 256 + (tid >> 3)) * 1024 + (tid & 7) * 8;
    f32x4 aA0, aA1, aB0, aB1, eA, eB; u32x4 wA[4], wB[4];
    eA = (f32x4){0.f, 0.f, 0.f, 0.f}; eB = eA;
#define CS_LOAD(a0, a1, EV, WV, tok) do { a0 = *(const f32x4*)(abase + (size_t)(tok) * 256); a1 = *(const f32x4*)(abase + (size_t)16 * 16 * 256 + (size_t)(tok) * 256); \
        if (esrc) EV = *(const f32x4*)(esrc + (size_t)(tok) * 256); \
        _Pragma("unroll") for (int i = 0; i < 4; ++i) WV[i] = *(const u32x4*)(wsrc + (size_t)i * 64 * 1024 + (tok) * 64); } while (0)
#define CS_STORE(a0, a1, EV, WV, abuf, bbuf) do { \
        { u32x2 o_; o_.x = pk2(a0.x, a0.y); o_.y = pk2(a0.z, a0.w); *(LAS u32x2*)(lds + (abuf) + cf_off(2 * ch0 + ag, ad >> 3) + ((ad >> 2) & 1) * 8) = o_; } \
        { u32x2 o_; o_.x = pk2(a1.x, a1.y); o_.y = pk2(a1.z, a1.w); *(LAS u32x2*)(lds + (abuf) + cf_off(2 * (ch0 + 16) + ag, ad >> 3) + ((ad >> 2) & 1) * 8) = o_; } \
        if (tid < 32) { u32x2 o_; o_.x = pk2(EV.x, EV.y); o_.y = pk2(EV.z, EV.w); *(LAS u32x2*)(lds + (abuf) + cf_off(64 + (tid >> 4), (tid & 15) >> 1) + (tid & 1) * 8) = o_; } \
        _Pragma("unroll") for (int i = 0; i < 4; ++i) *(LAS u32x4*)(lds + (bbuf) + cf_off((tid >> 3) + 64 * i, tid & 7)) = WV[i]; } while (0)
    const int sA0 = (fr >> 1) & 7, sA1 = ((fr >> 1) + 1) & 7;
    const int aoff00 = fr * 128 + ((fq ^ sA0) << 4), aoff01 = fr * 128 + (((4 + fq) ^ sA0) << 4);
    const int aoff10 = (fr + 2) * 128 + ((fq ^ sA1) << 4), aoff11 = (fr + 2) * 128 + (((4 + fq) ^ sA1) << 4);
    const int woff0 = (16 * wave + fr) * 128 + ((fq ^ sA0) << 4), woff1 = (16 * wave + fr) * 128 + (((4 + fq) ^ sA0) << 4);
    f32x4 acc[4];
#pragma unroll
    for (int m = 0; m < 4; ++m) acc[m] = (f32x4){0.f, 0.f, 0.f, 0.f};
#define CS_STEP(ab, bb, AO, WO, HALF) do { const bf16x8 bw = *(const LAS bf16x8*)(lds + (bb) + (WO) + (HALF) * 16384); \
        _Pragma("unroll") for (int m = 0; m < 4; ++m) { const bf16x8 a = *(const LAS bf16x8*)(lds + (ab) + (AO) + m * 2048); acc[m] = MFMA16(bw, a, acc[m]); } } while (0)
#define CS_COMPUTE(ab, bb) do { CS_STEP(ab, bb, aoff00, woff0, 0); CS_STEP(ab, bb, aoff01, woff1, 0); CS_STEP(ab, bb, aoff10, woff0, 1); CS_STEP(ab, bb, aoff11, woff1, 1); } while (0)
    CS_LOAD(aA0, aA1, eA, wA, 0); CS_LOAD(aB0, aB1, eB, wB, 1);
    CS_STORE(aA0, aA1, eA, wA, CS_A0, CS_B0);
    CS_LOAD(aA0, aA1, eA, wA, 2);
    __syncthreads();
#pragma unroll 1
    for (int tok = 0; tok < 16; tok += 2) {
        CS_COMPUTE(CS_A0, CS_B0);
        CS_STORE(aB0, aB1, eB, wB, CS_A1, CS_B1);
        if (tok + 3 < 16) CS_LOAD(aB0, aB1, eB, wB, tok + 3);
        __syncthreads();
        CS_COMPUTE(CS_A1, CS_B1);
        if (tok + 2 < 16) CS_STORE(aA0, aA1, eA, wA, CS_A0, CS_B0);
        if (tok + 4 < 16) CS_LOAD(aA0, aA1, eA, wA, tok + 4);
        __syncthreads();
    }
#undef CS_LOAD
#undef CS_STORE
#undef CS_STEP
#undef CS_COMPUTE
    { const int col = 16 * wave + 4 * fq; const f32x4 bias = peb_load(PEB, kv, col);
#pragma unroll
      for (int m = 0; m < 4; ++m) { const int row = 16 * m + fr; const f32x4 v = acc[m] + bias;
          u32x2 o; o.x = pk2(gelu_tanh(v.x), gelu_tanh(v.y)); o.y = pk2(gelu_tanh(v.z), gelu_tanh(v.w));
          *(LAS u32x2*)(lds + CS_HID + cf_off2(row, col >> 3) + (col & 7) * 2) = o; } }
    { const float* w2 = kv ? p.w2_v : p.w2_k; const int n = tid & 63, kb = tid >> 6; float x[16];
#pragma unroll
      for (int j = 0; j < 16; ++j) x[j] = w2[(size_t)(16 * kb + j) * 64 + n];
#pragma unroll
      for (int h2 = 0; h2 < 2; ++h2) { u32x4 o; o.x = pk2(x[8 * h2], x[8 * h2 + 1]); o.y = pk2(x[8 * h2 + 2], x[8 * h2 + 3]); o.z = pk2(x[8 * h2 + 4], x[8 * h2 + 5]); o.w = pk2(x[8 * h2 + 6], x[8 * h2 + 7]);
          *(LAS u32x4*)(lds + CS_W2 + cf_off2(n, 2 * kb + h2)) = o; } }
    __syncthreads();
    { const int m = wave & 3, n0 = 2 * (wave >> 2);
      f32x4 acc2[2]; acc2[0] = (f32x4){0.f, 0.f, 0.f, 0.f}; acc2[1] = acc2[0];
#pragma unroll
      for (int ks = 0; ks < 4; ++ks) { const bf16x8 a = *(const LAS bf16x8*)(lds + CS_HID + cf_off2(16 * m + fr, 4 * ks + fq));
#pragma unroll
          for (int j = 0; j < 2; ++j) { const bf16x8 bw = *(const LAS bf16x8*)(lds + CS_W2 + cf_off2(16 * (n0 + j) + fr, 4 * ks + fq)); acc2[j] = MFMA16(bw, a, acc2[j]); } }
      const int row = 16 * m + fr, i = c0 + (row >> 1), g = row & 1;
      if (i < NC_P) {
          float* dst = CK + (size_t)kv * CMPO + (size_t)CMPO_S + ((size_t)(b * NC_P + i) * 2 + g) * 64 + 4 * fq;
          bf16* kd = KCB + ((size_t)((kv * NBP + b) * 2 + g) * 512 + i) * 64 + 4 * fq;
#pragma unroll
          for (int j = 0; j < 2; ++j) { *(f32x4*)(dst + 16 * (n0 + j)) = acc2[j];
              u32x2 o; o.x = pk2(acc2[j].x, acc2[j].y); o.y = pk2(acc2[j].z, acc2[j].w); *(u32x2*)(kd + 16 * (n0 + j)) = o;
              if (i == 0) *(u32x2*)(kd + (size_t)511 * 64 + 16 * (n0 + j)) = (u32x2){0u, 0u}; }
      } }
    __syncthreads();
}

typedef short s16x4 __attribute__((ext_vector_type(4)));
typedef float f32x16 __attribute__((ext_vector_type(16)));
#define MFMA32(a, b, c) __builtin_amdgcn_mfma_f32_32x32x16_bf16(a, b, c, 0, 0, 0)
constexpr int AT_STG = 16384;
constexpr int AT_IMP = 2 * AT_STG;
constexpr int AT_SEL = AT_IMP + 8 * 4096;
constexpr int AT_QM = AT_SEL + 1024;
constexpr int AT_LS = AT_QM + 1024;
constexpr int AT_ACC = 68 * 1024;
constexpr int AT_ROW = 68;
constexpr int AT_QL = AT_ACC + 256 * AT_ROW * 4;
constexpr float AT_MASKED = -1e30f, AT_MINIT = -1e20f;

__device__ __forceinline__ int crow(int r, int hi) { return (r & 3) + 8 * (r >> 2) + 4 * hi; }
__device__ __forceinline__ unsigned cvtpk(float lo, float hi) { unsigned r; asm("v_cvt_pk_bf16_f32 %0, %1, %2" : "=v"(r) : "v"(lo), "v"(hi)); return r; }
__device__ __forceinline__ float xmax32(float v) { const auto rr = __builtin_amdgcn_permlane32_swap(__float_as_uint(v), __float_as_uint(v), false, false); return fmaxf(__uint_as_float(rr[0]), __uint_as_float(rr[1])); }
__device__ __forceinline__ float xsum32(float v) { const auto rr = __builtin_amdgcn_permlane32_swap(__float_as_uint(v), __float_as_uint(v), false, false); return __uint_as_float(rr[0]) + __uint_as_float(rr[1]); }
__device__ __forceinline__ float xget32(float v, int hi) { const auto rr = __builtin_amdgcn_permlane32_swap(__float_as_uint(v), __float_as_uint(v), false, false); return __uint_as_float(hi ? rr[0] : rr[1]); }
__device__ __forceinline__ s16x4 vtr(LAS const unsigned char* p) { typedef short v4i16_t __attribute__((ext_vector_type(4)));
    return __builtin_bit_cast(s16x4, __builtin_amdgcn_ds_read_tr16_b64_v4i16((LAS v4i16_t*)p)); }

struct AtStage { u32x4 k, v; };
template <bool NEEDV> __device__ __forceinline__ AtStage at_load(const bf16* ksrc, const bf16* vsrc, int tid) {
    AtStage s; const size_t off = (size_t)(tid >> 3) * 64 + (tid & 7) * 8;
    s.k = *(const u32x4*)(ksrc + off); if (NEEDV) s.v = *(const u32x4*)(vsrc + off); else s.v = (u32x4){0u, 0u, 0u, 0u};
    return s;
}
template <bool NEEDV> __device__ __forceinline__ void at_store(LAS unsigned char* buf, const AtStage& s, int tid) {
    const int key = tid >> 3, ch = tid & 7;
    *(LAS u32x4*)(buf + ch * 1024 + key * 16) = s.k;
    if (NEEDV) *(LAS u32x4*)(buf + 8192 + (ch >> 2) * 4096 + key * 64 + (ch & 3) * 16) = s.v;
}
__device__ __forceinline__ void at_scores(LAS const unsigned char* buf, const bf16x8 (&qf)[4], f32x16& s0, f32x16& s1, int lane) {
    LAS const unsigned char* kp = buf + (lane >> 5) * 1024 + (lane & 31) * 16;
    s0 = f32x16{}; s1 = f32x16{};
#pragma unroll
    for (int d0 = 0; d0 < 4; ++d0) { const bf16x8 ka = *(LAS const bf16x8*)(kp + d0 * 2048), kb = *(LAS const bf16x8*)(kp + d0 * 2048 + 512);
        s0 = MFMA32(ka, qf[d0], s0); s1 = MFMA32(kb, qf[d0], s1); }
}
__device__ __forceinline__ void at_softmax_pv(LAS const unsigned char* buf, f32x16& s0, f32x16& s1, f32x16 (&o)[2], float& m, float& l, int lane, bool lane_on) {
    float mx = fmaxf(s0[0], s1[0]);
#pragma unroll
    for (int r = 1; r < 16; r += 1) mx = __builtin_fmaxf(__builtin_fmaxf(mx, s0[r]), s1[r]);
    mx = xmax32(mx);
    mx = lane_on ? mx : AT_MASKED;
    const float mn = fmaxf(m, mx), al = __builtin_amdgcn_exp2f(m - mn);
    m = mn;
    const float off = lane_on ? mn : 1e30f;
    float rs = 0.f;
#pragma unroll
    for (int r = 0; r < 16; ++r) { s0[r] = __builtin_amdgcn_exp2f(s0[r] - off); s1[r] = __builtin_amdgcn_exp2f(s1[r] - off); rs += s0[r] + s1[r]; }
    l = l * al + rs;
    if (__ballot(al != 1.0f) != 0ull) {
#pragma unroll
        for (int r = 0; r < 16; ++r) { o[0][r] *= al; o[1][r] *= al; } }
    u32x4 pw[4];
    pw[0] = (u32x4){cvtpk(s0[0], s0[1]), cvtpk(s0[2], s0[3]), cvtpk(s0[4], s0[5]), cvtpk(s0[6], s0[7])};
    pw[1] = (u32x4){cvtpk(s0[8], s0[9]), cvtpk(s0[10], s0[11]), cvtpk(s0[12], s0[13]), cvtpk(s0[14], s0[15])};
    pw[2] = (u32x4){cvtpk(s1[0], s1[1]), cvtpk(s1[2], s1[3]), cvtpk(s1[4], s1[5]), cvtpk(s1[6], s1[7])};
    pw[3] = (u32x4){cvtpk(s1[8], s1[9]), cvtpk(s1[10], s1[11]), cvtpk(s1[12], s1[13]), cvtpk(s1[14], s1[15])};
    const int hi = lane >> 5;
    LAS const unsigned char* vp = buf + 8192 + ((lane >> 4) & 1) * 32 + (lane & 3) * 8 + (4 * hi + ((lane & 15) >> 2)) * 64;
#pragma unroll
    for (int k = 0; k < 4; ++k) {
        const bf16x8 pf = __builtin_bit_cast(bf16x8, pw[k]);
#pragma unroll
        for (int dh = 0; dh < 2; ++dh) { const s16x4 lo = vtr(vp + dh * 4096 + k * 1024), hh = vtr(vp + dh * 4096 + k * 1024 + 512);
            const bf16x8 vf = (bf16x8){lo[0], lo[1], lo[2], lo[3], hh[0], hh[1], hh[2], hh[3]};
            o[dh] = MFMA32(vf, pf, o[dh]); }
    }
}

__device__ __forceinline__ void at_softmax_pv_fixed(LAS const unsigned char* buf, f32x16& s0, f32x16& s1, f32x16 (&o)[2], float& l, int lane, float coff) {
    if (coff != 0.f) {
#pragma unroll
        for (int r = 0; r < 16; ++r) { s0[r] -= coff; s1[r] -= coff; } }
    float rs = 0.f;
#pragma unroll
    for (int r = 0; r < 16; ++r) { s0[r] = __builtin_amdgcn_exp2f(s0[r]); s1[r] = __builtin_amdgcn_exp2f(s1[r]); rs += s0[r] + s1[r]; }
    l += rs;
    u32x4 pw[4];
    pw[0] = (u32x4){cvtpk(s0[0], s0[1]), cvtpk(s0[2], s0[3]), cvtpk(s0[4], s0[5]), cvtpk(s0[6], s0[7])};
    pw[1] = (u32x4){cvtpk(s0[8], s0[9]), cvtpk(s0[10], s0[11]), cvtpk(s0[12], s0[13]), cvtpk(s0[14], s0[15])};
    pw[2] = (u32x4){cvtpk(s1[0], s1[1]), cvtpk(s1[2], s1[3]), cvtpk(s1[4], s1[5]), cvtpk(s1[6], s1[7])};
    pw[3] = (u32x4){cvtpk(s1[8], s1[9]), cvtpk(s1[10], s1[11]), cvtpk(s1[12], s1[13]), cvtpk(s1[14], s1[15])};
    const int hi = lane >> 5;
    LAS const unsigned char* vp = buf + 8192 + ((lane >> 4) & 1) * 32 + (lane & 3) * 8 + (4 * hi + ((lane & 15) >> 2)) * 64;
#pragma unroll
    for (int k = 0; k < 4; ++k) {
        const bf16x8 pf = __builtin_bit_cast(bf16x8, pw[k]);
#pragma unroll
        for (int dh = 0; dh < 2; ++dh) { const s16x4 lo = vtr(vp + dh * 4096 + k * 1024), hh = vtr(vp + dh * 4096 + k * 1024 + 512);
            const bf16x8 vf = (bf16x8){lo[0], lo[1], lo[2], lo[3], hh[0], hh[1], hh[2], hh[3]};
            o[dh] = MFMA32(vf, pf, o[dh]); }
    }
}

template <int MODE>
__device__ __forceinline__ void at_branch(const bf16* ksrc, const bf16* vsrc, int key0, int nst, LAS unsigned char* lds, const bf16x8 (&qf)[4], f32x16 (&o)[2], float& m, float& l,
                                          int t, unsigned long long sel_lo, unsigned long long sel_hi, int wlo, int whi, LAS float* impw, int tid, int lane, float coff = 0.f) {
    constexpr bool NEEDV = MODE != 3;
    const int hi = lane >> 5;
    float carry = 0.f;
    AtStage st = at_load<NEEDV>(ksrc, vsrc, tid);
    at_store<NEEDV>(lds, st, tid);
    __syncthreads();
    for (int s = 0; s < nst; ++s) {
        LAS unsigned char* buf = lds + (s & 1) * AT_STG;
        if (s + 1 < nst) st = at_load<NEEDV>(ksrc + (size_t)(s + 1) * 64 * 64, vsrc + (size_t)(s + 1) * 64 * 64, tid);
        const int kb = key0 + 64 * s;
        bool active = true;
        bool chosen = true;
        if (MODE == 1) { const int j = kb >> 6; const unsigned long long w = j < 64 ? sel_lo : sel_hi; chosen = (w >> (j & 63)) & 1ull; active = __ballot(chosen) != 0ull; }
        if (MODE == 2) active = (kb + 63 >= wlo - 512) && (kb <= whi);
        if (MODE == 0 || MODE == 3) active = 16 * kb + 31 <= whi;
        if (active) {
            f32x16 s0, s1;
            at_scores(buf, qf, s0, s1, lane);
            bool edge;
            if (MODE == 0 || MODE == 3) edge = 16 * (kb + 63) + 31 > wlo;
            else if (MODE == 1) edge = kb + 63 > wlo;
            else edge = (kb + 63 > wlo) || (kb < whi - 512);
            if (edge || MODE == 3) {
#pragma unroll
                for (int r = 0; r < 16; ++r) { const int k0 = kb + crow(r, hi), k1 = k0 + 32; bool v0, v1;
                    if (MODE == 0 || MODE == 3) { v0 = 16 * k0 + 31 <= t; v1 = 16 * k1 + 31 <= t; }
                    else if (MODE == 1) { v0 = k0 <= t; v1 = k1 <= t; }
                    else { v0 = k0 <= t && k0 >= t - 512; v1 = k1 <= t && k1 >= t - 512; }
                    if (MODE != 3) { s0[r] = v0 ? s0[r] : AT_MASKED; s1[r] = v1 ? s1[r] : AT_MASKED; }
                    else { s0[r] = v0 ? __builtin_amdgcn_exp2f(s0[r] - m) * l : 0.f; s1[r] = v1 ? __builtin_amdgcn_exp2f(s1[r] - m) * l : 0.f; } }
            }
            if (MODE == 2) at_softmax_pv_fixed(buf, s0, s1, o, l, lane, coff);
            else if (MODE != 3) at_softmax_pv(buf, s0, s1, o, m, l, lane, chosen);
            else {
#pragma unroll
                for (int n = 0; n < 2; ++n) { const f32x16& pp = n ? s1 : s0; const int jb0 = (kb >> 2) + 8 * n;
                    float own[4], sp[4], rc[4];
#pragma unroll
                    for (int G = 0; G < 4; ++G) { sp[G] = 0.5f * pp[4 * G + 3]; own[G] = pp[4 * G] + pp[4 * G + 1] + pp[4 * G + 2] + sp[G]; rc[G] = xget32(sp[G], hi); }
                    float val[4];
                    if (hi) { val[0] = own[0] + rc[0]; val[1] = own[1] + rc[1]; val[2] = own[2] + rc[2]; val[3] = own[3] + rc[3]; }
                    else { val[0] = own[0] + carry; val[1] = own[1] + rc[0]; val[2] = own[2] + rc[1]; val[3] = own[3] + rc[2]; }
                    carry = rc[3];
#pragma unroll
                    for (int G = 0; G < 4; ++G) { val[G] += dpp_mov<0xB1>(val[G]); val[G] += dpp_mov<0x4E>(val[G]);

                        if ((lane & 3) == 0) impw[((lane & 31) >> 2) * 128 + jb0 + 2 * G + hi] = val[G]; }
                }
            }
        } else if (MODE == 3) carry = 0.f;
        if (s + 1 < nst) at_store<NEEDV>(lds + ((s + 1) & 1) * AT_STG, st, tid);
        __syncthreads();
    }
}

__device__ __forceinline__ void at_slc_tile(LAS unsigned char* lds, LAS const unsigned char* buf, bool diag, int myq, float coff, f32x16 (&o)[2], float& rs, int lane) {
    const int hi = lane >> 5, col = lane & 31, head = col & 3;
    LAS const unsigned char* qimg = lds + AT_IMP;
    const int colg = myq * 4 + head;
    bf16x8 qf[4];
#pragma unroll
    for (int d0 = 0; d0 < 4; ++d0) qf[d0] = *(LAS const bf16x8*)(qimg + colg * 128 + (((d0 * 2 + hi) ^ (colg & 7)) << 4));
    f32x16 s0, s1;
    { LAS const unsigned char* kp = buf + hi * 1024 + col * 16;
      bf16x8 kf[8];
#pragma unroll
      for (int i = 0; i < 8; ++i) kf[i] = *(LAS const bf16x8*)(kp + (i >> 1) * 2048 + (i & 1) * 512);
      asm volatile("" ::: "memory");
      s0 = f32x16{}; s1 = f32x16{};
#pragma unroll
      for (int d0 = 0; d0 < 4; ++d0) { s0 = MFMA32(kf[2 * d0], qf[d0], s0); s1 = MFMA32(kf[2 * d0 + 1], qf[d0], s1); } }
    LAS const unsigned char* vp = buf + 8192 + ((lane >> 4) & 1) * 32 + (lane & 3) * 8 + (4 * hi + ((lane & 15) >> 2)) * 64;
    s16x4 vlo[4][2], vhi[4][2];
#pragma unroll
    for (int k = 0; k < 4; ++k)
#pragma unroll
        for (int dh = 0; dh < 2; ++dh) { vlo[k][dh] = vtr(vp + dh * 4096 + k * 1024); vhi[k][dh] = vtr(vp + dh * 4096 + k * 1024 + 512); }
    asm volatile("" ::: "memory");
    if (diag) {
#pragma unroll
        for (int r = 0; r < 16; ++r) { const int k0 = crow(r, hi); s0[r] = k0 <= myq ? s0[r] : AT_MASKED; s1[r] = k0 + 32 <= myq ? s1[r] : AT_MASKED; } }
    if (coff != 0.f) {
#pragma unroll
        for (int r = 0; r < 16; ++r) { s0[r] -= coff; s1[r] -= coff; } }
    rs = 0.f;
#pragma unroll
    for (int r = 0; r < 16; ++r) { s0[r] = __builtin_amdgcn_exp2f(s0[r]); s1[r] = __builtin_amdgcn_exp2f(s1[r]); rs += s0[r] + s1[r]; }
    u32x4 pw[4];
    pw[0] = (u32x4){cvtpk(s0[0], s0[1]), cvtpk(s0[2], s0[3]), cvtpk(s0[4], s0[5]), cvtpk(s0[6], s0[7])};
    pw[1] = (u32x4){cvtpk(s0[8], s0[9]), cvtpk(s0[10], s0[11]), cvtpk(s0[12], s0[13]), cvtpk(s0[14], s0[15])};
    pw[2] = (u32x4){cvtpk(s1[0], s1[1]), cvtpk(s1[2], s1[3]), cvtpk(s1[4], s1[5]), cvtpk(s1[6], s1[7])};
    pw[3] = (u32x4){cvtpk(s1[8], s1[9]), cvtpk(s1[10], s1[11]), cvtpk(s1[12], s1[13]), cvtpk(s1[14], s1[15])};
    o[0] = f32x16{}; o[1] = f32x16{};
#pragma unroll
    for (int k = 0; k < 4; ++k) {
        const bf16x8 pf = __builtin_bit_cast(bf16x8, pw[k]);
#pragma unroll
        for (int dh = 0; dh < 2; ++dh) { const s16x4 lo = vlo[k][dh], hh = vhi[k][dh];
            const bf16x8 vf = (bf16x8){lo[0], lo[1], lo[2], lo[3], hh[0], hh[1], hh[2], hh[3]};
            o[dh] = MFMA32(vf, pf, o[dh]); }
    }
    rs = xsum32(rs);
}
__device__ __forceinline__ void at_slc_merge(LAS unsigned char* lds, int myq, bool on, const f32x16 (&o)[2], float rs, int lane) {
    const int hi = lane >> 5, colg = myq * 4 + (lane & 3);
    LAS float* ap = (LAS float*)(lds + AT_ACC) + colg * AT_ROW + 4 * hi;
    LAS float* ls = (LAS float*)(lds + AT_LS);
    if (on) {
        f32x4 a4[2][4];
#pragma unroll
        for (int dh = 0; dh < 2; ++dh)
#pragma unroll
            for (int rg = 0; rg < 4; ++rg) a4[dh][rg] = *(LAS const f32x4*)(ap + dh * 32 + 8 * rg);
        asm volatile("" ::: "memory");
        if (hi == 0) ls[colg] += rs;
#pragma unroll
        for (int dh = 0; dh < 2; ++dh)
#pragma unroll
            for (int rg = 0; rg < 4; ++rg) *(LAS f32x4*)(ap + dh * 32 + 8 * rg) = (f32x4){a4[dh][rg][0] + o[dh][4 * rg], a4[dh][rg][1] + o[dh][4 * rg + 1], a4[dh][rg][2] + o[dh][4 * rg + 2], a4[dh][rg][3] + o[dh][4 * rg + 3]};
    }
}
__device__ __forceinline__ void at_slc(const bf16* ksrc, const bf16* vsrc, int jq, LAS unsigned char* lds, float coff, int tid, int lane, int wave) {
    const int col = lane & 31, w4 = wave & 3, side = wave >> 2;
    LAS const int* qcnt = (LAS const int*)(lds + AT_QM);
    LAS const unsigned char* qlist = lds + AT_QL;
    AtStage sa = at_load<true>(ksrc, vsrc, tid), sb = sa;
    if (jq >= 1) sb = at_load<true>(ksrc + 64 * 64, vsrc + 64 * 64, tid);
    at_store<true>(lds, sa, tid);
    if (jq >= 1) at_store<true>(lds + AT_STG, sb, tid);
    __syncthreads();
#pragma unroll 1
    for (int j0 = 0; j0 <= jq; j0 += 2) {
        const bool more_a = j0 + 2 <= jq, more_b = j0 + 3 <= jq;
        if (more_a) sa = at_load<true>(ksrc + (size_t)(j0 + 2) * 64 * 64, vsrc + (size_t)(j0 + 2) * 64 * 64, tid);
        if (more_b) sb = at_load<true>(ksrc + (size_t)(j0 + 3) * 64 * 64, vsrc + (size_t)(j0 + 3) * 64 * 64, tid);
        const int na = __builtin_amdgcn_readfirstlane(qcnt[j0]), nb = j0 + 1 <= jq ? __builtin_amdgcn_readfirstlane(qcnt[j0 + 1]) : 0;
        const int rounds = (na > 32 || nb > 32) ? 2 : 1;
        const int j = j0 + side, n = side ? nb : na;
#pragma unroll 1
        for (int rd = 0; rd < rounds; ++rd) {
            const int tile = w4 + 4 * rd; const bool have = 8 * tile < n;
            f32x16 o[2]; float rs = 0.f; int myq = 0;
            if (have) { myq = qlist[j * 64 + 8 * tile + (col >> 2)];
                at_slc_tile(lds, lds + side * AT_STG, j == jq, myq, coff, o, rs, lane);
                if (side == 0) at_slc_merge(lds, myq, 8 * tile + (col >> 2) < n, o, rs, lane); }
            __syncthreads();
            if (have && side == 1) at_slc_merge(lds, myq, 8 * tile + (col >> 2) < n, o, rs, lane);
            if (rd == rounds - 1) { if (more_a) at_store<true>(lds, sa, tid);
                                    if (more_b) at_store<true>(lds + AT_STG, sb, tid); }
            __syncthreads();
        }
    }
}

__device__ __forceinline__ void ph_attn_prompt(const P& p, LAS unsigned char* lds) {
    const int tid = tid_now(), lane = tid & 63, wave = __builtin_amdgcn_readfirstlane(tid >> 6), hi = lane >> 5;
    const bf16* QB = (const bf16*)(p.ws + WS_QB); const bf16* KB = (const bf16*)(p.ws + WS_KB); const bf16* VB = (const bf16*)(p.ws + WS_VB); const bf16* KCB = (const bf16*)(p.ws + WS_KCB);
    const float* GATES = (const float*)(p.ws + WS_GATES); float* ATTN = (float*)(p.ws + WS_ATTN);
    LAS float* impw = (LAS float*)(lds + AT_IMP + wave * 4096);
    LAS unsigned* selw = (LAS unsigned*)(lds + AT_SEL + wave * 128);
    float coff, coffw; { const float gq = wave_max(fabsf(p.q_g[lane])), gk = wave_max(fabsf(p.k_g[64 + lane])), gw = wave_max(fabsf(p.k_g[128 + lane]));
        coff = fmaxf(0.f, 8.0f * 1.4426950408889634f * 1.01f * gq * gk - 100.f); coffw = fmaxf(0.f, 8.0f * 1.4426950408889634f * 1.01f * gq * gw - 100.f); }
    for (int hw = blockIdx.x; hw < 256; hw += gridDim.x) {
        const int pr = ((hw & 7) >> 1) * 64 + (hw & 1) * 32 + (hw >> 3);
        const int bg = pr >> 6, b = bg >> 1, g = bg & 1;
#pragma unroll 1
        for (int half = 0; half < 2; ++half) {
            const int jq = half ? 127 - (pr & 63) : (pr & 63);
            const int t0 = 64 * jq, col = lane & 31, qi = col >> 2, head = col & 3, t = t0 + 8 * wave + qi;
            const int wlo = t0 + 8 * wave, whi = wlo + 7;
            bf16x8 qf[4];
            { const bf16* qp = QB + ((size_t)bg * SEQ + wlo) * 256 + (size_t)col * 64 + hi * 8;
#pragma unroll
              for (int d0 = 0; d0 < 4; ++d0) qf[d0] = *(const bf16x8*)(qp + d0 * 16); }
            const float* gp = GATES + (size_t)(b * SEQ + t) * 24 + (g * 4 + head) * 3;
            const float g_c = gp[0], g_s = gp[1], g_w = gp[2];
            f32x16 o[2]; float m, l;
            const int ncu = 4 * jq + 3 < NC_P ? 4 * jq + 3 : NC_P;
            const int nstc = (ncu + 63) >> 6;
            const bf16* kc = KCB + (size_t)bg * 512 * 64; const bf16* vc = kc + (size_t)NBP * 2 * 512 * 64;
            o[0] = f32x16{}; o[1] = f32x16{}; m = AT_MINIT; l = 0.f;
            at_branch<0>(kc, vc, 0, nstc, lds, qf, o, m, l, t, 0ull, 0ull, wlo, whi, impw, tid, lane);
            float lt = xsum32(l), il = lt > 0.f ? 1.0f / lt : 0.f;
            float* op = ATTN + (size_t)(b * SEQ + t) * AW + (g * 4 + head) * 64 + 4 * hi;
            { const float sc = g_c * il;
#pragma unroll
              for (int dh = 0; dh < 2; ++dh)
#pragma unroll
                for (int rg = 0; rg < 4; ++rg) *(f32x4*)(op + 32 * dh + 8 * rg) = (f32x4){sc * o[dh][4 * rg], sc * o[dh][4 * rg + 1], sc * o[dh][4 * rg + 2], sc * o[dh][4 * rg + 3]}; }
            if (jq >= 16) {
                for (int i = lane; i < 1024; i += 64) impw[i] = 0.f;
                asm volatile("s_waitcnt lgkmcnt(0)" ::: "memory");
                at_branch<3>(kc, vc, 0, nstc, lds, qf, o, m, il, t, 0ull, 0ull, wlo, whi, impw, tid, lane);
                asm volatile("s_waitcnt lgkmcnt(0)" ::: "memory");
                const int cur = jq;
                for (int q8 = 0; q8 < 8; q8 += 2) {
                    const float v0 = impw[q8 * 128 + lane], v1 = impw[q8 * 128 + 64 + lane], u0 = impw[q8 * 128 + 128 + lane], u1 = impw[q8 * 128 + 192 + lane];
                    const int j0 = lane, j1 = lane + 64;
                    const bool f0 = j0 == 0 || j0 == cur || j0 == cur - 1, f1 = j1 == cur || j1 == cur - 1;
                    const unsigned k0 = j0 > cur ? 0u : f0 ? 0x7F000000u : __float_as_uint(fmaxf(v0, 0.f)) + 1u, k1 = j1 > cur ? 0u : f1 ? 0x7F000000u : __float_as_uint(fmaxf(v1, 0.f)) + 1u;
                    const unsigned h0 = j0 > cur ? 0u : f0 ? 0x7F000000u : __float_as_uint(fmaxf(u0, 0.f)) + 1u, h1 = j1 > cur ? 0u : f1 ? 0x7F000000u : __float_as_uint(fmaxf(u1, 0.f)) + 1u;
                    unsigned T = 0u, U = 0u;
                    for (int bit = 30; bit >= 0; --bit) { const unsigned tr = T | (1u << bit), ur = U | (1u << bit);
                        const int cnt = __popcll(__ballot(k0 >= tr)) + __popcll(__ballot(k1 >= tr)), cnu = __popcll(__ballot(h0 >= ur)) + __popcll(__ballot(h1 >= ur));
                        if (cnt >= 16) T = tr;
                        if (cnu >= 16) U = ur; }
                    const unsigned long long below = (1ull << lane) - 1ull;
                    { const unsigned long long gt0 = __ballot(k0 > T), gt1 = __ballot(k1 > T), eq0 = __ballot(k0 == T), eq1 = __ballot(k1 == T);
                      const int need = 16 - (__popcll(gt0) + __popcll(gt1));
                      const int pre0 = __popcll(eq0 & below), pre1 = __popcll(eq0) + __popcll(eq1 & below);
                      const unsigned long long s0m = __ballot(k0 > T || (k0 == T && pre0 < need)), s1m = __ballot(k1 > T || (k1 == T && pre1 < need));
                      if (lane == 0) { selw[q8 * 4 + 0] = (unsigned)s0m; selw[q8 * 4 + 1] = (unsigned)(s0m >> 32); selw[q8 * 4 + 2] = (unsigned)s1m; selw[q8 * 4 + 3] = (unsigned)(s1m >> 32); } }
                    { const unsigned long long gt0 = __ballot(h0 > U), gt1 = __ballot(h1 > U), eq0 = __ballot(h0 == U), eq1 = __ballot(h1 == U);
                      const int need = 16 - (__popcll(gt0) + __popcll(gt1));
                      const int pre0 = __popcll(eq0 & below), pre1 = __popcll(eq0) + __popcll(eq1 & below);
                      const unsigned long long s0m = __ballot(h0 > U || (h0 == U && pre0 < need)), s1m = __ballot(h1 > U || (h1 == U && pre1 < need));
                      if (lane == 0) { selw[q8 * 4 + 4] = (unsigned)s0m; selw[q8 * 4 + 5] = (unsigned)(s0m >> 32); selw[q8 * 4 + 6] = (unsigned)s1m; selw[q8 * 4 + 7] = (unsigned)(s1m >> 32); } }
                }
            }
            asm volatile("s_waitcnt lgkmcnt(0)" ::: "memory");
            __syncthreads();
            for (int j = wave; j <= jq; j += 8) {
                unsigned long long mk = ~0ull;
                if (jq >= 16) { const unsigned wsel = *(LAS const unsigned*)(lds + AT_SEL + (lane >> 3) * 128 + (lane & 7) * 16 + (j >> 5) * 4); mk = __ballot((wsel >> (j & 31)) & 1u); }
                const unsigned mlo = (unsigned)mk, mhi = (unsigned)(mk >> 32);
                const int n = __popcll(mk), rk = (int)__builtin_amdgcn_mbcnt_hi(mhi, __builtin_amdgcn_mbcnt_lo(mlo, 0u));
                *(LAS unsigned char*)(lds + AT_QL + j * 64 + (((mk >> lane) & 1ull) ? rk : n + (lane - rk))) = (unsigned char)lane;
                if (lane == 0) *(LAS int*)(lds + AT_QM + j * 4) = n;
            }
#ifndef PROBE_SLC2
#define PROBE_SLC2 1
#endif
#ifdef PROBE_LIVE
            __syncthreads();
            if (hw == 0 && half == 1 && wave == 0) {
                int cnt = 0;
                for (int j = lane; j <= jq; j += 64) { const int n = *(LAS const int*)(lds + AT_QM + j * 4); cnt += PROBE_LIVE == 0 ? (n > 0 ? 1 : 0) : (n + 7) >> 3; }
                cnt = (int)wave_sum((float)cnt);
                const unsigned long long t_end = __builtin_amdgcn_s_memrealtime() + (unsigned long long)cnt * (PROBE_LIVE == 0 ? 100ull : 100ull / PROBE_LIVE);
                while (__builtin_amdgcn_s_memrealtime() < t_end) __builtin_amdgcn_s_sleep(8);
            }
#endif
#pragma unroll 1
            for (int rep = 0; rep < PROBE_SLC2; ++rep) {
            { const int colg = 32 * wave + col;
#pragma unroll
              for (int d0 = 0; d0 < 4; ++d0) *(LAS bf16x8*)(lds + AT_IMP + colg * 128 + (((d0 * 2 + hi) ^ (colg & 7)) << 4)) = qf[d0];
              for (int i = tid; i < 256 * AT_ROW / 4; i += 512) *(LAS f32x4*)(lds + AT_ACC + i * 16) = (f32x4){0.f, 0.f, 0.f, 0.f};
              if (tid < 256) *(LAS float*)(lds + AT_LS + tid * 4) = 0.f; }
            at_slc(KB + (size_t)bg * SEQ * 64, VB + (size_t)bg * SEQ * 64, jq, lds, coff, tid, lane, wave);
            }
            { const float lt2 = *(LAS const float*)(lds + AT_LS + (32 * wave + col) * 4);
              const float sc = g_s * (lt2 > 0.f ? 1.0f / lt2 : 0.f);
              LAS float* ap = (LAS float*)(lds + AT_ACC) + (32 * wave + col) * AT_ROW + 4 * hi;
#pragma unroll
              for (int dh = 0; dh < 2; ++dh)
#pragma unroll
                for (int rg = 0; rg < 4; ++rg) { const f32x4 c4 = *(const f32x4*)(op + 32 * dh + 8 * rg);
                    LAS f32x4* a1 = (LAS f32x4*)(ap + dh * 32 + 8 * rg); const f32x4 s4 = *a1; *a1 = c4 + sc * s4; } }
            const int kw0 = t0 >= 512 ? t0 - 512 : 0;
            o[0] = f32x16{}; o[1] = f32x16{}; m = AT_MINIT; l = 0.f;
            at_branch<2>(KB + ((size_t)(4 + bg) * SEQ + kw0) * 64, VB + ((size_t)(4 + bg) * SEQ + kw0) * 64, kw0, (t0 + 64 - kw0) >> 6, lds, qf, o, m, l, t, 0ull, 0ull, wlo, whi, impw, tid, lane, coffw);
            lt = xsum32(l); il = lt > 0.f ? 1.0f / lt : 0.f;
            { const float sc = g_w * il;
              LAS const float* ap = (LAS const float*)(lds + AT_ACC) + (32 * wave + col) * AT_ROW + 4 * hi;
#pragma unroll
              for (int dh = 0; dh < 2; ++dh)
#pragma unroll
                for (int rg = 0; rg < 4; ++rg) { const f32x4 a4 = *(LAS const f32x4*)(ap + dh * 32 + 8 * rg);
                    o[dh][4 * rg] = a4[0] + sc * o[dh][4 * rg]; o[dh][4 * rg + 1] = a4[1] + sc * o[dh][4 * rg + 1]; o[dh][4 * rg + 2] = a4[2] + sc * o[dh][4 * rg + 2]; o[dh][4 * rg + 3] = a4[3] + sc * o[dh][4 * rg + 3]; } }
#pragma unroll
            for (int dh = 0; dh < 2; ++dh)
#pragma unroll
                for (int rg = 0; rg < 4; ++rg) *(f32x4*)(op + 32 * dh + 8 * rg) = (f32x4){o[dh][4 * rg], o[dh][4 * rg + 1], o[dh][4 * rg + 2], o[dh][4 * rg + 3]};
        }
    }
}

enum { SK_Z = 0, SK_GLU, SK_OUT, SK_UP, SK_DOWN };
template <int EP, int K>
__device__ __forceinline__ void skinny_gemm(const P& p, LAS unsigned char* lds, const bf16* A  , const bf16* Bt, int ncolblk, int first_wg) {
    const int tid = tid_now(), lane = tid & 63, wave = __builtin_amdgcn_readfirstlane(tid >> 6), fr = lane & 15, fq = lane >> 4;
    constexpr int KW = K / 8, NKS = KW / 32;
    static_assert(KW % 32 == 0, "K / 8 must be a multiple of 32");
    LAS float* part = (LAS float*)lds;
    const int nwg = (int)gridDim.x - first_wg;
    if ((int)blockIdx.x < first_wg) return;
    for (int u = (int)blockIdx.x - first_wg; u < 4 * ncolblk; u += nwg) {
        const int rb = u & 3, cb = u >> 2;
        const bf16* ap = A + (size_t)(32 * rb + fr) * K + wave * KW + 8 * fq;
        const bf16* bp[4];
#pragma unroll
        for (int n = 0; n < 4; ++n) { int brow;
            if (EP == SK_UP) brow = (cb >> 2) * 256 + (cb & 3) * 32 + (n >> 1) * 128 + (n & 1) * 16 + fr;
            else brow = cb * 64 + 16 * n + fr;
            bp[n] = Bt + (size_t)brow * K + wave * KW + 8 * fq; }
        f32x4 acc[2][4];
#pragma unroll
        for (int m = 0; m < 2; ++m)
#pragma unroll
            for (int n = 0; n < 4; ++n) acc[m][n] = (f32x4){0.f, 0.f, 0.f, 0.f};
#pragma unroll 1
        for (int k0 = 0; k0 < NKS; k0 += 4) {
            bf16x8 a[4][2], bw[4][4];
#pragma unroll
            for (int s = 0; s < 4; ++s) if (k0 + s < NKS) {
#pragma unroll
                for (int m = 0; m < 2; ++m) a[s][m] = *(const bf16x8*)(ap + (size_t)(16 * m) * K + 32 * (k0 + s));
#pragma unroll
                for (int n = 0; n < 4; ++n) bw[s][n] = *(const bf16x8*)(bp[n] + 32 * (k0 + s)); }
#pragma unroll
            for (int s = 0; s < 4; ++s) if (k0 + s < NKS) {
#pragma unroll
                for (int m = 0; m < 2; ++m)
#pragma unroll
                    for (int n = 0; n < 4; ++n) acc[m][n] = MFMA16(bw[s][n], a[s][m], acc[m][n]); }
        }
#pragma unroll
        for (int m = 0; m < 2; ++m)
#pragma unroll
            for (int n = 0; n < 4; ++n) *(LAS f32x4*)(part + wave * 2048 + (16 * m + fr) * 64 + 16 * n + 4 * fq) = acc[m][n];
        __syncthreads();
        {
            const int row = tid >> 4, c4 = tid & 15, r = MP + 32 * rb + row;
            f32x4 v = (f32x4){0.f, 0.f, 0.f, 0.f}, v2 = (f32x4){0.f, 0.f, 0.f, 0.f};
#pragma unroll
            for (int w = 0; w < 8; ++w) { v += *(const LAS f32x4*)(part + w * 2048 + row * 64 + 4 * c4); if (EP == SK_UP) v2 += *(const LAS f32x4*)(part + w * 2048 + row * 64 + ((4 * c4 + 32) & 63)); }
            const float* ADA = (const float*)(p.ws + WS_ADA) + (size_t)ada_row(r) * 6144;
            if (EP == SK_Z) { *(f32x4*)((float*)(p.ws + WS_Z) + (size_t)r * INP + cb * 64 + 4 * c4) = v; }
            if (EP == SK_GLU) { const int col = cb * 64 + 4 * c4; const f32x4 s = *(const f32x4*)((const float*)(p.ws + WS_SF) + (size_t)r * 512 + col); const f32x4 bv = *(const f32x4*)(p.b_glu + col);
                f32x4 o; o.x = s.x * sigmoid_f(v.x + bv.x); o.y = s.y * sigmoid_f(v.y + bv.y); o.z = s.z * sigmoid_f(v.z + bv.z); o.w = s.w * sigmoid_f(v.w + bv.w);
                *(f32x4*)((float*)(p.ws + WS_S2) + (size_t)r * 512 + col) = o; }
            if (EP == SK_OUT) { const int col = cb * 64 + 4 * c4;
                *(f32x4*)((float*)(p.ws + WS_X1) + (size_t)r * D + col) = *(const f32x4*)(p.xs + (size_t)(r - MP) * D + col) + *(const f32x4*)(ADA + 2 * D + col) * v; }
            if (EP == SK_UP) { if (c4 < 8) { u32x2 o; o.x = pk2(silu_f(v.x) * v2.x, silu_f(v.y) * v2.y); o.y = pk2(silu_f(v.z) * v2.z, silu_f(v.w) * v2.w);
                *(u32x2*)((bf16*)(p.ws + WS_FF) + (size_t)r * DFF + cb * 32 + 4 * c4) = o; } }
            if (EP == SK_DOWN) { const int col = cb * 64 + 4 * c4;
                *(f32x4*)(p.out + O_YS + (size_t)(r - MP) * D + col) = *(const f32x4*)((const float*)(p.ws + WS_X1) + (size_t)r * D + col) + *(const f32x4*)(ADA + 5 * D + col) * v; }
        }
        __syncthreads();
    }
}

struct EpiInproj {
    static constexpr bool PERM = false, AFTER_DRAIN = false;
    float* out; bf16 *QB, *KB, *VB; float *GATES, *U; const float *ROPE, *q_g, *k_g; LAS float* red;
    __device__ __forceinline__ void operator()(const pg8::f32x4 (&acc)[2][2][4][2], const pg8::Unit& u, int wr, int wc, int fr, int fq) const {
        const int pn = u.pn, row0 = u.pm * 256 + wr * 64 + fr;
        if (pn >= 5) {
#pragma unroll
            for (int ai = 0; ai < 2; ++ai)
#pragma unroll
                for (int m = 0; m < 4; ++m) { const int r = row0 + ai * 128 + m * 16;
#pragma unroll
                    for (int bj = 0; bj < 2; ++bj)
#pragma unroll
                        for (int n = 0; n < 2; ++n) { const int zc = pn * 256 + bj * 128 + wc * 32 + n * 16 + 4 * fq; const pg8::f32x4 v = acc[ai][bj][m][n];
                            if (zc < O3) { pg8::f32x4 g; g[0] = sigmoid_f(v[0]); g[1] = sigmoid_f(v[1]); g[2] = sigmoid_f(v[2]); g[3] = sigmoid_f(v[3]); *(pg8::f32x4*)(GATES + (size_t)r * 24 + (zc - O2)) = g; }
                            else if (zc < INC) *(pg8::f32x4*)(U + (size_t)r * SW + (zc - O3)) = v; } }
            return;
        }
        const bool qtile = pn < 2; const int br = pn - 2;
        LAS float* rw = red + (wr * 64 + fr) * 8 + wc; LAS float* rx = red + (wr * 64 + fr) * 8 + (wc ^ 1);
#pragma unroll
        for (int ai = 0; ai < 2; ++ai)
#pragma unroll
            for (int m = 0; m < 4; ++m)
#pragma unroll
                for (int bj = 0; bj < 2; ++bj) { if (bj == 1 && !qtile) continue;
                    const pg8::f32x4 a = acc[ai][bj][m][0], c = acc[ai][bj][m][1];
                    float s = (a[0] * a[0] + a[1] * a[1]) + (a[2] * a[2] + a[3] * a[3]) + (c[0] * c[0] + c[1] * c[1]) + (c[2] * c[2] + c[3] * c[3]);
                    { const auto r16 = __builtin_amdgcn_permlane16_swap(__float_as_uint(s), __float_as_uint(s), false, false); s = __uint_as_float(r16[0]) + __uint_as_float(r16[1]); }
                    { const auto r32 = __builtin_amdgcn_permlane32_swap(__float_as_uint(s), __float_as_uint(s), false, false); s = __uint_as_float(r32[0]) + __uint_as_float(r32[1]); }
                    if (fq == 0) rw[(ai * 128 + m * 16) * 8 + bj * 4] = s; }
        asm volatile("s_waitcnt lgkmcnt(0)" ::: "memory"); __builtin_amdgcn_s_barrier(); asm volatile("" ::: "memory");
        const int hc = 32 * (wc & 1) + 4 * fq;
        const int b = (u.pm * 256) / SEQ;
        const float* gp = qtile ? q_g : k_g + br * 64;
        const pg8::f32x4 g0 = *(const pg8::f32x4*)(gp + hc), g1 = *(const pg8::f32x4*)(gp + hc + 16);
        const bool rot = (wc & 1) == 0;
        pg8::f32x4 csn = {0.f, 0.f, 0.f, 0.f}, snn = {0.f, 0.f, 0.f, 0.f};
        if (rot) { const int t0r = (u.pm * 256 + wr * 64 + fr) % SEQ; csn = *(const pg8::f32x4*)(ROPE + (size_t)t0r * 16 + 4 * (fq & 1)); snn = *(const pg8::f32x4*)(ROPE + (size_t)t0r * 16 + 8 + 4 * (fq & 1)); }
#pragma unroll
        for (int ai = 0; ai < 2; ++ai)
#pragma unroll
            for (int m = 0; m < 4; ++m) {
                const int rl = ai * 128 + wr * 64 + m * 16 + fr, r = u.pm * 256 + rl, t = r % SEQ;
                const pg8::f32x4 cs = csn, sn = snn;
                if (rot && (ai * 4 + m) < 7) { const int itn = ai * 4 + m + 1, tn = (u.pm * 256 + (itn >> 2) * 128 + wr * 64 + (itn & 3) * 16 + fr) % SEQ;
                    csn = *(const pg8::f32x4*)(ROPE + (size_t)tn * 16 + 4 * (fq & 1)); snn = *(const pg8::f32x4*)(ROPE + (size_t)tn * 16 + 8 + 4 * (fq & 1)); }
#pragma unroll
                for (int bj = 0; bj < 2; ++bj) {
                    pg8::f32x4 y0 = acc[ai][bj][m][0], y1 = acc[ai][bj][m][1];
                    const bool normed = qtile || bj == 0;
                    if (normed) {
                        const float ss = rw[(ai * 128 + m * 16) * 8 + bj * 4] + rx[(ai * 128 + m * 16) * 8 + bj * 4];
                        const float rstd = 1.0f / sqrtf(ss * (1.0f / 64.0f) + EPS);
                        y0 = y0 * rstd * g0; y1 = y1 * rstd * g1;
                        if (rot) {
#pragma unroll
                            for (int j = 0; j < 4; ++j) { const float own = y0[j];
                                const auto rr = __builtin_amdgcn_permlane32_swap(__float_as_uint(own), __float_as_uint(own), false, false);
                                const float pr = __uint_as_float(fq >= 2 ? rr[0] : rr[1]);
                                y0[j] = fq < 2 ? own * cs[j] - pr * sn[j] : pr * sn[j] + own * cs[j]; }
                        }
                    }
                    if (qtile) {
                        const float qs = 0.125f * 1.4426950408889634f;
                        bf16* qp = QB + ((size_t)(b * 2 + pn) * SEQ + t) * 256 + (2 * bj + (wc >> 1)) * 64 + hc;
                        u32x2 o0, o1; o0.x = pk2(y0[0] * qs, y0[1] * qs); o0.y = pk2(y0[2] * qs, y0[3] * qs); o1.x = pk2(y1[0] * qs, y1[1] * qs); o1.y = pk2(y1[2] * qs, y1[3] * qs);
                        *(u32x2*)qp = o0; *(u32x2*)(qp + 16) = o1;
                    } else {
                        const int kc = bj * 128 + (wc >> 1) * 64 + hc;
                        float* op = br == 0 ? out + O_KVC_P + (size_t)r * 256 : br == 1 ? out + O_KVS_P + (size_t)r * 256 : (t >= SEQ - 512 ? out + O_KVW_P + (size_t)(b * 512 + t - (SEQ - 512)) * 256 : nullptr);
                        if (op) { *(pg8::f32x4*)(op + kc) = y0; *(pg8::f32x4*)(op + kc + 16) = y1; }
                        if (br > 0) { bf16* kp = (bj ? VB : KB) + ((size_t)(((br - 1) * NBP + b) * 2 + (wc >> 1)) * SEQ + t) * 64 + hc;
                            u32x2 o0, o1; o0.x = pk2(y0[0], y0[1]); o0.y = pk2(y0[2], y0[3]); o1.x = pk2(y1[0], y1[1]); o1.y = pk2(y1[2], y1[3]);
                            *(u32x2*)kp = o0; *(u32x2*)(kp + 16) = o1; }
                    }
                }
                asm volatile("" ::: "memory");
            }
    }
};

enum { PH_PREP = 0, PH_H, PH_INPROJ, PH_SSM1, PH_CMPGEMM, PH_ATTN, PH_MIXIN, PH_OUT, PH_H2, PH_UP, PH_DOWN, PH_N };
constexpr int BAR_LDS_OFF = 148 * 1024;
constexpr int CW_BAR = 4096;

template <int PH>
__device__ __forceinline__ void run_phase(const P& p, LAS unsigned char* lds) {
    unsigned char* ws = p.ws;
    if constexpr (PH == PH_PREP) ph_prep(p, lds);
    if constexpr (PH == PH_H) { ph_normmod<0>(p); ph_cmpf<0>(p, lds); }
    if constexpr (PH == PH_INPROJ) { pg8::Gemm g{(const bf16*)(ws + WS_H), (const bf16*)(ws + WS_WIN_T), MP, INP, D}; pg8::StaticOrder S; S.init(MP, INP, gridDim.x, blockIdx.x);
        EpiInproj E{p.out, (bf16*)(ws + WS_QB), (bf16*)(ws + WS_KB), (bf16*)(ws + WS_VB), (float*)(ws + WS_GATES), (float*)(ws + WS_U), (const float*)(ws + WS_ROPE), p.q_g, p.k_g, (LAS float*)(lds + 132 * 1024)};
        pg8::gemm_phase<EpiInproj, pg8::StaticOrder>(lds, g, S, E, nullptr);
        skinny_gemm<SK_Z, 1024>(p, lds, (const bf16*)(ws + WS_H) + (size_t)MP * D, (const bf16*)(ws + WS_WIN_T), 29, 0); }
    if constexpr (PH == PH_SSM1) { ph_split(p, lds); __syncthreads(); ph_ssm<1>(p, lds, 0, (int)gridDim.x, 0, NBP * NSG * NCH, 1 << 30, 0); }
    if constexpr (PH == PH_CMPGEMM) {
        constexpr int NP = NBP * NSG * NCH, NS = DB * NSG;
        if (gridDim.x == 256) {
            if (blockIdx.x < 64) { ph_cmpf_small(p, lds, blockIdx.x); __syncthreads(); ph_ssm<2>(p, lds, 0, 64, NP - 512, NP, 1 << 30, 0); }
            else ph_ssm<2>(p, lds, 64, 256, 0, NP - 512 + NS, NP - 512, 512);
        } else { for (int u = blockIdx.x; u < 64; u += gridDim.x) { ph_cmpf_small(p, lds, u); } __syncthreads(); ph_ssm<2>(p, lds, 0, (int)gridDim.x, 0, NP + NS, 1 << 30, 0); } }
    if constexpr (PH == PH_ATTN) { ph_attn_prompt(p, lds); __syncthreads(); ph_attn_sample(p, lds); __syncthreads();
        { pg8::Gemm g{(const bf16*)(ws + WS_SB), (const bf16*)(ws + WS_WGLU_T), MP, 512, 512}; pg8::StaticOrder S; S.init(MP, 512, gridDim.x, blockIdx.x);
        EpiGlu E{(const float*)(ws + WS_SF), (float*)(ws + WS_S2), p.b_glu}; pg8::gemm_phase<EpiGlu, pg8::StaticOrder>(lds, g, S, E, nullptr);
        skinny_gemm<SK_GLU, 512>(p, lds, (const bf16*)(ws + WS_SB) + (size_t)MP * 512, (const bf16*)(ws + WS_WGLU_T), 8, (int)gridDim.x / 2); }
        __syncthreads();
        ph_late_transposes(p, lds, (int)gridDim.x / 2, (int)gridDim.x); }
    if constexpr (PH == PH_MIXIN) ph_mixin(p);
    if constexpr (PH == PH_OUT) { pg8::Gemm g{(const bf16*)(ws + WS_MIX), (const bf16*)(ws + WS_WOUT_T), MP, D, D}; pg8::StaticOrder S; S.init(MP, D, gridDim.x, blockIdx.x);
        EpiOut E{p.xp, p.xs, (const float*)(ws + WS_ADA), (float*)(ws + WS_X1)}; pg8::gemm_phase<EpiOut, pg8::StaticOrder>(lds, g, S, E, nullptr);
        skinny_gemm<SK_OUT, 1024>(p, lds, (const bf16*)(ws + WS_MIX) + (size_t)MP * D, (const bf16*)(ws + WS_WOUT_T), 16, 0); }
    if constexpr (PH == PH_H2) ph_normmod<1>(p);
    if constexpr (PH == PH_UP) { pg8::Gemm g{(const bf16*)(ws + WS_H), (const bf16*)(ws + WS_WUP_T), MP, 2 * DFF, D}; pg8::StaticOrder S; S.init(MP, 2 * DFF, gridDim.x, blockIdx.x);
        EpiUp E{(bf16*)(ws + WS_FF)}; pg8::gemm_phase<EpiUp, pg8::StaticOrder>(lds, g, S, E, nullptr);
        skinny_gemm<SK_UP, 1024>(p, lds, (const bf16*)(ws + WS_H) + (size_t)MP * D, (const bf16*)(ws + WS_WUP_T), 88, (int)gridDim.x / 2); }
    if constexpr (PH == PH_DOWN) { pg8::Gemm g{(const bf16*)(ws + WS_FF), (const bf16*)(ws + WS_WDN_T), MP, D, DFF}; pg8::StaticOrder S; S.init(MP, D, gridDim.x, blockIdx.x);
        EpiDown E{(const float*)(ws + WS_X1), (const float*)(ws + WS_ADA), p.out}; pg8::gemm_phase<EpiDown, pg8::StaticOrder>(lds, g, S, E, nullptr);
        skinny_gemm<SK_DOWN, 2816>(p, lds, (const bf16*)(ws + WS_FF) + (size_t)MP * DFF, (const bf16*)(ws + WS_WDN_T), 16, 0); }
}

#ifndef REPMASK
#define REPMASK 0u
#endif
template <int PH, int HI>
__device__ __forceinline__ void run_from(const P& p, LAS unsigned char* lds, const XcdBarrier& bar) {
    run_phase<PH>(p, lds);
    if constexpr (((REPMASK) >> PH) & 1u) { xcd_barrier(bar); run_phase<PH>(p, lds); }
    if constexpr (PH + 1 < HI) { xcd_barrier(bar); run_from<PH + 1, HI>(p, lds, bar); }
}

template <int LO, int HI>
__global__ void __launch_bounds__(512, 2) k_fwd(P p) {
    extern __shared__ __attribute__((aligned(16))) unsigned char lds_raw[];
    LAS unsigned char* lds = (LAS unsigned char*)lds_raw;
    if (threadIdx.x < 4) ((LAS unsigned*)(lds + BAR_LDS_OFF))[threadIdx.x] = 0u;
    __syncthreads();
    XcdBarrier bar; bar.bar = (unsigned*)(p.ws + WS_CTL) + CW_BAR; bar.x = 0; bar.st = (volatile LAS unsigned*)(lds + BAR_LDS_OFF);
    if constexpr (HI - LO > 1) bar = xcd_barrier_post((unsigned*)(p.ws + WS_CTL) + CW_BAR, (volatile LAS unsigned*)(lds + BAR_LDS_OFF));
    run_from<LO, HI>(p, lds, bar);
}

extern "C" void kernel_launch(void* const* d_in, const int* in_sizes, int n_in, void* d_out, int out_size, void* d_ws, size_t ws_size, hipStream_t stream) {
    if (n_in != 39 || (size_t)out_size != O_END || ws_size < WS_END) { fprintf(stderr, "kernel_launch: unexpected shapes (n_in %d out %d ws %zu need %zu)\n", n_in, out_size, ws_size, (size_t)WS_END); return; }
    static int grid = 0;
    if (grid == 0) {
        int dev = 0, cus = 0, per_cu = 0;
        if (hipGetDevice(&dev) != hipSuccess || hipDeviceGetAttribute(&cus, hipDeviceAttributeMultiprocessorCount, dev) != hipSuccess) { fprintf(stderr, "kernel_launch: device query failed\n"); grid = -1; return; }
        if (hipFuncSetAttribute((const void*)k_fwd<0, PH_N>, hipFuncAttributeMaxDynamicSharedMemorySize, LDS_BYTES) != hipSuccess) { fprintf(stderr, "kernel_launch: hipFuncSetAttribute failed\n"); grid = -1; return; }
        if (hipOccupancyMaxActiveBlocksPerMultiprocessor(&per_cu, (const void*)k_fwd<0, PH_N>, 512, LDS_BYTES) != hipSuccess || per_cu < 1) { fprintf(stderr, "kernel_launch: occupancy query says %d blocks per CU\n", per_cu); (void)hipGetLastError(); grid = -1; return; }
        grid = cus;
    }
    if (grid < 0) return;
    P p{};
    p.xp = (const float*)d_in[0]; p.xs = (const float*)d_in[1]; p.cache_c = (const float*)d_in[2]; p.cache_s = (const float*)d_in[3]; p.cache_w = (const float*)d_in[4];
    p.st_re = (const float*)d_in[5]; p.st_im = (const float*)d_in[6]; p.pt = (const int*)d_in[7]; p.cp = (const float*)d_in[8]; p.cs = (const float*)d_in[9];
    p.norm_mix_g = (const float*)d_in[10]; p.w_ada = (const float*)d_in[11]; p.b_ada = (const float*)d_in[12]; p.w_in = (const float*)d_in[13]; p.q_g = (const float*)d_in[14]; p.k_g = (const float*)d_in[15];
    p.pe_k = (const float*)d_in[16]; p.w1_k = (const float*)d_in[17]; p.w2_k = (const float*)d_in[18]; p.pe_v = (const float*)d_in[19]; p.w1_v = (const float*)d_in[20]; p.w2_v = (const float*)d_in[21];
    p.a_re = (const float*)d_in[22]; p.a_im = (const float*)d_in[23]; p.log_dt = (const float*)d_in[24]; p.b_re = (const float*)d_in[25]; p.b_im = (const float*)d_in[26]; p.c_re = (const float*)d_in[27]; p.c_im = (const float*)d_in[28];
    p.ssm_d = (const float*)d_in[29]; p.w_glu = (const float*)d_in[30]; p.b_glu = (const float*)d_in[31]; p.attn_g = (const float*)d_in[32]; p.ssm_g = (const float*)d_in[33]; p.w_out = (const float*)d_in[34];
    p.norm_ffn_g = (const float*)d_in[35]; p.w_gate = (const float*)d_in[36]; p.w_up = (const float*)d_in[37]; p.w_down = (const float*)d_in[38];
    p.out = (float*)d_out; p.ws = (unsigned char*)d_ws;
    if (hipMemsetAsync((char*)d_ws + WS_CTL, 0, (size_t)(CW_BAR + XCD_BAR_WORDS) * 4, stream) != hipSuccess) { fprintf(stderr, "kernel_launch: memset failed\n"); return; }
    hipLaunchKernelGGL((k_fwd<0, PH_N>), dim3(grid), dim3(512), LDS_BYTES, stream, p);
}
```

```cpp
#include <hip/hip_runtime.h>
#include <cstdio>
#include <cstdint>
#include <cstddef>

namespace pg8 {
#define PG8_LAS __attribute__((address_space(3)))
typedef unsigned short bf16_t;
typedef short bf16x8 __attribute__((ext_vector_type(8)));
typedef float f32x4 __attribute__((ext_vector_type(4)));
typedef unsigned u32x4 __attribute__((ext_vector_type(4)));
constexpr int BM = 256, BK = 64, HALF = 128, HTB = HALF * BK * 2  , STAGE_BYTES = 8 * HTB, NXCD = 8, WGM = 8;

__host__ __device__ __forceinline__ int lds_byte(int r, int c) { const int st = (r >> 4) * 2 + (c >> 5), rr = r & 15, cc = c & 31, ob = rr * 64 + cc * 2; return st * 1024 + (ob ^ (((ob >> 9) & 1) << 5)); }
__host__ __device__ __forceinline__ void stage_rc(int b, int& R, int& C) { const int st = b / 1024, sb = b % 1024, swz = sb ^ (((sb >> 9) & 1) << 5); R = (st >> 1) * 16 + swz / 64; C = (st & 1) * 32 + (swz % 64) / 2; }
__host__ __device__ __forceinline__ int perm32(int rho) { const int n = rho >> 4, i = rho & 15; return 8 * (i >> 2) + 4 * n + (i & 3); }

struct Unit { int pm, pn; };
struct Gemm { const bf16_t* A; const bf16_t* Bt; int M, N, K; };

struct StaticOrder {
    int nM, nN, nwg, G, c;
    __host__ __device__ void init(int M, int N, int G_, int c_) { nM = M / BM; nN = N / BM; nwg = nM * nN; G = G_; c = c_; }
    __host__ __device__ bool next(int i, Unit& u) const {
        const long L = (long)i * G + c; if (L >= nwg) return false;
        int wgid = (int)L; { const int q = nwg / NXCD, r = nwg % NXCD, xcd = wgid % NXCD, off = wgid / NXCD; wgid = (xcd < r ? xcd * (q + 1) : r * (q + 1) + (xcd - r) * q) + off; }
        const int nig = WGM * nN, gid = wgid / nig, fm = gid * WGM, gsz = (nM - fm) < WGM ? (nM - fm) : WGM;
        u.pm = fm + ((wgid % nig) % gsz); u.pn = (wgid % nig) / gsz; return true;
    }
    __device__ __forceinline__ void a_ready(const Unit&) const {}
    __device__ __forceinline__ void done(const Unit&) const {}
};
__device__ __forceinline__ unsigned cvt_pk_bf16(float lo, float hi) { unsigned r; asm volatile("v_cvt_pk_bf16_f32 %0, %1, %2" : "=v"(r) : "v"(lo), "v"(hi)); return r; }
typedef float f32x2 __attribute__((ext_vector_type(2)));
struct EpiF32 {
    static constexpr bool PERM = false, AFTER_DRAIN = false;
    float* C; int ldc; const float* bias;
    __device__ __forceinline__ void operator()(const f32x4 (&acc)[2][2][4][2], const Unit& u, int wr, int wc, int fr, int fq) const {
        const int row0 = u.pm * BM + wr * 64 + fr, col0 = u.pn * BM + wc * 32 + 4 * fq;
        f32x4 bv[2][2];
#pragma unroll
        for (int bj = 0; bj < 2; ++bj)
#pragma unroll
            for (int n = 0; n < 2; ++n) bv[bj][n] = bias ? *(const f32x4*)(bias + col0 + bj * HALF + n * 16) : (f32x4){0.f, 0.f, 0.f, 0.f};
#pragma unroll
        for (int ai = 0; ai < 2; ++ai)
#pragma unroll
            for (int m = 0; m < 4; ++m) { float* rowp = C + (size_t)(row0 + ai * HALF + m * 16) * ldc + col0;
#pragma unroll
                for (int bj = 0; bj < 2; ++bj)
#pragma unroll
                    for (int n = 0; n < 2; ++n) *(f32x4*)(rowp + bj * HALF + n * 16) = acc[ai][bj][m][n] + bv[bj][n]; }
    }
};
template <class Epi, class Sched, bool STAMP = false>
__device__ __forceinline__ void gemm_phase(PG8_LAS unsigned char* lds, const Gemm g, const Sched& S, const Epi& E, unsigned long long* stamps) {
    int tid_ = threadIdx.x; asm volatile("" : "+v"(tid_));
    const int tid = tid_, wid = __builtin_amdgcn_readfirstlane(tid >> 6), lane = tid & 63, wr = wid >> 2, wc = wid & 3, fr = lane & 15, fq = lane >> 4;
    const int K = g.K, nt = K / BK;
    int ts_lo = 0, ts_hi = 0, nts = 0; const unsigned long long rt_entry = STAMP ? (unsigned long long)wall_clock64() : 0ull;
#define PG8_STAMP() do { if (STAMP && wid == 0 && nts < 64) { const unsigned long long _c = (unsigned long long)clock64(); \
        ts_lo = (lane == nts) ? (int)(unsigned)_c : ts_lo; ts_hi = (lane == nts) ? (int)(unsigned)(_c >> 32) : ts_hi; ++nts; } } while (0)
    PG8_STAMP();
    unsigned voffA[2], voffB[2];
#pragma unroll
    for (int i = 0; i < 2; ++i) { int R, C; stage_rc(tid * 16 + i * 8192, R, C); const int Rb = Epi::PERM ? ((R & ~31) + perm32(R & 31)) : R;
        voffA[i] = (unsigned)(R * K + C) * 2u; voffB[i] = (unsigned)(Rb * K + C) * 2u; }
    const size_t kstep = (size_t)(BK * 2);
    const size_t hstep = (size_t)HALF * K * 2;
    const size_t tstep = 2 * hstep;
    const unsigned ldsw = (unsigned)wid * 1024u;
    const int aoff = lds_byte(wr * 64 + fr, fq * 8), boff = lds_byte(wc * 32 + fr, fq * 8);
#define PG8_SA(b, h) (((b) * 2 + (h)) * HTB)
#define PG8_SB(b, h) ((4 + (b) * 2 + (h)) * HTB)
#define PG8_STAGE(bufoff, gbase, voff) do { _Pragma("unroll") for (int _i = 0; _i < 2; ++_i) \
        __builtin_amdgcn_global_load_lds((const unsigned*)((const char*)(gbase) + (voff)[_i]), (PG8_LAS unsigned*)(lds + (bufoff) + ldsw + _i * 8192), 16, 0, 0); } while (0)
#define PG8_LDA(dst, b, h) do { _Pragma("unroll") for (int m = 0; m < 4; ++m) _Pragma("unroll") for (int k = 0; k < 2; ++k) dst[m][k] = *(const PG8_LAS bf16x8*)(lds + PG8_SA(b, h) + aoff + m * 2048 + k * 1024); } while (0)
#define PG8_LDB(dst, b, h) do { _Pragma("unroll") for (int n = 0; n < 2; ++n) _Pragma("unroll") for (int k = 0; k < 2; ++k) dst[n][k] = *(const PG8_LAS bf16x8*)(lds + PG8_SB(b, h) + boff + n * 2048 + k * 1024); } while (0)
#define PG8_MMA(ai, bj, At, Bt) do { __builtin_amdgcn_s_setprio(1); _Pragma("unroll") for (int m = 0; m < 4; ++m) _Pragma("unroll") for (int n = 0; n < 2; ++n) _Pragma("unroll") for (int k = 0; k < 2; ++k) \
        acc[ai][bj][m][n] = __builtin_amdgcn_mfma_f32_16x16x32_bf16(Bt[n][k], At[m][k], acc[ai][bj][m][n], 0, 0, 0); __builtin_amdgcn_s_setprio(0); } while (0)
#define PG8_WAIT_V(n) asm volatile("s_waitcnt vmcnt(" #n ")" ::: "memory")
#define PG8_WAIT_L(n) asm volatile("s_waitcnt lgkmcnt(" #n ")" ::: "memory")
#define PG8_BAR __builtin_amdgcn_s_barrier()
#define PG8_SCHED __builtin_amdgcn_sched_barrier(0)
    Unit cur, nxt; int ui = 0;
    if (!S.next(0, cur)) return;
    f32x4 acc[2][2][4][2];
#pragma unroll
    for (int a = 0; a < 2; ++a)
#pragma unroll
        for (int b = 0; b < 2; ++b)
#pragma unroll
            for (int m = 0; m < 4; ++m)
#pragma unroll
                for (int n = 0; n < 2; ++n) acc[a][b][m][n] = (f32x4){0.f, 0.f, 0.f, 0.f};
    bf16x8 At[4][2], B0[2][2], B1[2][2];
    const char* cA = (const char*)g.A + (size_t)cur.pm * tstep; const char* cB = (const char*)g.Bt + (size_t)cur.pn * tstep;
    S.a_ready(cur);
    PG8_STAGE(PG8_SB(0, 0), cB, voffB); PG8_STAGE(PG8_SA(0, 0), cA, voffA); PG8_STAGE(PG8_SB(0, 1), cB + hstep, voffB); PG8_STAGE(PG8_SA(0, 1), cA + hstep, voffA);
    if (wr == 1) PG8_BAR;
    PG8_WAIT_V(4); PG8_BAR;
    PG8_STAGE(PG8_SB(1, 0), cB + kstep, voffB); PG8_STAGE(PG8_SA(1, 0), cA + kstep, voffA); PG8_STAGE(PG8_SB(1, 1), cB + hstep + kstep, voffB);
    PG8_WAIT_V(6); PG8_BAR;
    PG8_STAMP();
    for (;;) {
        const bool has_next = S.next(ui + 1, nxt);
        const char* nA = has_next ? (const char*)g.A + (size_t)nxt.pm * tstep : cA; const char* nB = has_next ? (const char*)g.Bt + (size_t)nxt.pn * tstep : cB;
        for (int t = 0; t < nt; t += 2) {
            const bool last = (t == nt - 2);
            const char* a1 = cA + (size_t)(t + 1) * kstep;
            const char* a2 = last ? nA : cA + (size_t)(t + 2) * kstep; const char* b2 = last ? nB : cB + (size_t)(t + 2) * kstep;
            const char* a3 = a2 + kstep; const char* b3 = b2 + kstep;
            if (last && has_next) S.a_ready(nxt);
            PG8_LDB(B0, 0, 0); PG8_SCHED; PG8_LDA(At, 0, 0); PG8_STAGE(PG8_SA(1, 1), a1 + hstep, voffA);
            PG8_WAIT_L(8); PG8_BAR; PG8_WAIT_L(0); PG8_MMA(0, 0, At, B0); PG8_BAR; PG8_SCHED;
            PG8_LDB(B1, 0, 1); PG8_STAGE(PG8_SB(0, 0), b2, voffB);
            PG8_BAR; PG8_WAIT_L(0); PG8_MMA(0, 1, At, B1); PG8_BAR;
            PG8_LDA(At, 0, 1); PG8_STAGE(PG8_SA(0, 0), a2, voffA);
            PG8_BAR; PG8_WAIT_L(0); PG8_MMA(1, 0, At, B0); PG8_BAR; PG8_SCHED;
            PG8_STAGE(PG8_SB(0, 1), b2 + hstep, voffB);
            PG8_WAIT_V(6); PG8_BAR; PG8_MMA(1, 1, At, B1); PG8_BAR;
            PG8_LDB(B0, 1, 0); PG8_SCHED; PG8_LDA(At, 1, 0); PG8_STAGE(PG8_SA(0, 1), a2 + hstep, voffA);
            PG8_WAIT_L(8); PG8_BAR; PG8_WAIT_L(0); PG8_MMA(0, 0, At, B0); PG8_BAR; PG8_SCHED;
            PG8_LDB(B1, 1, 1); PG8_STAGE(PG8_SB(1, 0), b3, voffB);
            PG8_BAR; PG8_WAIT_L(0); PG8_MMA(0, 1, At, B1); PG8_BAR;
            PG8_LDA(At, 1, 1); PG8_STAGE(PG8_SA(1, 0), a3, voffA);
            PG8_BAR; PG8_WAIT_L(0); PG8_MMA(1, 0, At, B0); PG8_BAR; PG8_SCHED;
            PG8_STAGE(PG8_SB(1, 1), b3 + hstep, voffB);
            PG8_WAIT_V(6); PG8_BAR; PG8_MMA(1, 1, At, B1); PG8_BAR;
        }
        PG8_STAMP();
        if constexpr (!Epi::AFTER_DRAIN) { E(acc, cur, wr, wc, fr, fq); S.done(cur); }
        PG8_STAMP();
        if (!has_next) break;
#pragma unroll
        for (int a = 0; a < 2; ++a)
#pragma unroll
            for (int b = 0; b < 2; ++b)
#pragma unroll
                for (int m = 0; m < 4; ++m)
#pragma unroll
                    for (int n = 0; n < 2; ++n) acc[a][b][m][n] = (f32x4){0.f, 0.f, 0.f, 0.f};
        cur = nxt; cA = nA; cB = nB; ++ui;
    }
    PG8_WAIT_V(0);
    if (wr == 0) PG8_BAR;
    PG8_BAR;
    if constexpr (Epi::AFTER_DRAIN) { E.fused(acc, cur, wr, wc, fr, fq, lds, wid, lane); S.done(cur); }
    PG8_STAMP();
    if (STAMP && wid == 0) { stamps[lane] = lane < nts ? (((unsigned long long)(unsigned)ts_hi << 32) | (unsigned)ts_lo) : 0ull;
        if (lane == 62) stamps[62] = rt_entry; if (lane == 63) stamps[63] = (unsigned long long)wall_clock64(); }
#undef PG8_STAMP
#undef PG8_SA
#undef PG8_SB
#undef PG8_STAGE
#undef PG8_LDA
#undef PG8_LDB
#undef PG8_MMA
#undef PG8_WAIT_V
#undef PG8_WAIT_L
#undef PG8_BAR
#undef PG8_SCHED
}
}

#define LAS __attribute__((address_space(3)))
typedef unsigned short bf16;
typedef float f32x4 __attribute__((ext_vector_type(4)));
typedef unsigned u32x4 __attribute__((ext_vector_type(4)));
typedef unsigned u32x2 __attribute__((ext_vector_type(2)));

constexpr int D = 1024, SEQ = 8192, NBP = 2, MP = NBP * SEQ;
constexpr int DB = 32, DSQ = 4, MS = DB * DSQ, MR = MP + MS;
constexpr int MPAD = 16640;
constexpr int PAST = 16384, PAGE = 128, NPG = 128;
constexpr int HD = 64, AW = 512, NH = 8, GQ = 4, NKV = 2;
constexpr int SW = 512, SG = 16, NSG = 32, SST = 64;
constexpr int INC = 1816, INP = 2048, O1 = 512, O2 = 1280, O3 = 1304;
constexpr int DFF = 2816;
constexpr int NC_P = 511, NC_S = 1023;
constexpr int CMP_ROWS_S = DB * 1024 * 2, CMP_ROWS_P = NBP * 512 * 2, CMP_ROWS = CMP_ROWS_S + CMP_ROWS_P;
constexpr int CMPO_S = DB * NC_S * 2 * 64, CMPO_P = NBP * NC_P * 2 * 64, CMPO = CMPO_S + CMPO_P;
constexpr float EPS = 1e-6f;
constexpr int SCH = 128, NCH = SEQ / SCH;

constexpr size_t O_YP = 0, O_YS = 16777216, O_KVC_P = 16908288, O_KVS_P = 21102592, O_KVW_P = 25296896, O_SRE_P = 25559040, O_SIM_P = 25563136,
                 O_KVC_S = 25567232, O_KVS_S = 25600000, O_KVW_S = 25632768, O_SRE_S = 25665536, O_SIM_S = 25731072, O_END = 25796608;

constexpr size_t A256(size_t x) { return (x + 255) & ~(size_t)255; }
constexpr size_t WS_CTL    = 0;
constexpr size_t WS_ADA    = (size_t)1 << 20;
constexpr size_t WS_LB     = WS_ADA + A256((size_t)34 * 6144 * 4);
constexpr size_t WS_BBR    = WS_LB + A256(2048 * 2 * 4);
constexpr size_t WS_BBI    = WS_BBR + A256(2048 * 16 * 4);
constexpr size_t WS_PEB    = WS_BBI + A256(2048 * 16 * 4);
constexpr size_t WS_WIN_T  = WS_PEB + A256(2 * 8 * 128 * 4);
constexpr size_t WS_WGLU_T = WS_WIN_T + (size_t)2048 * 1024 * 2;
constexpr size_t WS_WOUT_T = WS_WGLU_T + (size_t)512 * 512 * 2;
constexpr size_t WS_WUP_T  = WS_WOUT_T + (size_t)1024 * 1024 * 2;
constexpr size_t WS_WDN_T  = WS_WUP_T + (size_t)5632 * 1024 * 2;
constexpr size_t WS_WC1_T  = WS_WDN_T + (size_t)1024 * 2816 * 2;
constexpr size_t WS_H      = WS_WC1_T + (size_t)2 * 256 * 1024 * 2;
constexpr size_t WS_Z      = WS_H + (size_t)MPAD * 1024 * 2;
constexpr size_t WS_Q      = WS_Z + (size_t)MPAD * 2048 * 4;
constexpr size_t WS_KV3    = WS_Q + (size_t)MR * 512 * 4;
constexpr size_t WS_GATES  = WS_KV3 + (size_t)3 * MR * 256 * 4;
constexpr size_t WS_U      = WS_GATES + A256((size_t)MR * 24 * 4);
constexpr size_t WS_ACMP   = WS_U + (size_t)MR * 512 * 4;
constexpr size_t WS_PC     = WS_ACMP + (size_t)2 * CMP_ROWS * 1024 * 2;
constexpr size_t WS_CMPKV  = WS_PC + (size_t)2 * CMP_ROWS * 256 * 4;
constexpr size_t WS_E      = WS_CMPKV + A256((size_t)2 * CMPO * 4);
constexpr size_t WS_SF     = WS_E + (size_t)NBP * NSG * NCH * 64 * 2 * 4;
constexpr size_t WS_SB     = WS_SF + (size_t)MPAD * 512 * 4;
constexpr size_t WS_ATTN   = WS_SB + (size_t)MPAD * 512 * 2;
constexpr size_t WS_S2     = WS_ATTN + (size_t)MR * 512 * 4;
constexpr size_t WS_MIX    = WS_S2 + (size_t)MPAD * 512 * 4;
constexpr size_t WS_X1     = WS_MIX + (size_t)MPAD * 1024 * 2;
constexpr size_t WS_FF     = WS_X1 + (size_t)MPAD * 1024 * 4;
constexpr size_t WS_QB     = WS_FF + (size_t)MPAD * 2816 * 2;
constexpr size_t WS_KB     = WS_QB + (size_t)NBP * 2 * SEQ * 256 * 2;
constexpr size_t WS_VB     = WS_KB + (size_t)2 * NBP * 2 * SEQ * 64 * 2;
constexpr size_t WS_KCB    = WS_VB + (size_t)2 * NBP * 2 * SEQ * 64 * 2;
constexpr size_t WS_ROPE   = WS_KCB + (size_t)2 * NBP * 2 * 512 * 64 * 2;
constexpr size_t WS_END    = WS_ROPE + (size_t)SEQ * 16 * 4;

constexpr int LDS_BYTES = 150 * 1024;

struct P {
    const float *xp, *xs, *cache_c, *cache_s, *cache_w, *st_re, *st_im; const int* pt;
    const float *cp, *cs, *norm_mix_g, *w_ada, *b_ada, *w_in, *q_g, *k_g, *pe_k, *w1_k, *w2_k, *pe_v, *w1_v, *w2_v;
    const float *a_re, *a_im, *log_dt, *b_re, *b_im, *c_re, *c_im, *ssm_d, *w_glu, *b_glu, *attn_g, *ssm_g, *w_out, *norm_ffn_g, *w_gate, *w_up, *w_down;
    float* out; unsigned char* ws;
};

__device__ __forceinline__ int tid_now() { int t = threadIdx.x; asm volatile("" : "+v"(t)); return t; }
__device__ __forceinline__ unsigned pk2(float lo, float hi) { unsigned r; asm("v_cvt_pk_bf16_f32 %0, %1, %2" : "=v"(r) : "v"(lo), "v"(hi)); return r; }
__device__ __forceinline__ unsigned f2bf(float f) { return pk2(f, 0.f) & 0xffffu; }
template <int CTRL> __device__ __forceinline__ float dpp_mov(float v) { return __int_as_float(__builtin_amdgcn_update_dpp(0, __float_as_int(v), CTRL, 0xF, 0xF, true)); }
__device__ __forceinline__ float wave_sum(float v) {
    v += dpp_mov<0xB1>(v); v += dpp_mov<0x4E>(v); v += dpp_mov<0x141>(v); v += dpp_mov<0x140>(v);
    const float a = __int_as_float(__builtin_amdgcn_readlane(__float_as_int(v), 0)), b = __int_as_float(__builtin_amdgcn_readlane(__float_as_int(v), 16));
    const float c = __int_as_float(__builtin_amdgcn_readlane(__float_as_int(v), 32)), d = __int_as_float(__builtin_amdgcn_readlane(__float_as_int(v), 48));
    return (a + b) + (c + d);
}
__device__ __forceinline__ float wave_max(float v) {
    v = fmaxf(v, dpp_mov<0xB1>(v)); v = fmaxf(v, dpp_mov<0x4E>(v)); v = fmaxf(v, dpp_mov<0x141>(v)); v = fmaxf(v, dpp_mov<0x140>(v));
    const float a = __int_as_float(__builtin_amdgcn_readlane(__float_as_int(v), 0)), b = __int_as_float(__builtin_amdgcn_readlane(__float_as_int(v), 16));
    const float c = __int_as_float(__builtin_amdgcn_readlane(__float_as_int(v), 32)), d = __int_as_float(__builtin_amdgcn_readlane(__float_as_int(v), 48));
    return fmaxf(fmaxf(a, b), fmaxf(c, d));
}
__device__ __forceinline__ float rdlane(float v, int l) { return __int_as_float(__builtin_amdgcn_readlane(__float_as_int(v), l)); }
__device__ __forceinline__ float sigmoid_f(float x) { return 1.0f / (1.0f + expf(-x)); }
__device__ __forceinline__ float silu_f(float x) { return x / (1.0f + expf(-x)); }
__device__ __forceinline__ float gelu_tanh(float x) {
    const float y = 0.7978845608028654f * (x + 0.044715f * x * x * x);
    const float t = 1.0f - 2.0f / (expf(2.0f * y) + 1.0f);
    return 0.5f * x * (1.0f + t);
}
__device__ __forceinline__ void sincos_d(double x, double& s, double& c) {
    const double k = rint(x * 0.63661977236758134308);
    double y = fma(-k, 1.57079632679489655800e+00, x);
    y = fma(-k, 6.12323399573676603587e-17, y);
    const double y2 = y * y;
    double sp = 1.0 / 355687428096000.0;
    sp = fma(sp, y2, -1.0 / 1307674368000.0); sp = fma(sp, y2, 1.0 / 6227020800.0); sp = fma(sp, y2, -1.0 / 39916800.0); sp = fma(sp, y2, 1.0 / 362880.0);
    sp = fma(sp, y2, -1.0 / 5040.0); sp = fma(sp, y2, 1.0 / 120.0); sp = fma(sp, y2, -1.0 / 6.0); sp = fma(sp, y2, 1.0);
    const double sy = sp * y;
    double cp = 1.0 / 20922789888000.0;
    cp = fma(cp, y2, -1.0 / 87178291200.0); cp = fma(cp, y2, 1.0 / 479001600.0); cp = fma(cp, y2, -1.0 / 3628800.0); cp = fma(cp, y2, 1.0 / 40320.0);
    cp = fma(cp, y2, -1.0 / 720.0); cp = fma(cp, y2, 1.0 / 24.0); cp = fma(cp, y2, -0.5); cp = fma(cp, y2, 1.0);
    const double cy = cp;
    const int q = (int)((long long)k & 3);
    s = (q == 0) ? sy : (q == 1) ? cy : (q == 2) ? -sy : -cy;
    c = (q == 0) ? cy : (q == 1) ? -sy : (q == 2) ? -cy : sy;
}
__device__ __forceinline__ const float* xrow_ptr(const P& p, int r) { return r < MP ? p.xp + (size_t)r * D : p.xs + (size_t)(r - MP) * D; }
__device__ __forceinline__ int ada_row(int r) { return r < MP ? r / SEQ : 2 + (r - MP) / DSQ; }

__device__ __forceinline__ void transpose_item(const float* W, int ldw, int nvalid, bf16* WT, int ldt, int kb, int nb, int rowmode, int rowoff, LAS float* scr, int lane) {
    const int k0 = 64 * kb, n0 = 32 * nb;
    { float v[32]; const int nn = n0 + (lane & 31);
#pragma unroll
      for (int i = 0; i < 32; ++i) v[i] = nn < nvalid ? __builtin_nontemporal_load(W + (size_t)(k0 + 2 * i + (lane >> 5)) * ldw + nn) : 0.f;
#pragma unroll
      for (int i = 0; i < 32; ++i) scr[(2 * i + (lane >> 5)) * 33 + (lane & 31)] = v[i]; }
    asm volatile("s_waitcnt lgkmcnt(0)" ::: "memory");
    const int c = lane & 7;
#pragma unroll
    for (int j = 0; j < 4; ++j) { const int n = (lane >> 3) + 8 * j, nn = n0 + n; const LAS float* s = scr + (8 * c) * 33 + n;
        u32x4 o; o.x = pk2(s[0 * 33], s[1 * 33]); o.y = pk2(s[2 * 33], s[3 * 33]); o.z = pk2(s[4 * 33], s[5 * 33]); o.w = pk2(s[6 * 33], s[7 * 33]);
        if (nn < nvalid) { const int drow = rowmode ? ((nn >> 7) * 256 + rowoff + (nn & 127)) : (rowoff + nn);
            *(u32x4*)(WT + (size_t)drow * ldt + k0 + 8 * c) = o; } }
    asm volatile("s_waitcnt lgkmcnt(0)" ::: "memory");
}

constexpr int PREP_JOBS = 224;
__device__ __forceinline__ f32x4 peb_load(const float* PEB, int kv, int col) {
    f32x4 s = *(const f32x4*)(PEB + (kv * 8) * 128 + col);
#pragma unroll
    for (int q = 1; q < 8; ++q) s += *(const f32x4*)(PEB + (kv * 8 + q) * 128 + col);
    return s;
}
__device__ __forceinline__ void ph_prep(const P& p, LAS unsigned char* lds) {
    const int tid = tid_now(), lane = tid & 63, wave = tid >> 6;
    unsigned char* ws = p.ws;
    for (int job = blockIdx.x; job < PREP_JOBS; job += gridDim.x) {
        if (job < 192) {
            LAS float* cbuf = (LAS float*)lds;
            { f32x4 cv[17];
#pragma unroll
              for (int it = 0; it < 17; ++it) { const int i = tid + it * 512, r = i >> 8, k4 = i & 255;
                  const float* src = r < 2 ? p.cp + r * D : p.cs + (r - 2) * D; cv[it] = *(const f32x4*)(src + k4 * 4); }
#pragma unroll
              for (int it = 0; it < 17; ++it) { const int i = tid + it * 512; f32x4 v = cv[it];
                  v.x = silu_f(v.x); v.y = silu_f(v.y); v.z = silu_f(v.z); v.w = silu_f(v.w);
                  *(LAS f32x4*)(cbuf + i * 4) = v; } }
            __syncthreads();
            const int c0 = job * 32, col = lane & 31, kh = lane >> 5, kbase = wave * 128 + kh * 64;
            float acc[34];
#pragma unroll
            for (int r = 0; r < 34; ++r) acc[r] = 0.f;
            const float* ub = p.w_ada + (size_t)(__builtin_amdgcn_readfirstlane(wave) * 128) * 6144 + c0;
            const unsigned voff = (unsigned)(kh * 64 * 6144 + col) * 4u;
            LAS const float* cb0 = cbuf + kbase; asm volatile("" : "+v"(cb0));
            LAS const float* cb1 = cb0 + 16 * D; asm volatile("" : "+v"(cb1));
            LAS const float* cb2 = cb0 + 32 * D; asm volatile("" : "+v"(cb2));
#pragma unroll
            for (int hb = 0; hb < 2; ++hb) {
                float wv[32];
#pragma unroll
                for (int k = 0; k < 32; ++k) wv[k] = __builtin_nontemporal_load((const float*)((const char*)(ub + (size_t)(hb * 32 + k) * 6144) + voff));
                asm volatile("" ::: "memory");
#pragma unroll
                for (int k4 = 0; k4 < 8; ++k4) {
#pragma unroll
                    for (int r = 0; r < 34; ++r) { const f32x4 cv = *(const LAS f32x4*)((r < 16 ? cb0 + r * D : r < 32 ? cb1 + (r - 16) * D : cb2 + (r - 32) * D) + hb * 32 + k4 * 4);
                        acc[r] += cv.x * wv[4 * k4] + cv.y * wv[4 * k4 + 1] + cv.z * wv[4 * k4 + 2] + cv.w * wv[4 * k4 + 3]; }
                    asm volatile("" ::: "memory");
                }
            }
            __syncthreads();
            LAS float* red = (LAS float*)lds;
#pragma unroll
            for (int r = 0; r < 34; ++r) red[((wave * 2 + kh) * 34 + r) * 32 + col] = acc[r];
            __syncthreads();
            float* ADA = (float*)(ws + WS_ADA);
            for (int o = tid; o < 34 * 32; o += 512) { const int r = o >> 5, c = o & 31; float s = p.b_ada[c0 + c];
#pragma unroll
                for (int w = 0; w < 16; ++w) s += red[(w * 34 + r) * 32 + c];
                ADA[(size_t)r * 6144 + c0 + c] = s; }
            __syncthreads();
        } else if (job < 208) {
            const int kv = (job - 192) >> 3, part = (job - 192) & 7; const float* pe = kv ? p.pe_v : p.pe_k; const float* w1 = kv ? p.w1_v : p.w1_k;
            float a0 = 0.f, a1 = 0.f;
#pragma unroll 1
            for (int kb = 0; kb < 2; ++kb) { const int k0 = part * 256 + wave * 32 + kb * 16; float x0[16], x1[16], pv[16];
#pragma unroll
                for (int u = 0; u < 16; ++u) { pv[u] = pe[k0 + u]; x0[u] = w1[(size_t)(k0 + u) * 128 + lane]; x1[u] = w1[(size_t)(k0 + u) * 128 + 64 + lane]; }
#pragma unroll
                for (int u = 0; u < 16; ++u) { a0 += pv[u] * x0[u]; a1 += pv[u] * x1[u]; } }
            LAS float* red = (LAS float*)lds;
            red[wave * 128 + lane] = a0; red[wave * 128 + 64 + lane] = a1;
            __syncthreads();
            if (tid < 128) { float s = 0.f;
#pragma unroll
                for (int w = 0; w < 8; ++w) s += red[w * 128 + tid];
                ((float*)(ws + WS_PEB))[(kv * 8 + part) * 128 + tid] = s; }
            __syncthreads();
        } else {
            const int sj = job - 208;
            float* LB = (float*)(ws + WS_LB); float* BBR = (float*)(ws + WS_BBR); float* BBI = (float*)(ws + WS_BBI);
            LAS double* fb = (LAS double*)lds;
            if (tid < 128) { const int idx = sj * 128 + tid, g = idx >> 6;
                const double dt = exp((double)p.log_dt[g]), are = (double)p.a_re[idx], aim = (double)p.a_im[idx];
                const double mag = exp(are * dt); double sn, cs; sincos_d(aim * dt, sn, cs);
                const double lbr = mag * cs, lbi = mag * sn, den = are * are + aim * aim, nre = lbr - 1.0;
                LB[idx * 2] = (float)lbr; LB[idx * 2 + 1] = (float)lbi;
                fb[tid * 2] = (nre * are + lbi * aim) / den; fb[tid * 2 + 1] = (lbi * are - nre * aim) / den; }
            __syncthreads();
#pragma unroll
            for (int it = 0; it < 4; ++it) { const int e = tid + it * 512, il = e >> 4, o = sj * 128 * SG + e;
                const double fre = fb[il * 2], fim = fb[il * 2 + 1], br = (double)p.b_re[o], bi = (double)p.b_im[o];
                BBR[o] = (float)(fre * br - fim * bi); BBI[o] = (float)(fre * bi + fim * br); }
            __syncthreads();
        }
    }
    __syncthreads();
    { float* ROPE = (float*)(ws + WS_ROPE);
      for (int idx = blockIdx.x * 512 + tid; idx < SEQ * 8; idx += gridDim.x * 512) { const int pos = idx >> 3, i = idx & 7;
          const double inv = exp(-(double)i * 1.640295422175541); double sd, cd; sincos_d((double)pos * inv, sd, cd);
          ROPE[pos * 16 + i] = (float)cd; ROPE[pos * 16 + 8 + i] = (float)sd; } }
    LAS float* scr = (LAS float*)(lds + wave * 8448);
    constexpr int I0 = 16 * 57, I1 = 8 * 16, I6 = 16 * 4;
    constexpr int NT = I0 + I1 + 4 * I6;
    const int it0 = (int)blockIdx.x * 8 + wave, step = (int)gridDim.x * 8, lim = NT;
    for (int it = it0; it < lim; it += step) {
        int r = it;
        if (r < I0) { transpose_item(p.w_in, INC, INC, (bf16*)(ws + WS_WIN_T), 1024, r / 57, r % 57, 0, 0, scr, lane); continue; } r -= I0;
        if (r < I1) { transpose_item(p.w_glu, 512, 512, (bf16*)(ws + WS_WGLU_T), 512, r / 16, r % 16, 0, 0, scr, lane); continue; } r -= I1;
        { const int m = r / I6, rr = r % I6, kv = m >> 1, half = m & 1; const float* w1 = kv ? p.w1_v : p.w1_k;
          transpose_item(w1 + (size_t)half * 1024 * 128, 128, 128, (bf16*)(ws + WS_WC1_T) + (size_t)kv * 256 * 1024, 1024, rr / 4, rr % 4, 0, half * 128, scr, lane); }
    }
}
__device__ __forceinline__ void ph_late_transposes(const P& p, LAS unsigned char* lds, int wg_lo, int wg_hi) {
    const int tid = tid_now(), lane = tid & 63, wave = tid >> 6;
    if ((int)blockIdx.x < wg_lo || (int)blockIdx.x >= wg_hi) return;
    unsigned char* ws = p.ws;
    LAS float* scr = (LAS float*)(lds + wave * 8448);
    constexpr int I2 = 16 * 32, I3 = 16 * 88, I5 = 44 * 32;
    constexpr int NT = I2 + 2 * I3 + I5;
    for (int it = ((int)blockIdx.x - wg_lo) * 8 + wave; it < NT; it += (wg_hi - wg_lo) * 8) {
        int r = it;
        if (r < I2) { transpose_item(p.w_out, 1024, 1024, (bf16*)(ws + WS_WOUT_T), 1024, r / 32, r % 32, 0, 0, scr, lane); continue; } r -= I2;
        if (r < I3) { transpose_item(p.w_gate, DFF, DFF, (bf16*)(ws + WS_WUP_T), 1024, r / 88, r % 88, 1, 0, scr, lane); continue; } r -= I3;
        if (r < I3) { transpose_item(p.w_up, DFF, DFF, (bf16*)(ws + WS_WUP_T), 1024, r / 88, r % 88, 1, 128, scr, lane); continue; } r -= I3;
        transpose_item(p.w_down, 1024, 1024, (bf16*)(ws + WS_WDN_T), DFF, r / 32, r % 32, 0, 0, scr, lane);
    }
}

template <int WHICH>
__device__ __forceinline__ void ph_normmod(const P& p) {
    const int tid = tid_now(), lane = tid & 63, wave = tid >> 6, gw = blockIdx.x * 8 + wave, NGW = gridDim.x * 8;
    const float* ADA = (const float*)(p.ws + WS_ADA); const float* gain = WHICH ? p.norm_ffn_g : p.norm_mix_g;
    bf16* H = (bf16*)(p.ws + WS_H);
    int cur = -1; f32x4 mul[4], add[4];
#pragma unroll
    for (int j = 0; j < 4; ++j) { mul[j] = (f32x4){0.f, 0.f, 0.f, 0.f}; add[j] = mul[j]; }
    for (int r0 = gw; r0 < MR; r0 += 4 * NGW) {
        f32x4 v[4][4];
#pragma unroll
        for (int i = 0; i < 4; ++i) { const int r = r0 + i * NGW < MR ? r0 + i * NGW : r0;
            const float* src = WHICH ? (const float*)(p.ws + WS_X1) + (size_t)r * D : xrow_ptr(p, r);
#pragma unroll
            for (int j = 0; j < 4; ++j) { if (WHICH == 0) v[i][j] = __builtin_nontemporal_load((const f32x4*)(src + 4 * (lane + 64 * j))); else v[i][j] = *(const f32x4*)(src + 4 * (lane + 64 * j)); } }
#pragma unroll
        for (int i = 0; i < 4; ++i) { const int r = r0 + i * NGW; if (r >= MR) break;
            const int arow = ada_row(r);
            if (arow != cur) { cur = arow; const float* ar = ADA + (size_t)arow * 6144; const float* sh = ar + (WHICH ? 3 : 0) * D; const float* sc = ar + (WHICH ? 4 : 1) * D;
#pragma unroll
                for (int j = 0; j < 4; ++j) { const int c = 4 * (lane + 64 * j); const f32x4 g = *(const f32x4*)(gain + c), s1 = *(const f32x4*)(sc + c); mul[j] = g * (s1 + 1.0f); add[j] = *(const f32x4*)(sh + c); } }
            float ss = 0.f;
#pragma unroll
            for (int j = 0; j < 4; ++j) ss += (v[i][j].x * v[i][j].x + v[i][j].y * v[i][j].y) + (v[i][j].z * v[i][j].z + v[i][j].w * v[i][j].w);
            const float rstd = 1.0f / sqrtf(wave_sum(ss) * (1.0f / D) + EPS);
#pragma unroll
            for (int j = 0; j < 4; ++j) { const int c = 4 * (lane + 64 * j);
                const f32x4 y = (v[i][j] * rstd) * mul[j] + add[j];
                u32x2 o; o.x = pk2(y.x, y.y); o.y = pk2(y.z, y.w);
                *(u32x2*)(H + (size_t)r * D + c) = o; } }
    }
}

__device__ __forceinline__ void ph_split(const P& p, LAS unsigned char* lds) {
    const int tid = tid_now(), lane = tid & 63, wave = tid >> 6, gw = blockIdx.x * 8 + wave, NGW = gridDim.x * 8;
    LAS float* zrow = (LAS float*)(lds + wave * 7424);
    const float* Z = (const float*)(p.ws + WS_Z); float* Q = (float*)(p.ws + WS_Q); float* KV3 = (float*)(p.ws + WS_KV3);
    float* GATES = (float*)(p.ws + WS_GATES); float* U = (float*)(p.ws + WS_U);
    bf16* QB = (bf16*)(p.ws + WS_QB); bf16* KB = (bf16*)(p.ws + WS_KB); bf16* VB = (bf16*)(p.ws + WS_VB);
    const float qg = p.q_g[lane];
    for (int tk = gw; tk < 4 * (MR - MP); tk += NGW) {
        const int r = MP + (tk >> 2), q4 = tk & 3;
        const float* zr = Z + (size_t)r * INP;
        for (int i = lane; i < INC / 4; i += 64) *(LAS f32x4*)(zrow + 4 * i) = *(const f32x4*)(zr + 4 * i);
        const int pos = r < MP ? (r % SEQ) : PAST + ((r - MP) % DSQ);
        float cs, sn;
        { const double inv = exp(-(double)(lane & 7) * 1.640295422175541); double sd, cd; sincos_d((double)pos * inv, sd, cd); cs = (float)cd; sn = (float)sd; }
        float *oc, *os, *ow;
        if (r < MP) { const int b = r / SEQ, t = r % SEQ; oc = p.out + O_KVC_P + (size_t)r * 256; os = p.out + O_KVS_P + (size_t)r * 256;
            ow = t >= SEQ - 512 ? p.out + O_KVW_P + (size_t)(b * 512 + t - (SEQ - 512)) * 256 : nullptr; }
        else { const int s = r - MP; oc = p.out + O_KVC_S + (size_t)s * 256; os = p.out + O_KVS_S + (size_t)s * 256; ow = p.out + O_KVW_S + (size_t)s * 256; }
        asm volatile("s_waitcnt lgkmcnt(0)" ::: "memory");
        for (int hh = q4; hh < 14; hh += 4) {
            int off; float gain;
            if (hh < 8) { off = hh * 64; gain = qg; }
            else { const int kk = hh - 8, br = kk >> 1, g = kk & 1; off = O1 + br * 256 + g * 64; gain = p.k_g[br * 64 + lane]; }
            const float v = zrow[off + lane];
            const float ss = wave_sum(v * v);
            float y = v * (1.0f / sqrtf(ss * (1.0f / 64.0f) + EPS)) * gain;
            const float pr = __shfl_xor(y, 8);
            if (lane < 8) y = y * cs - pr * sn; else if (lane < 16) y = pr * sn + y * cs;
            if (hh < 8) { if (r >= MP) Q[(size_t)r * AW + hh * 64 + lane] = y;
                if (r < MP) QB[((size_t)((r / SEQ) * 2 + (hh >> 2)) * SEQ + (r % SEQ)) * 256 + (hh & 3) * 64 + lane] = (bf16)f2bf(y * (0.125f * 1.4426950408889634f)); }
            else { const int kk = hh - 8, br = kk >> 1, g = kk & 1;
                if (r >= MP) KV3[((size_t)br * MR + r) * 256 + g * 64 + lane] = y;
                if (r < MP && br > 0) KB[((size_t)(((br - 1) * NBP + r / SEQ) * 2 + g) * SEQ + (r % SEQ)) * 64 + lane] = (bf16)f2bf(y);
                float* o = br == 0 ? oc : br == 1 ? os : ow; if (o) o[g * 64 + lane] = y; }
        }
#pragma unroll
        for (int br = 0; br < 3; ++br)
#pragma unroll
            for (int g = 0; g < 2; ++g) { if (((br * 2 + g) & 3) != q4) continue; const float v = zrow[O1 + br * 256 + 128 + g * 64 + lane];
                if (r >= MP) KV3[((size_t)br * MR + r) * 256 + 128 + g * 64 + lane] = v;
                if (r < MP && br > 0) VB[((size_t)(((br - 1) * NBP + r / SEQ) * 2 + g) * SEQ + (r % SEQ)) * 64 + lane] = (bf16)f2bf(v);
                float* o = br == 0 ? oc : br == 1 ? os : ow; if (o) o[128 + g * 64 + lane] = v; }
        if (q4 == 1 && lane < 24) GATES[(size_t)r * 24 + lane] = sigmoid_f(zrow[O2 + lane]);
        if (q4 == 3) for (int i = lane; i < SW / 4; i += 64) *(f32x4*)(U + (size_t)r * SW + 4 * i) = *(const LAS f32x4*)(zrow + O3 + 4 * i);
        asm volatile("s_waitcnt lgkmcnt(0)" ::: "memory");
    }
}

template <int PART> __device__ __forceinline__ void ph_cmp_build(const P& p) {
    const int tid = tid_now(), lane = tid & 63, wave = tid >> 6, gw = blockIdx.x * 8 + wave, NGW = gridDim.x * 8;
    bf16* A = (bf16*)(p.ws + WS_ACMP); const float* KVC = (const float*)(p.ws + WS_KV3);
    const int seg = lane >> 4, kvi = seg >> 1, g = seg & 1, d4 = (lane & 15) * 4;
    constexpr int NIS = DB * PAST / 64, NIP = MP / 64, NI = NIS + NIP;
    for (int it = (PART ? NIS : 0) + gw; it < (PART ? NI : NIS); it += NGW) {
        const float* src; size_t arow0;
        if (it < NIS) { const int b = it / (PAST / 64), h64 = it % (PAST / 64), t0 = h64 * 64; const int page = p.pt[b * NPG + t0 / PAGE];
            src = p.cache_c + ((size_t)page * PAGE + (t0 % PAGE)) * 256; arow0 = (size_t)(b * 1024 + t0 / 16) * 2; }
        else { const int r0 = (it - NIS) * 64, b = r0 / SEQ, t0 = r0 % SEQ; src = KVC + (size_t)r0 * 256; arow0 = (size_t)CMP_ROWS_S + (size_t)(b * 512 + t0 / 16) * 2; }
#pragma unroll 1
        for (int c = 0; c < 4; ++c) {
            f32x4 v[16];
#pragma unroll
            for (int tok = 0; tok < 16; ++tok) v[tok] = *(const f32x4*)(src + (size_t)(c * 16 + tok) * 256 + 4 * lane);
            bf16* dst = A + ((size_t)kvi * CMP_ROWS + arow0 + 2 * c + g) * 1024 + d4;
#pragma unroll
            for (int tok = 0; tok < 16; ++tok) { u32x2 o; o.x = pk2(v[tok].x, v[tok].y); o.y = pk2(v[tok].z, v[tok].w); *(u32x2*)(dst + tok * 64) = o; }
        }
    }
}

__device__ __forceinline__ void ph_cmp_out(const P& p, LAS unsigned char* lds) {
    const int tid = tid_now(), lane = tid & 63, wave = tid >> 6, gw = blockIdx.x * 8 + wave, NGW = gridDim.x * 8;
    LAS float* w2s = (LAS float*)lds;
    for (int i = tid; i < 2 * 128 * 64; i += 512) w2s[i] = i < 8192 ? p.w2_k[i] : p.w2_v[i - 8192];
    __syncthreads();
    const float* PC = (const float*)(p.ws + WS_PC); const float* PEB = (const float*)(p.ws + WS_PEB); float* CK = (float*)(p.ws + WS_CMPKV);
    bf16* KCB = (bf16*)(p.ws + WS_KCB);
    constexpr int NOS = DB * NC_S * 2, NOP = NBP * NC_P * 2, NO = NOS + NOP;
    auto srcrow = [&](int it, int& kv, int& o, size_t& dst) -> const float* {
        kv = it / NO; o = it % NO; size_t ra;
        if (o < NOS) { const int b = o / (NC_S * 2), rem = o % (NC_S * 2), i = rem >> 1, g = rem & 1; ra = (size_t)(b * 1024 + i) * 2 + g; dst = (size_t)o * 64; }
        else { const int o2 = o - NOS, b = o2 / (NC_P * 2), rem = o2 % (NC_P * 2), i = rem >> 1, g = rem & 1; ra = (size_t)CMP_ROWS_S + (size_t)(b * 512 + i) * 2 + g; dst = (size_t)CMPO_S + (size_t)o2 * 64; }
        return PC + ((size_t)kv * CMP_ROWS + ra) * 256; };
    float x0 = 0.f, x1 = 0.f, x2 = 0.f, x3 = 0.f;
    if (gw < 2 * NO) { int kv, o; size_t dst; const float* pa = srcrow(gw, kv, o, dst); x0 = pa[lane]; x1 = pa[512 + 128 + lane]; x2 = pa[64 + lane]; x3 = pa[512 + 192 + lane]; }
    for (int it = gw; it < 2 * NO; it += NGW) {
        int kv, o; size_t dst; (void)srcrow(it, kv, o, dst);
        const float h0 = gelu_tanh(x0 + x1 + PEB[kv * 128 + lane]);
        const float h1 = gelu_tanh(x2 + x3 + PEB[kv * 128 + 64 + lane]);
        if (it + NGW < 2 * NO) { int kv2, o2; size_t d2; const float* pa = srcrow(it + NGW, kv2, o2, d2); x0 = pa[lane]; x1 = pa[512 + 128 + lane]; x2 = pa[64 + lane]; x3 = pa[512 + 192 + lane]; }
        const LAS float* w2 = w2s + kv * 8192;
        float acc0 = 0.f, acc1 = 0.f;
#pragma unroll 8
        for (int n = 0; n < 64; ++n) { acc0 += rdlane(h0, n) * w2[n * 64 + lane]; acc1 += rdlane(h1, n) * w2[(64 + n) * 64 + lane]; }
        const float acc = acc0 + acc1;
        CK[(size_t)kv * CMPO + dst + lane] = acc;
        if (o >= NOS) { const int o2 = o - NOS, b = o2 / (NC_P * 2), rem = o2 % (NC_P * 2), i = rem >> 1, g = rem & 1;
            KCB[((size_t)((kv * NBP + b) * 2 + g) * 512 + i) * 64 + lane] = (bf16)f2bf(acc);
            if (i == 0) KCB[((size_t)((kv * NBP + b) * 2 + g) * 512 + 511) * 64 + lane] = (bf16)0; }
    }
}
#define XB_TMO      128
#define XB_XCNT(j)  (256  + 64 * (j))
#define XB_XSUB(j)  (1280 + 64 * (j))
#define XB_XGEN(j)  (2304 + 64 * (j))
#define XB_TOP      3328
#define XB_TOPGEN   3392
#define XCD_BAR_WORDS 3456
#define XB_SPIN_CAP (1u << 21)
__device__ __forceinline__ unsigned xb_ld(unsigned* p)              { return __hip_atomic_load(p, __ATOMIC_RELAXED, __HIP_MEMORY_SCOPE_AGENT); }
__device__ __forceinline__ unsigned xb_add(unsigned* p, unsigned v) { return __hip_atomic_fetch_add(p, v, __ATOMIC_RELAXED, __HIP_MEMORY_SCOPE_AGENT); }
__device__ __forceinline__ unsigned xb_xcc_id() { return (unsigned)__builtin_amdgcn_s_getreg((3 << 11) | 20) & 0xFu; }
#define XB_SPIN(cond, bar) do { unsigned _sp = 0; while (cond) { __builtin_amdgcn_s_sleep(1); \
    if ((++_sp & 255u) == 0u) { if (xb_ld(&(bar)[XB_TMO])) break; if (_sp > XB_SPIN_CAP) { atomicAdd(&(bar)[XB_TMO], 1u); break; } } } } while (0)

struct XcdBarrier {
    unsigned* bar; unsigned x;
    volatile LAS unsigned* st;
};

__device__ __forceinline__ XcdBarrier xcd_barrier_post(unsigned* bar, volatile LAS unsigned* st) {
    XcdBarrier b; b.bar = bar; b.x = xb_xcc_id(); b.st = st;
    if (threadIdx.x == 0) (void)xb_add(&bar[XB_XCNT(b.x)], 1u);
    return b;
}
__device__ __forceinline__ void xcd_barrier_complete(unsigned* bar, unsigned x, unsigned& nloc, unsigned& nx) {
    const unsigned G = gridDim.x * gridDim.y * gridDim.z;
    unsigned sum, cnt, mine, sp = 0u;
    for (;;) {
        sum = 0u; cnt = 0u; mine = 0u;
#pragma unroll
        for (unsigned j = 0; j < 16; ++j) { const unsigned c = xb_ld(&bar[XB_XCNT(j)]); sum += c; cnt += (c > 0u) ? 1u : 0u; mine = (j == x) ? c : mine; }
        if (sum == G) break;
        __builtin_amdgcn_s_sleep(1);
        if ((++sp & 255u) == 0u) { if (xb_ld(&bar[XB_TMO])) break; if (sp > XB_SPIN_CAP) { atomicAdd(&bar[XB_TMO], 1u); break; } }
    }
    nloc = mine > 0u ? mine : 1u; nx = cnt > 0u ? cnt : 1u;
}

__device__ __forceinline__ void xcd_barrier(const XcdBarrier& b) {
    asm volatile("s_waitcnt vmcnt(0)" ::: "memory");
    __syncthreads();
    if (threadIdx.x == 0) {
        unsigned* bar = b.bar;
        __builtin_amdgcn_s_waitcnt(0);
        unsigned nloc = b.st[0], nx = b.st[1];
        if (nloc == 0u) { xcd_barrier_complete(bar, b.x, nloc, nx); b.st[0] = nloc; b.st[1] = nx; }
        const unsigned old = xb_add(&bar[XB_XSUB(b.x)], 1u);
        const unsigned gen = old / nloc;
        if (old + 1u == (gen + 1u) * nloc) {
            __builtin_amdgcn_fence(__ATOMIC_RELEASE, "agent");
            asm volatile("s_waitcnt vmcnt(0)" ::: "memory");
            const unsigned og = xb_add(&bar[XB_TOP], 1u);
            const unsigned tg = og / nx;
            if (og + 1u == (tg + 1u) * nx) xb_add(&bar[XB_TOPGEN], 1u);
            else XB_SPIN(xb_ld(&bar[XB_TOPGEN]) == tg, bar);
            __builtin_amdgcn_fence(__ATOMIC_ACQUIRE, "agent");
            xb_add(&bar[XB_XGEN(b.x)], 1u);
            asm volatile("s_waitcnt vmcnt(0)" ::: "memory");
        } else {
            XB_SPIN(xb_ld(&bar[XB_XGEN(b.x)]) == gen, bar);
            __builtin_amdgcn_fence(__ATOMIC_ACQUIRE, "agent");
            asm volatile("s_waitcnt vmcnt(0)" ::: "memory");
        }
    }
    __syncthreads();
}

typedef short bf16x8 __attribute__((ext_vector_type(8)));
#define MFMA16(a, b, c) __builtin_amdgcn_mfma_f32_16x16x32_bf16(a, b, c, 0, 0, 0)
__device__ __forceinline__ unsigned cvtpk_bf16(float lo, float hi) { unsigned r; asm("v_cvt_pk_bf16_f32 %0, %1, %2" : "=v"(r) : "v"(lo), "v"(hi)); return r; }
__device__ __forceinline__ void split8(const f32x4& x0, const f32x4& x1, bf16x8& hi, bf16x8& lo) {
    u32x4 h, l;
    h.x = cvtpk_bf16(x0.x, x0.y); h.y = cvtpk_bf16(x0.z, x0.w); h.z = cvtpk_bf16(x1.x, x1.y); h.w = cvtpk_bf16(x1.z, x1.w);
    l.x = cvtpk_bf16(x0.x - __uint_as_float(h.x << 16), x0.y - __uint_as_float(h.x & 0xffff0000u)); l.y = cvtpk_bf16(x0.z - __uint_as_float(h.y << 16), x0.w - __uint_as_float(h.y & 0xffff0000u));
    l.z = cvtpk_bf16(x1.x - __uint_as_float(h.z << 16), x1.y - __uint_as_float(h.z & 0xffff0000u)); l.w = cvtpk_bf16(x1.z - __uint_as_float(h.w << 16), x1.w - __uint_as_float(h.w & 0xffff0000u));
    hi = __builtin_bit_cast(bf16x8, h); lo = __builtin_bit_cast(bf16x8, l);
}
template <int PASS>
__device__ __forceinline__ void ph_ssm(const P& p, LAS unsigned char* lds, int wg_lo, int wg_hi, int vlo, int vhi, int vsplit, int vshift) {
    const int tid = tid_now(), lane = tid & 63, wave = tid >> 6, gw = ((int)blockIdx.x - wg_lo) * 8 + wave, NGW = (wg_hi - wg_lo) * 8;
    const float* LB = (const float*)(p.ws + WS_LB); const float* BBR = (const float*)(p.ws + WS_BBR); const float* BBI = (const float*)(p.ws + WS_BBI);
    const float* U = (const float*)(p.ws + WS_U); float* E = (float*)(p.ws + WS_E);
    float* SF = (float*)(p.ws + WS_SF); bf16* SB = (bf16*)(p.ws + WS_SB);
    LAS float* bu = (LAS float*)(lds + wave * 17920);
    LAS float* hb = bu + 16 * 132;
    LAS float* ubuf = hb + 16 * 132;
    constexpr int NIT_P = NBP * NSG * NCH, NIT = PASS == 1 ? NIT_P : NIT_P + DB * NSG;
    const int l15 = lane & 15, lq = lane >> 4, ih = 8 * (lq & 1);
    for (int vit = vlo + gw; vit < vhi; vit += NGW) {
        const int it = vit >= vsplit ? vit + vshift : vit;
        if (it >= NIT) break;
        int b, g, c, r0, ntok; const bool prompt = it < NIT_P;
        if (prompt) { c = it % NCH; g = (it / NCH) % NSG; b = it / (NCH * NSG); r0 = b * SEQ + c * SCH; ntok = SCH; }
        else { const int i2 = it - NIT_P; c = 0; g = i2 % NSG; b = i2 / NSG; r0 = MP + b * DSQ; ntok = DSQ; }
        const int sp = g * SST + lane;
        bf16x8 b1[8], b2[8];
#pragma unroll
        for (int ct = 0; ct < 8; ++ct) { const int n = 16 * ct + l15; const float* src = (ct < 4 ? BBR : BBI) + (size_t)(g * SST + (n & 63)) * SG + ih;
            bf16x8 lo; split8(*(const f32x4*)src, *(const f32x4*)(src + 4), b1[ct], lo); b2[ct] = lane < 32 ? lo : (bf16x8){0, 0, 0, 0, 0, 0, 0, 0}; }
        const float lbr = LB[sp * 2], lbi = LB[sp * 2 + 1];
        float hr = 0.f, hi = 0.f;
        if (PASS == 2) {
            if (prompt) {
                float tr = lbr, ti = lbi;
#pragma unroll
                for (int q = 0; q < 7; ++q) { const float nr = tr * tr - ti * ti, ni = 2.0f * tr * ti; tr = nr; ti = ni; }
                const float* e = E + ((size_t)((b * NSG + g) * NCH) * 64 + lane) * 2;
                for (int c0 = 0; c0 < c; c0 += 16) { float er[16], ei[16];
#pragma unroll
                    for (int u = 0; u < 16; ++u) { const int cc = c0 + u < c ? c0 + u : c - 1; er[u] = e[(size_t)cc * 128]; ei[u] = e[(size_t)cc * 128 + 1]; }
#pragma unroll
                    for (int u = 0; u < 16; ++u) if (c0 + u < c) { const float nr = tr * hr - ti * hi + er[u], ni = tr * hi + ti * hr + ei[u]; hr = nr; hi = ni; } }
            } else { hr = p.st_re[(b * NSG + g) * SST + lane]; hi = p.st_im[(b * NSG + g) * SST + lane]; }
        }
        bf16x8 ch[4], cl[4];
        f32x4 dv = (f32x4){0.f, 0.f, 0.f, 0.f};
        if (PASS == 2) {
#pragma unroll
            for (int ks = 0; ks < 4; ++ks) { const float* src = (ks < 2 ? p.c_re : p.c_im) + (size_t)(g * SG + l15) * SST + (32 * ks + 8 * lq) % 64;
                f32x4 x0 = *(const f32x4*)src, x1 = *(const f32x4*)(src + 4);
                if (ks >= 2) { x0 = -x0; x1 = -x1; }
                split8(x0, x1, ch[ks], cl[ks]); }
            dv[0] = p.ssm_d[g * SG + l15];
        }
        const int nsb = (ntok + 15) >> 4;
        for (int sb = 0; sb < nsb; ++sb) {
            const int nt = ntok - sb * 16 < 16 ? ntok - sb * 16 : 16;
            bf16x8 ua;
            { const int tl = l15 < nt ? l15 : 0; const float* up = U + (size_t)(r0 + sb * 16 + tl) * SW + g * SG + ih;
              const f32x4 x0 = *(const f32x4*)up, x1 = *(const f32x4*)(up + 4);
              bf16x8 uh, ul; split8(x0, x1, uh, ul); ua = lane < 32 ? uh : ul;
              if (PASS == 2 && lane < 32) { *(LAS f32x4*)(ubuf + l15 * 16 + ih) = x0; *(LAS f32x4*)(ubuf + l15 * 16 + ih + 4) = x1; } }
#pragma unroll
            for (int ct = 0; ct < 8; ++ct) { f32x4 d = (f32x4){0.f, 0.f, 0.f, 0.f}; d = MFMA16(ua, b1[ct], d); d = MFMA16(ua, b2[ct], d);
#pragma unroll
                for (int rg = 0; rg < 4; ++rg) bu[(4 * lq + rg) * 132 + 16 * ct + l15] = d[rg]; }
            asm volatile("s_waitcnt lgkmcnt(0)" ::: "memory");
            if (nt == 16) {
                float br[16], bi[16];
#pragma unroll
                for (int tt = 0; tt < 16; ++tt) { br[tt] = bu[tt * 132 + lane]; bi[tt] = bu[tt * 132 + 64 + lane]; }
#pragma unroll
                for (int tt = 0; tt < 16; ++tt) {
                    const float nr = lbr * hr - lbi * hi + br[tt], ni = lbr * hi + lbi * hr + bi[tt];
                    hr = nr; hi = ni;
                    if (PASS == 2) { hb[tt * 132 + lane] = hr; hb[tt * 132 + 64 + lane] = hi; }
                }
            } else
            for (int tt = 0; tt < nt; ++tt) {
                const float br = bu[tt * 132 + lane], bi = bu[tt * 132 + 64 + lane];
                const float nr = lbr * hr - lbi * hi + br, ni = lbr * hi + lbi * hr + bi;
                hr = nr; hi = ni;
                if (PASS == 2) { hb[tt * 132 + lane] = hr; hb[tt * 132 + 64 + lane] = hi; }
            }
            if (PASS == 2) {
                asm volatile("s_waitcnt lgkmcnt(0)" ::: "memory");
                f32x4 y = (f32x4){0.f, 0.f, 0.f, 0.f};
#pragma unroll
                for (int ks = 0; ks < 4; ++ks) { const LAS float* hp = hb + l15 * 132 + 32 * ks + 8 * lq;
                    const f32x4 h0 = *(const LAS f32x4*)hp, h1 = *(const LAS f32x4*)(hp + 4); bf16x8 ah, al; split8(h0, h1, ah, al);
                    y = MFMA16(ah, ch[ks], y); y = MFMA16(al, ch[ks], y); y = MFMA16(ah, cl[ks], y); }
#pragma unroll
                for (int rg = 0; rg < 4; ++rg) { const int tt = 4 * lq + rg;
                    if (tt < nt) { const int r = r0 + sb * 16 + tt; const float uv = ubuf[tt * 16 + l15];
                        const float s = gelu_tanh(y[rg] + dv[0] * uv);
                        SF[(size_t)r * SW + g * SG + l15] = s; SB[(size_t)r * SW + g * SG + l15] = (bf16)f2bf(s); } }
                asm volatile("s_waitcnt lgkmcnt(0)" ::: "memory");
            }
        }
        if (PASS == 1) { float* e = E + ((size_t)((b * NSG + g) * NCH + c) * 64 + lane) * 2; e[0] = hr; e[1] = hi; }
        else if (prompt) { if (c == NCH - 1) { p.out[O_SRE_P + (b * NSG + g) * SST + lane] = hr; p.out[O_SIM_P + (b * NSG + g) * SST + lane] = hi; } }
        else { p.out[O_SRE_S + (b * NSG + g) * SST + lane] = hr; p.out[O_SIM_S + (b * NSG + g) * SST + lane] = hi; }
    }
}

constexpr float NEGM = -1e30f;
constexpr int SA_TILE = 0;
constexpr int SA_MO = 8 * 16640;
constexpr int SA_ML = SA_MO + 8192;
constexpr int SA_PS = SA_ML + 256;
constexpr int SA_IMP = SA_PS + 1088 * 4;
constexpr int SA_SEL = SA_IMP + 320 * 4;
__device__ __forceinline__ void att_stage(const float* kp, int stride, int klo, int khi, LAS float* tile, int lane) {
#pragma unroll 1
    for (int u0 = 0; u0 < 64; u0 += 32) { float v[32];
#pragma unroll
        for (int u = 0; u < 32; ++u) v[u] = (u0 + u >= klo && u0 + u < khi) ? __builtin_nontemporal_load(kp + (ptrdiff_t)(u0 + u) * stride + lane) : 0.f;
#pragma unroll
        for (int u = 0; u < 32; ++u) tile[(u0 + u) * 65 + lane] = v[u]; }
}
__device__ __forceinline__ void att_qk(LAS float* tile, int lane, const float (&q)[4], float (&s)[4]) {
    asm volatile("s_waitcnt vmcnt(0) lgkmcnt(0)" ::: "memory");
    s[0] = 0.f; s[1] = 0.f; s[2] = 0.f; s[3] = 0.f;
#pragma unroll 8
    for (int d = 0; d < 64; ++d) { const float kv = tile[lane * 65 + d];
        s[0] += kv * rdlane(q[0], d); s[1] += kv * rdlane(q[1], d); s[2] += kv * rdlane(q[2], d); s[3] += kv * rdlane(q[3], d); }
    asm volatile("s_waitcnt lgkmcnt(0)" ::: "memory");
}
__device__ __forceinline__ void att_scores(const float* kp, int stride, int klo, int khi, LAS float* tile, int lane, const float (&q)[4], float (&s)[4]) {
    att_stage(kp, stride, klo, khi, tile, lane);
    att_qk(tile, lane, q, s);
}
__device__ __forceinline__ void att_tile(const float* kp, const float* vp, int stride, int klo, int khi, bool valid, LAS float* tile, int lane,
                                         const float (&q)[4], float (&m)[4], float (&l)[4], float (&o)[4], float (&s)[4]) {
    float pr[4];
    att_stage(kp, stride, klo, khi, tile, lane);
    float vr[64];
#pragma unroll
    for (int u = 0; u < 64; ++u) vr[u] = (u >= klo && u < khi) ? __builtin_nontemporal_load(vp + (ptrdiff_t)u * stride + lane) : 0.f;
    {
        asm volatile("s_waitcnt lgkmcnt(0)" ::: "memory");
        s[0] = 0.f; s[1] = 0.f; s[2] = 0.f; s[3] = 0.f;
#pragma unroll 8
        for (int d = 0; d < 64; ++d) { const float kv = tile[lane * 65 + d];
            s[0] += kv * rdlane(q[0], d); s[1] += kv * rdlane(q[1], d); s[2] += kv * rdlane(q[2], d); s[3] += kv * rdlane(q[3], d); }
    }
#pragma unroll
    for (int h = 0; h < 4; ++h) {
        const float sc = valid ? s[h] : NEGM;
        const float mn = fmaxf(m[h], wave_max(sc));
        const float pv = valid ? expf(sc - mn) : 0.f;
        const float al = expf(m[h] - mn);
        l[h] = l[h] * al + wave_sum(pv); o[h] *= al; m[h] = mn; pr[h] = pv;
    }
#pragma unroll
    for (int u = 0; u < 64; ++u) { o[0] += rdlane(pr[0], u) * vr[u]; o[1] += rdlane(pr[1], u) * vr[u]; o[2] += rdlane(pr[2], u) * vr[u]; o[3] += rdlane(pr[3], u) * vr[u]; }
}
__device__ __forceinline__ void sa_merge(LAS unsigned char* lds, int wave, int lane, const float (&m)[4], const float (&l)[4], const float (&o)[4], float gate, float& outv, float (&gm)[4], float (&gil)[4]) {
    LAS float* mo = (LAS float*)(lds + SA_MO); LAS float* ml = (LAS float*)(lds + SA_ML);
#pragma unroll
    for (int h = 0; h < 4; ++h) { mo[(wave * 4 + h) * 64 + lane] = o[h]; if (lane == 0) { ml[(wave * 4 + h) * 2] = m[h]; ml[(wave * 4 + h) * 2 + 1] = l[h]; } }
    __syncthreads();
#pragma unroll
    for (int h = 0; h < 4; ++h) { float M = NEGM;
#pragma unroll
        for (int w = 0; w < 8; ++w) M = fmaxf(M, ml[(w * 4 + h) * 2]);
        float L = 0.f;
#pragma unroll
        for (int w = 0; w < 8; ++w) L += ml[(w * 4 + h) * 2 + 1] * expf(ml[(w * 4 + h) * 2] - M);
        gm[h] = M; gil[h] = L > 0.f ? 1.0f / L : 0.f; }
    if (wave < 4) { float M = NEGM, il = 0.f;
#pragma unroll
        for (int h = 0; h < 4; ++h) if (h == wave) { M = gm[h]; il = gil[h]; }
        float acc = 0.f;
#pragma unroll
        for (int w = 0; w < 8; ++w) acc += mo[(w * 4 + wave) * 64 + lane] * expf(ml[(w * 4 + wave) * 2] - M);
        outv += gate * acc * il; }
    __syncthreads();
}

__device__ __forceinline__ void ph_attn_sample(const P& p, LAS unsigned char* lds) {
    const int tid = tid_now(), lane = tid & 63, wave = __builtin_amdgcn_readfirstlane(tid >> 6);
    LAS float* tile = (LAS float*)(lds + SA_TILE + wave * 16640);
    LAS float* psall = (LAS float*)(lds + SA_PS); LAS float* imp = (LAS float*)(lds + SA_IMP); LAS int* sel = (LAS int*)(lds + SA_SEL);
    const float* Q = (const float*)(p.ws + WS_Q); const float* KV3 = (const float*)(p.ws + WS_KV3); const float* GATES = (const float*)(p.ws + WS_GATES);
    const float* CK = (const float*)(p.ws + WS_CMPKV); float* ATTN = (float*)(p.ws + WS_ATTN);
    const float* KVS = KV3 + (size_t)MR * 256; const float* KVW = KV3 + (size_t)2 * MR * 256;
    for (int hw = blockIdx.x; hw < MS * 2; hw += gridDim.x) {
        const int cidx = (hw & 7) * 8 + ((hw >> 3) >> 2), qi = (hw >> 3) & 3, b = cidx >> 1, g = cidx & 1;
        const int r = MP + b * DSQ + qi, t = PAST + qi;
        float q[4];
#pragma unroll
        for (int h = 0; h < 4; ++h) q[h] = Q[(size_t)r * AW + (g * 4 + h) * 64 + lane] * 0.125f;
        const float* gt = GATES + (size_t)r * 24 + g * 12;
        float gc = 0.f, gs = 0.f, gw_ = 0.f;
        if (wave < 4) { gc = gt[wave * 3]; gs = gt[wave * 3 + 1]; gw_ = gt[wave * 3 + 2]; }
        float outv = 0.f, gm[4], gil[4], m[4], l[4], o[4];
        const float* kc = CK + (size_t)b * NC_S * 128 + g * 64; const float* vc = kc + CMPO;
#pragma unroll
        for (int h = 0; h < 4; ++h) { m[h] = NEGM; l[h] = 0.f; o[h] = 0.f; }
        float sc2[2][4];
#pragma unroll 1
        for (int ix = 0; ix < 2; ++ix) { const int ti = wave + 8 * ix, khi = NC_S - 64 * ti < 64 ? NC_S - 64 * ti : 64; float st[4];
            att_tile(kc + (size_t)ti * 64 * 128, vc + (size_t)ti * 64 * 128, 128, 0, khi, 64 * ti + lane < NC_S, tile, lane, q, m, l, o, st);
#pragma unroll
            for (int h = 0; h < 4; ++h) { sc2[0][h] = ix == 0 ? st[h] : sc2[0][h]; sc2[1][h] = st[h]; } }
        sa_merge(lds, wave, lane, m, l, o, gc, outv, gm, gil);
#pragma unroll
        for (int ix = 0; ix < 2; ++ix) { const int ti = wave + 8 * ix;
            float ps = 0.f;
            if (64 * ti + lane < NC_S) {
#pragma unroll
                for (int h = 0; h < 4; ++h) ps += expf(sc2[ix][h] - gm[h]) * gil[h]; }
            psall[ti * 64 + lane] = ps;
        }
        if (wave == 0) psall[16 * 64 + lane] = 0.f;
        __syncthreads();
        const int cur = t >> 6;
        if (tid < 320) { float v = 0.f;
            if (tid < 257) { const int c4 = 4 * tid; v = psall[c4] + psall[c4 + 1] + psall[c4 + 2] + 0.5f * psall[c4 + 3] + (tid > 0 ? 0.5f * psall[c4 - 1] : 0.f); }
            imp[tid] = v; }
        __syncthreads();
        {
            unsigned key[5];
#pragma unroll
            for (int i = 0; i < 5; ++i) { const int j = lane + 64 * i; key[i] = 0u;
                if (j < 257) key[i] = j > cur ? 1u : (j == 0 || j == cur || j == cur - 1) ? 0x7F000000u : __float_as_uint(fmaxf(imp[j], 0.f)) + 2u; }
            unsigned T = 0u;
            for (int bit = 30; bit >= 0; --bit) { const unsigned tr = T | (1u << bit); int cnt = 0;
#pragma unroll
                for (int i = 0; i < 5; ++i) cnt += __popcll(__ballot(key[i] >= tr));
                if (cnt >= 16) T = tr; }
            int ngt = 0;
#pragma unroll
            for (int i = 0; i < 5; ++i) ngt += __popcll(__ballot(key[i] > T));
            const int need = 16 - ngt; const unsigned long long below = (1ull << lane) - 1ull;
            int eqbefore = 0, rank = 0;
#pragma unroll
            for (int i = 0; i < 5; ++i) { const unsigned long long eqm = __ballot(key[i] == T);
                const bool take = key[i] > T || (key[i] == T && eqbefore + __popcll(eqm & below) < need);
                const unsigned long long tm = __ballot(take);
                if (take && wave == 0) sel[rank + __popcll(tm & below)] = lane + 64 * i;
                rank += __popcll(tm); eqbefore += __popcll(eqm); }
        }
        __syncthreads();
        float sdump[4];
#pragma unroll
        for (int h = 0; h < 4; ++h) { m[h] = NEGM; l[h] = 0.f; o[h] = 0.f; }
        for (int k = wave; k < 16; k += 8) {
            const int j = __builtin_amdgcn_readfirstlane(sel[k]);
            if (j < 256) { const int page = p.pt[b * NPG + (j >> 1)]; const float* kp = p.cache_s + ((size_t)page * PAGE + (j & 1) * 64) * 256 + g * 64;
                att_tile(kp, kp + 128, 256, 0, 64, true, tile, lane, q, m, l, o, sdump); }
            else { const float* kp = KVS + (size_t)(MP + b * DSQ) * 256 + g * 64;
                att_tile(kp, kp + 128, 256, 0, DSQ, lane <= qi, tile, lane, q, m, l, o, sdump); }
        }
        sa_merge(lds, wave, lane, m, l, o, gs, outv, gm, gil);
#pragma unroll
        for (int h = 0; h < 4; ++h) { m[h] = NEGM; l[h] = 0.f; o[h] = 0.f; }
        { const float* kp = p.cache_w + ((size_t)(b * 512 + 64 * wave)) * 256 + g * 64;
          att_tile(kp, kp + 128, 256, 0, 64, 64 * wave + lane >= qi, tile, lane, q, m, l, o, sdump); }
        if (wave == 0) { const float* kp = KVW + (size_t)(MP + b * DSQ) * 256 + g * 64;
            att_tile(kp, kp + 128, 256, 0, DSQ, lane <= qi, tile, lane, q, m, l, o, sdump); }
        sa_merge(lds, wave, lane, m, l, o, gw_, outv, gm, gil);
        if (wave < 4) ATTN[(size_t)r * AW + (g * 4 + wave) * 64 + lane] = outv;
    }
}

__device__ __forceinline__ void ph_mixin(const P& p) {
    const int tid = tid_now(), lane = tid & 63, wave = tid >> 6, gw = blockIdx.x * 8 + wave, NGW = gridDim.x * 8;
    const float* ATTN = (const float*)(p.ws + WS_ATTN); const float* S2 = (const float*)(p.ws + WS_S2); bf16* MIX = (bf16*)(p.ws + WS_MIX);
    f32x4 gn[2][2];
#pragma unroll
    for (int part = 0; part < 2; ++part)
#pragma unroll
        for (int j = 0; j < 2; ++j) gn[part][j] = *(const f32x4*)((part ? p.ssm_g : p.attn_g) + 4 * (lane + 64 * j));
    for (int r0 = gw; r0 < MR; r0 += 4 * NGW) {
        f32x4 v[4][2][2];
#pragma unroll
        for (int w = 0; w < 4; ++w) { const int r = r0 + w * NGW < MR ? r0 + w * NGW : r0;
#pragma unroll
            for (int part = 0; part < 2; ++part) { const float* src = (part ? S2 : ATTN) + (size_t)r * 512;
#pragma unroll
                for (int j = 0; j < 2; ++j) v[w][part][j] = *(const f32x4*)(src + 4 * (lane + 64 * j)); } }
#pragma unroll
        for (int w = 0; w < 4; ++w) { const int r = r0 + w * NGW; if (r >= MR) break;
#pragma unroll
            for (int part = 0; part < 2; ++part) { float ss = 0.f;
#pragma unroll
                for (int j = 0; j < 2; ++j) { const f32x4 x = v[w][part][j]; ss += (x.x * x.x + x.y * x.y) + (x.z * x.z + x.w * x.w); }
                const float rstd = 1.0f / sqrtf(wave_sum(ss) * (1.0f / 512.0f) + EPS);
#pragma unroll
                for (int j = 0; j < 2; ++j) { const int c = 4 * (lane + 64 * j); const f32x4 y = v[w][part][j] * rstd * gn[part][j];
                    u32x2 o; o.x = pk2(y.x, y.y); o.y = pk2(y.z, y.w); *(u32x2*)(MIX + (size_t)r * D + part * 512 + c) = o; } } }
    }
}

struct EpiCmp {
    static constexpr bool PERM = false, AFTER_DRAIN = false;
    float* C;
    __device__ __forceinline__ void operator()(const pg8::f32x4 (&acc)[2][2][4][2], const pg8::Unit& u, int wr, int wc, int fr, int fq) const {
        const int row0 = u.pm * 256 + wr * 64 + fr, col0 = wc * 32 + 4 * fq;
#pragma unroll
        for (int ai = 0; ai < 2; ++ai)
#pragma unroll
            for (int m = 0; m < 4; ++m) { float* rowp = C + (size_t)(row0 + ai * 128 + m * 16) * 256 + col0;
#pragma unroll
                for (int bj = 0; bj < 2; ++bj)
#pragma unroll
                    for (int n = 0; n < 2; ++n) *(pg8::f32x4*)(rowp + bj * 128 + n * 16) = acc[ai][bj][m][n]; }
    }
};
struct CmpOrder {
    int G, c;
    __device__ bool next(int i, pg8::Unit& u) const { const int L = i * G + c; if (L >= 2 * (CMP_ROWS / 256)) return false; u.pm = L; u.pn = L >= CMP_ROWS / 256 ? 1 : 0; return true; }
    __device__ __forceinline__ void a_ready(const pg8::Unit&) const {}
    __device__ __forceinline__ void done(const pg8::Unit&) const {}
};
struct EpiGlu {
    static constexpr bool PERM = false, AFTER_DRAIN = false;
    const float* SF; float* S2; const float* bias;
    __device__ __forceinline__ void operator()(const pg8::f32x4 (&acc)[2][2][4][2], const pg8::Unit& u, int wr, int wc, int fr, int fq) const {
        const int row0 = u.pm * 256 + wr * 64 + fr, col0 = u.pn * 256 + wc * 32 + 4 * fq;
#pragma unroll
        for (int ai = 0; ai < 2; ++ai)
#pragma unroll
            for (int m = 0; m < 4; ++m) { const size_t ro = (size_t)(row0 + ai * 128 + m * 16) * 512 + col0;
#pragma unroll
                for (int bj = 0; bj < 2; ++bj)
#pragma unroll
                    for (int n = 0; n < 2; ++n) { const int co = bj * 128 + n * 16; const pg8::f32x4 s = *(const pg8::f32x4*)(SF + ro + co); const pg8::f32x4 bv = *(const pg8::f32x4*)(bias + col0 + co);
                        const pg8::f32x4 t = acc[ai][bj][m][n] + bv; pg8::f32x4 o;
                        o[0] = s[0] * sigmoid_f(t[0]); o[1] = s[1] * sigmoid_f(t[1]); o[2] = s[2] * sigmoid_f(t[2]); o[3] = s[3] * sigmoid_f(t[3]);
                        *(pg8::f32x4*)(S2 + ro + co) = o; } }
    }
};
struct EpiOut {
    static constexpr bool PERM = false, AFTER_DRAIN = false;
    const float *xp, *xs, *ADA; float* X1;
    __device__ __forceinline__ void operator()(const pg8::f32x4 (&acc)[2][2][4][2], const pg8::Unit& u, int wr, int wc, int fr, int fq) const {
        const int row0 = u.pm * 256 + wr * 64 + fr, col0 = u.pn * 256 + wc * 32 + 4 * fq;
#pragma unroll
        for (int ai = 0; ai < 2; ++ai)
#pragma unroll
            for (int m = 0; m < 4; ++m) { const int r = row0 + ai * 128 + m * 16;
                if (r < MR) { const float* xr = (r < MP ? xp + (size_t)r * D : xs + (size_t)(r - MP) * D) + col0; const float* gr = ADA + (size_t)ada_row(r) * 6144 + 2 * D + col0;
#pragma unroll
                    for (int bj = 0; bj < 2; ++bj)
#pragma unroll
                        for (int n = 0; n < 2; ++n) { const int co = bj * 128 + n * 16;
                            *(pg8::f32x4*)(X1 + (size_t)r * D + col0 + co) = *(const pg8::f32x4*)(xr + co) + *(const pg8::f32x4*)(gr + co) * acc[ai][bj][m][n]; } } }
    }
};
struct EpiUp {
    static constexpr bool PERM = true, AFTER_DRAIN = false;
    bf16* FF;
    __device__ __forceinline__ void operator()(const pg8::f32x4 (&acc)[2][2][4][2], const pg8::Unit& u, int wr, int wc, int fr, int fq) const {
        const int row0 = u.pm * 256 + wr * 64 + fr, col0 = u.pn * 128 + wc * 32 + 8 * fq;
#pragma unroll
        for (int ai = 0; ai < 2; ++ai)
#pragma unroll
            for (int m = 0; m < 4; ++m) { bf16* rowp = FF + (size_t)(row0 + ai * 128 + m * 16) * DFF + col0;
                const pg8::f32x4 g0 = acc[ai][0][m][0], g1 = acc[ai][0][m][1], u0 = acc[ai][1][m][0], u1 = acc[ai][1][m][1];
                pg8::u32x4 w; w.x = pk2(silu_f(g0[0]) * u0[0], silu_f(g0[1]) * u0[1]); w.y = pk2(silu_f(g0[2]) * u0[2], silu_f(g0[3]) * u0[3]);
                w.z = pk2(silu_f(g1[0]) * u1[0], silu_f(g1[1]) * u1[1]); w.w = pk2(silu_f(g1[2]) * u1[2], silu_f(g1[3]) * u1[3]);
                *(pg8::u32x4*)rowp = w; }
    }
};
struct EpiDown {
    static constexpr bool PERM = false, AFTER_DRAIN = false;
    const float *X1, *ADA; float* out;
    __device__ __forceinline__ void operator()(const pg8::f32x4 (&acc)[2][2][4][2], const pg8::Unit& u, int wr, int wc, int fr, int fq) const {
        const int row0 = u.pm * 256 + wr * 64 + fr, col0 = u.pn * 256 + wc * 32 + 4 * fq;
#pragma unroll
        for (int ai = 0; ai < 2; ++ai)
#pragma unroll
            for (int m = 0; m < 4; ++m) { const int r = row0 + ai * 128 + m * 16;
                if (r < MR) { const float* xr = X1 + (size_t)r * D + col0; const float* gr = ADA + (size_t)ada_row(r) * 6144 + 5 * D + col0;
                    float* orow = (r < MP ? out + O_YP + (size_t)r * D : out + O_YS + (size_t)(r - MP) * D) + col0;
#pragma unroll
                    for (int bj = 0; bj < 2; ++bj)
#pragma unroll
                        for (int n = 0; n < 2; ++n) { const int co = bj * 128 + n * 16;
                            *(pg8::f32x4*)(orow + co) = *(const pg8::f32x4*)(xr + co) + *(const pg8::f32x4*)(gr + co) * acc[ai][bj][m][n]; } } }
    }
};


constexpr int CF_ABYTES = 258 * 128, CF_A0 = 0, CF_A1 = CF_ABYTES, CF_B0 = 2 * CF_ABYTES, CF_BBYTES = 256 * 128, CF_B1 = CF_B0 + CF_BBYTES;
constexpr int CF_HID = 0, CF_W2 = 66048;
__device__ __forceinline__ int cf_off(int row, int q) { return row * 128 + ((q ^ ((row >> 1) & 7)) << 4); }
__device__ __forceinline__ int cf_off2(int row, int q) { return row * 256 + ((q ^ ((row >> 1) & 7)) << 4); }

template <int PART>
__device__ __forceinline__ void ph_cmpf(const P& p, LAS unsigned char* lds) {
    const int tid = tid_now(), lane = tid & 63, wave = __builtin_amdgcn_readfirstlane(tid >> 6), fr = lane & 15, fq = lane >> 4, wr = wave >> 1, wc = wave & 1;
    const float* KVC = p.out + O_KVC_P; const bf16* WC1 = (const bf16*)(p.ws + WS_WC1_T); const float* PEB = (const float*)(p.ws + WS_PEB);
    float* CK = (float*)(p.ws + WS_CMPKV); bf16* KCB = (bf16*)(p.ws + WS_KCB);
    constexpr int NU = PART ? 16 : 512, NCH_B = PART ? 512 : 1024, NC = PART ? NC_P : NC_S;
    const int lh = lane >> 5, pc = lane & 31, ag = pc >> 4, ad = 4 * (pc & 15);
    for (int u = blockIdx.x; u < NU; u += (PART ? 16 : (int)gridDim.x)) {
        const int kv = PART ? (u >> 3) : (u >> 8), b = PART ? ((u >> 2) & 1) : ((u >> 3) & 31), c0 = (PART ? (u & 3) : (u & 7)) * 128;
        const float* abase0; const float* abase1; const float* esrc = nullptr; const bool ext = c0 + 128 < NCH_B;
        if (PART == 0) { const int pg0 = p.pt[b * NPG + ((c0 + 16 * wave) >> 3)], pg1 = p.pt[b * NPG + ((c0 + 16 * wave) >> 3) + 1];
            abase0 = p.cache_c + ((size_t)pg0 * PAGE + lh * 16) * 256 + kv * 128 + 4 * pc; abase1 = p.cache_c + ((size_t)pg1 * PAGE + lh * 16) * 256 + kv * 128 + 4 * pc;
            if (ext && tid < 32) { const int ce = c0 + 128; const int pg = p.pt[b * NPG + (ce >> 3)]; esrc = p.cache_c + ((size_t)pg * PAGE + (ce & 7) * 16) * 256 + kv * 128 + 4 * tid; } }
        else { abase0 = KVC + ((size_t)b * SEQ + (size_t)(c0 + 16 * wave + lh) * 16) * 256 + kv * 128 + 4 * pc; abase1 = abase0 + (size_t)8 * 16 * 256;
            if (ext && tid < 32) esrc = KVC + ((size_t)b * SEQ + (size_t)(c0 + 128) * 16) * 256 + kv * 128 + 4 * tid; }
        const bf16* wsrc = WC1 + ((size_t)kv * 256 + (tid >> 3)) * 1024 + (tid & 7) * 8;
        f32x4 av[8], ev; u32x4 wv[4];
        ev = (f32x4){0.f, 0.f, 0.f, 0.f};
#define CF_LOAD(tok) do { _Pragma("unroll") for (int j = 0; j < 8; ++j) av[j] = __builtin_nontemporal_load((const f32x4*)((j < 4 ? abase0 : abase1) + (size_t)(2 * (j & 3)) * 16 * 256 + (size_t)(tok) * 256)); \
            if (esrc) ev = *(const f32x4*)(esrc + (size_t)(tok) * 256); \
            _Pragma("unroll") for (int i = 0; i < 4; ++i) wv[i] = *(const u32x4*)(wsrc + (size_t)i * 64 * 1024 + (tok) * 64); } while (0)
#define CF_STORE(abuf, bbuf) do { \
            _Pragma("unroll") for (int j = 0; j < 8; ++j) { const int row_ = 2 * (16 * wave + 2 * j + lh) + ag; u32x2 o_; o_.x = pk2(av[j].x, av[j].y); o_.y = pk2(av[j].z, av[j].w); \
                *(LAS u32x2*)(lds + (abuf) + cf_off(row_, ad >> 3) + ((ad >> 2) & 1) * 8) = o_; } \
            if (tid < 32) { u32x2 o_; o_.x = pk2(ev.x, ev.y); o_.y = pk2(ev.z, ev.w); *(LAS u32x2*)(lds + (abuf) + cf_off(256 + (tid >> 4), (tid & 15) >> 1) + (tid & 1) * 8) = o_; } \
            _Pragma("unroll") for (int i = 0; i < 4; ++i) *(LAS u32x4*)(lds + (bbuf) + cf_off((tid >> 3) + 64 * i, tid & 7)) = wv[i]; } while (0)
        f32x4 acc[4][4];
#pragma unroll
        for (int m = 0; m < 4; ++m)
#pragma unroll
            for (int n = 0; n < 4; ++n) acc[m][n] = (f32x4){0.f, 0.f, 0.f, 0.f};
        CF_LOAD(0); CF_STORE(CF_A0, CF_B0);
        __syncthreads();
#pragma unroll 1
        for (int tok = 0; tok < 16; ++tok) {
            const int ab = (tok & 1) ? CF_A1 : CF_A0, bb = (tok & 1) ? CF_B1 : CF_B0;
            if (tok + 1 < 16) CF_LOAD(tok + 1);
#pragma unroll
            for (int half = 0; half < 2; ++half)
#pragma unroll
                for (int ks = 0; ks < 2; ++ks) {
                    bf16x8 a[4], bw[4];
#pragma unroll
                    for (int m = 0; m < 4; ++m) a[m] = *(const LAS bf16x8*)(lds + ab + cf_off(64 * wr + 16 * m + fr + 2 * half, 4 * ks + fq));
#pragma unroll
                    for (int n = 0; n < 4; ++n) bw[n] = *(const LAS bf16x8*)(lds + bb + cf_off(128 * half + 64 * wc + 16 * n + fr, 4 * ks + fq));
#pragma unroll
                    for (int m = 0; m < 4; ++m)
#pragma unroll
                        for (int n = 0; n < 4; ++n) acc[m][n] = MFMA16(bw[n], a[m], acc[m][n]);
                }
            if (tok + 1 < 16) { if (tok & 1) CF_STORE(CF_A0, CF_B0); else CF_STORE(CF_A1, CF_B1); }
            __syncthreads();
        }
#undef CF_LOAD
#undef CF_STORE
#pragma unroll
        for (int n = 0; n < 4; ++n) { const int col = 64 * wc + 16 * n + 4 * fq; const f32x4 bias = peb_load(PEB, kv, col);
#pragma unroll
            for (int m = 0; m < 4; ++m) { const int row = 64 * wr + 16 * m + fr; const f32x4 v = acc[m][n] + bias;
                u32x2 o; o.x = pk2(gelu_tanh(v.x), gelu_tanh(v.y)); o.y = pk2(gelu_tanh(v.z), gelu_tanh(v.w));
                *(LAS u32x2*)(lds + CF_HID + cf_off2(row, col >> 3) + (col & 7) * 2) = o; } }
        { const float* w2 = kv ? p.w2_v : p.w2_k; const int n = tid & 63, kb = tid >> 6; float x[16];
#pragma unroll
          for (int j = 0; j < 16; ++j) x[j] = w2[(size_t)(16 * kb + j) * 64 + n];
#pragma unroll
          for (int h2 = 0; h2 < 2; ++h2) { u32x4 o; o.x = pk2(x[8 * h2], x[8 * h2 + 1]); o.y = pk2(x[8 * h2 + 2], x[8 * h2 + 3]); o.z = pk2(x[8 * h2 + 4], x[8 * h2 + 5]); o.w = pk2(x[8 * h2 + 6], x[8 * h2 + 7]);
              *(LAS u32x4*)(lds + CF_W2 + cf_off2(n, 2 * kb + h2)) = o; } }
        __syncthreads();
        f32x4 acc2[2][4];
#pragma unroll
        for (int m = 0; m < 2; ++m)
#pragma unroll
            for (int n = 0; n < 4; ++n) acc2[m][n] = (f32x4){0.f, 0.f, 0.f, 0.f};
#pragma unroll
        for (int ks = 0; ks < 4; ++ks) { bf16x8 a[2], bw[4];
#pragma unroll
            for (int m = 0; m < 2; ++m) a[m] = *(const LAS bf16x8*)(lds + CF_HID + cf_off2(32 * wave + 16 * m + fr, 4 * ks + fq));
#pragma unroll
            for (int n = 0; n < 4; ++n) bw[n] = *(const LAS bf16x8*)(lds + CF_W2 + cf_off2(16 * n + fr, 4 * ks + fq));
#pragma unroll
            for (int m = 0; m < 2; ++m)
#pragma unroll
                for (int n = 0; n < 4; ++n) acc2[m][n] = MFMA16(bw[n], a[m], acc2[m][n]); }
#pragma unroll
        for (int m = 0; m < 2; ++m) { const int row = 32 * wave + 16 * m + fr, i = c0 + (row >> 1), g = row & 1;
            if (i < NC) {
                float* dst = CK + (size_t)kv * CMPO + (PART ? (size_t)CMPO_S : 0) + ((size_t)(b * NC + i) * 2 + g) * 64 + 4 * fq;
#pragma unroll
                for (int n = 0; n < 4; ++n) *(f32x4*)(dst + 16 * n) = acc2[m][n];
                if (PART) { bf16* kd = KCB + ((size_t)((kv * NBP + b) * 2 + g) * 512 + i) * 64 + 4 * fq;
#pragma unroll
                    for (int n = 0; n < 4; ++n) { u32x2 o; o.x = pk2(acc2[m][n].x, acc2[m][n].y); o.y = pk2(acc2[m][n].z, acc2[m][n].w); *(u32x2*)(kd + 16 * n) = o;
                        if (i == 0) *(u32x2*)(kd + (size_t)511 * 64 + 16 * n) = (u32x2){0u, 0u}; } }
            } }
        __syncthreads();
    }
}


constexpr int CS_A0 = 0, CS_ABYTES = 66 * 128, CS_A1 = CS_ABYTES, CS_B0 = 2 * CS_ABYTES, CS_B1 = CS_B0 + 32768;
constexpr int CS_HID = 0, CS_W2 = CS_B0;
__device__ __forceinline__ void ph_cmpf_small(const P& p, LAS unsigned char* lds, int u) {
    const int tid = tid_now(), lane = tid & 63, wave = __builtin_amdgcn_readfirstlane(tid >> 6), fr = lane & 15, fq = lane >> 4;
    const float* KVC = p.out + O_KVC_P; const bf16* WC1 = (const bf16*)(p.ws + WS_WC1_T); const float* PEB = (const float*)(p.ws + WS_PEB);
    float* CK = (float*)(p.ws + WS_CMPKV); bf16* KCB = (bf16*)(p.ws + WS_KCB);
    const int kv = u >> 5, b = (u >> 4) & 1, c0 = (u & 15) * 32; const bool ext = c0 + 32 < 512;
    const int pc = tid & 31, ch0 = tid >> 5, ag = pc >> 4, ad = 4 * (pc & 15);
    const float* abase = KVC + ((size_t)b * SEQ + (size_t)(c0 + ch0) * 16) * 256 + kv * 128 + 4 * pc;
    const float* esrc = (ext && tid < 32) ? KVC + ((size_t)b * SEQ + (size_t)(c0 + 32) * 16) * 256 + kv * 128 + 4 * tid : nullptr;
    const bf16* wsrc = WC1 + ((size_t)kv * 256 + (tid >> 3)) * 1024 + (tid & 7) * 8;
    f32x4 aA0, aA1, aB0, aB1, eA, eB; u32x4 wA[4], wB[4];
    eA = (f32x4){0.f, 0.f, 0.f, 0.f}; eB = eA;
#define CS_LOAD(a0, a1, EV, WV, tok) do { a0 = *(const f32x4*)(abase + (size_t)(tok) * 256); a1 = *(const f32x4*)(abase + (size_t)16 * 16 * 256 + (size_t)(tok) * 256); \
        if (esrc) EV = *(const f32x4*)(esrc + (size_t)(tok) * 256); \
        _Pragma("unroll") for (int i = 0; i < 4; ++i) WV[i] = *(const u32x4*)(wsrc + (size_t)i * 64 * 1024 + (tok) * 64); } while (0)
#define CS_STORE(a0, a1, EV, WV, abuf, bbuf) do { \
        { u32x2 o_; o_.x = pk2(a0.x, a0.y); o_.y = pk2(a0.z, a0.w); *(LAS u32x2*)(lds + (abuf) + cf_off(2 * ch0 + ag, ad >> 3) + ((ad >> 2) & 1) * 8) = o_; } \
        { u32x2 o_; o_.x = pk2(a1.x, a1.y); o_.y = pk2(a1.z, a1.w); *(LAS u32x2*)(lds + (abuf) + cf_off(2 * (ch0 + 16) + ag, ad >> 3) + ((ad >> 2) & 1) * 8) = o_; } \
        if (tid < 32) { u32x2 o_; o_.x = pk2(EV.x, EV.y); o_.y = pk2(EV.z, EV.w); *(LAS u32x2*)(lds + (abuf) + cf_off(64 + (tid >> 4), (tid & 15) >> 1) + (tid & 1) * 8) = o_; } \
        _Pragma("unroll") for (int i = 0; i < 4; ++i) *(LAS u32x4*)(lds + (bbuf) + cf_off((tid >> 3) + 64 * i, tid & 7)) = WV[i]; } while (0)
    const int sA0 = (fr >> 1) & 7, sA1 = ((fr >> 1) + 1) & 7;
    const int aoff00 = fr * 128 + ((fq ^ sA0) << 4), aoff01 = fr * 128 + (((4 + fq) ^ sA0) << 4);
    const int aoff10 = (fr + 2) * 128 + ((fq ^ sA1) << 4), aoff11 = (fr + 2) * 128 + (((4 + fq) ^ sA1) << 4);
    const int woff0 = (16 * wave + fr) * 128 + ((fq ^ sA0) << 4), woff1 = (16 * wave + fr) * 128 + (((4 + fq) ^ sA0) << 4);
    f32x4 acc[4];
#pragma unroll
    for (int m = 0; m < 4; ++m) acc[m] = (f32x4){0.f, 0.f, 0.f, 0.f};
#define CS_STEP(ab, bb, AO, WO, HALF) do { const bf16x8 bw = *(const LAS bf16x8*)(lds + (bb) + (WO) + (HALF) * 16384); \
        _Pragma("unroll") for (int m = 0; m < 4; ++m) { const bf16x8 a = *(const LAS bf16x8*)(lds + (ab) + (AO) + m * 2048); acc[m] = MFMA16(bw, a, acc[m]); } } while (0)
#define CS_COMPUTE(ab, bb) do { CS_STEP(ab, bb, aoff00, woff0, 0); CS_STEP(ab, bb, aoff01, woff1, 0); CS_STEP(ab, bb, aoff10, woff0, 1); CS_STEP(ab, bb, aoff11, woff1, 1); } while (0)
    CS_LOAD(aA0, aA1, eA, wA, 0); CS_LOAD(aB0, aB1, eB, wB, 1);
    CS_STORE(aA0, aA1, eA, wA, CS_A0, CS_B0);
    CS_LOAD(aA0, aA1, eA, wA, 2);
    __syncthreads();
#pragma unroll 1
    for (int tok = 0; tok < 16; tok += 2) {
        CS_COMPUTE(CS_A0, CS_B0);
        CS_STORE(aB0, aB1, eB, wB, CS_A1, CS_B1);
        if (tok + 3 < 16) CS_LOAD(aB0, aB1, eB, wB, tok + 3);
        __syncthreads();
        CS_COMPUTE(CS_A1, CS_B1);
        if (tok + 2 < 16) CS_STORE(aA0, aA1, eA, wA, CS_A0, CS_B0);
        if (tok + 4 < 16) CS_LOAD(aA0, aA1, eA, wA, tok + 4);
        __syncthreads();
    }
#undef CS_LOAD
#undef CS_STORE
#undef CS_STEP
#undef CS_COMPUTE
    { const int col = 16 * wave + 4 * fq; const f32x4 bias = peb_load(PEB, kv, col);
#pragma unroll
      for (int m = 0; m < 4; ++m) { const int row = 16 * m + fr; const f32x4 v = acc[m] + bias;
          u32x2 o; o.x = pk2(gelu_tanh(v.x), gelu_tanh(v.y)); o.y = pk2(gelu_tanh(v.z), gelu_tanh(v.w));
          *(LAS u32x2*)(lds + CS_HID + cf_off2(row, col >> 3) + (col & 7) * 2) = o; } }
    { const float* w2 = kv ? p.w2_v : p.w2_k; const int n = tid & 63, kb = tid >> 6; float x[16];
#pragma unroll
      for (int j = 0; j < 16; ++j) x[j] = w2[(size_t)(16 * kb + j) * 64 + n];
#pragma unroll
      for (int h2 = 0; h2 < 2; ++h2) { u32x4 o; o.x = pk2(x[8 * h2], x[8 * h2 + 1]); o.y = pk2(x[8 * h2 + 2], x[8 * h2 + 3]); o.z = pk2(x[8 * h2 + 4], x[8 * h2 + 5]); o.w = pk2(x[8 * h2 + 6], x[8 * h2 + 7]);
          *(LAS u32x4*)(lds + CS_W2 + cf_off2(n, 2 * kb + h2)) = o; } }
    __syncthreads();
    { const int m = wave & 3, n0 = 2 * (wave >> 2);
      f32x4 acc2[2]; acc2[0] = (f32x4){0.f, 0.f, 0.f, 0.f}; acc2[1] = acc2[0];
#pragma unroll
      for (int ks = 0; ks < 4; ++ks) { const bf16x8 a = *(const LAS bf16x8*)(lds + CS_HID + cf_off2(16 * m + fr, 4 * ks + fq));
#pragma unroll
          for (int j = 0; j < 2; ++j) { const bf16x8 bw = *(const LAS bf16x8*)(lds + CS_W2 + cf_off2(16 * (n0 + j) + fr, 4 * ks + fq)); acc2[j] = MFMA16(bw, a, acc2[j]); } }
      const int row = 16 * m + fr, i = c0 + (row >> 1), g = row & 1;
      if (i < NC_P) {
          float* dst = CK + (size_t)kv * CMPO + (size_t)CMPO_S + ((size_t)(b * NC_P + i) * 2 + g) * 64 + 4 * fq;
          bf16* kd = KCB + ((size_t)((kv * NBP + b) * 2 + g) * 512 + i) * 64 + 4 * fq;
#pragma unroll
          for (int j = 0; j < 2; ++j) { *(f32x4*)(dst + 16 * (n0 + j)) = acc2[j];
              u32x2 o; o.x = pk2(acc2[j].x, acc2[j].y); o.y = pk2(acc2[j].z, acc2[j].w); *(u32x2*)(kd + 16 * (n0 + j)) = o;
              if (i == 0) *(u32x2*)(kd + (size_t)511 * 64 + 16 * (n0 + j)) = (u32x2){0u, 0u}; }
      } }
    __syncthreads();
}

typedef short s16x4 __attribute__((ext_vector_type(4)));
typedef float f32x16 __attribute__((ext_vector_type(16)));
#define MFMA32(a, b, c) __builtin_amdgcn_mfma_f32_32x32x16_bf16(a, b, c, 0, 0, 0)
constexpr int AT_STG = 16384;
constexpr int AT_IMP = 2 * AT_STG;
constexpr int AT_SEL = AT_IMP + 8 * 4096;
constexpr int AT_QM = AT_SEL + 1024;
constexpr int AT_LS = AT_QM + 1024;
constexpr int AT_ACC = 68 * 1024;
constexpr int AT_ROW = 68;
constexpr int AT_QL = AT_ACC + 256 * AT_ROW * 4;
constexpr float AT_MASKED = -1e30f, AT_MINIT = -1e20f;

__device__ __forceinline__ int crow(int r, int hi) { return (r & 3) + 8 * (r >> 2) + 4 * hi; }
__device__ __forceinline__ unsigned cvtpk(float lo, float hi) { unsigned r; asm("v_cvt_pk_bf16_f32 %0, %1, %2" : "=v"(r) : "v"(lo), "v"(hi)); return r; }
__device__ __forceinline__ float xmax32(float v) { const auto rr = __builtin_amdgcn_permlane32_swap(__float_as_uint(v), __float_as_uint(v), false, false); return fmaxf(__uint_as_float(rr[0]), __uint_as_float(rr[1])); }
__device__ __forceinline__ float xsum32(float v) { const auto rr = __builtin_amdgcn_permlane32_swap(__float_as_uint(v), __float_as_uint(v), false, false); return __uint_as_float(rr[0]) + __uint_as_float(rr[1]); }
__device__ __forceinline__ float xget32(float v, int hi) { const auto rr = __builtin_amdgcn_permlane32_swap(__float_as_uint(v), __float_as_uint(v), false, false); return __uint_as_float(hi ? rr[0] : rr[1]); }
__device__ __forceinline__ s16x4 vtr(LAS const unsigned char* p) { typedef short v4i16_t __attribute__((ext_vector_type(4)));
    return __builtin_bit_cast(s16x4, __builtin_amdgcn_ds_read_tr16_b64_v4i16((LAS v4i16_t*)p)); }

struct AtStage { u32x4 k, v; };
template <bool NEEDV> __device__ __forceinline__ AtStage at_load(const bf16* ksrc, const bf16* vsrc, int tid) {
    AtStage s; const size_t off = (size_t)(tid >> 3) * 64 + (tid & 7) * 8;
    s.k = *(const u32x4*)(ksrc + off); if (NEEDV) s.v = *(const u32x4*)(vsrc + off); else s.v = (u32x4){0u, 0u, 0u, 0u};
    return s;
}
template <bool NEEDV> __device__ __forceinline__ void at_store(LAS unsigned char* buf, const AtStage& s, int tid) {
    const int key = tid >> 3, ch = tid & 7;
    *(LAS u32x4*)(buf + ch * 1024 + key * 16) = s.k;
    if (NEEDV) *(LAS u32x4*)(buf + 8192 + (ch >> 2) * 4096 + key * 64 + (ch & 3) * 16) = s.v;
}
__device__ __forceinline__ void at_scores(LAS const unsigned char* buf, const bf16x8 (&qf)[4], f32x16& s0, f32x16& s1, int lane) {
    LAS const unsigned char* kp = buf + (lane >> 5) * 1024 + (lane & 31) * 16;
    s0 = f32x16{}; s1 = f32x16{};
#pragma unroll
    for (int d0 = 0; d0 < 4; ++d0) { const bf16x8 ka = *(LAS const bf16x8*)(kp + d0 * 2048), kb = *(LAS const bf16x8*)(kp + d0 * 2048 + 512);
        s0 = MFMA32(ka, qf[d0], s0); s1 = MFMA32(kb, qf[d0], s1); }
}
__device__ __forceinline__ void at_softmax_pv(LAS const unsigned char* buf, f32x16& s0, f32x16& s1, f32x16 (&o)[2], float& m, float& l, int lane, bool lane_on) {
    float mx = fmaxf(s0[0], s1[0]);
#pragma unroll
    for (int r = 1; r < 16; r += 1) mx = __builtin_fmaxf(__builtin_fmaxf(mx, s0[r]), s1[r]);
    mx = xmax32(mx);
    mx = lane_on ? mx : AT_MASKED;
    const float mn = fmaxf(m, mx), al = __builtin_amdgcn_exp2f(m - mn);
    m = mn;
    const float off = lane_on ? mn : 1e30f;
    float rs = 0.f;
#pragma unroll
    for (int r = 0; r < 16; ++r) { s0[r] = __builtin_amdgcn_exp2f(s0[r] - off); s1[r] = __builtin_amdgcn_exp2f(s1[r] - off); rs += s0[r] + s1[r]; }
    l = l * al + rs;
    if (__ballot(al != 1.0f) != 0ull) {
#pragma unroll
        for (int r = 0; r < 16; ++r) { o[0][r] *= al; o[1][r] *= al; } }
    u32x4 pw[4];
    pw[0] = (u32x4){cvtpk(s0[0], s0[1]), cvtpk(s0[2], s0[3]), cvtpk(s0[4], s0[5]), cvtpk(s0[6], s0[7])};
    pw[1] = (u32x4){cvtpk(s0[8], s0[9]), cvtpk(s0[10], s0[11]), cvtpk(s0[12], s0[13]), cvtpk(s0[14], s0[15])};
    pw[2] = (u32x4){cvtpk(s1[0], s1[1]), cvtpk(s1[2], s1[3]), cvtpk(s1[4], s1[5]), cvtpk(s1[6], s1[7])};
    pw[3] = (u32x4){cvtpk(s1[8], s1[9]), cvtpk(s1[10], s1[11]), cvtpk(s1[12], s1[13]), cvtpk(s1[14], s1[15])};
    const int hi = lane >> 5;
    LAS const unsigned char* vp = buf + 8192 + ((lane >> 4) & 1) * 32 + (lane & 3) * 8 + (4 * hi + ((lane & 15) >> 2)) * 64;
#pragma unroll
    for (int k = 0; k < 4; ++k) {
        const bf16x8 pf = __builtin_bit_cast(bf16x8, pw[k]);
#pragma unroll
        for (int dh = 0; dh < 2; ++dh) { const s16x4 lo = vtr(vp + dh * 4096 + k * 1024), hh = vtr(vp + dh * 4096 + k * 1024 + 512);
            const bf16x8 vf = (bf16x8){lo[0], lo[1], lo[2], lo[3], hh[0], hh[1], hh[2], hh[3]};
            o[dh] = MFMA32(vf, pf, o[dh]); }
    }
}

__device__ __forceinline__ void at_softmax_pv_fixed(LAS const unsigned char* buf, f32x16& s0, f32x16& s1, f32x16 (&o)[2], float& l, int lane, float coff) {
    if (coff != 0.f) {
#pragma unroll
        for (int r = 0; r < 16; ++r) { s0[r] -= coff; s1[r] -= coff; } }
    float rs = 0.f;
#pragma unroll
    for (int r = 0; r < 16; ++r) { s0[r] = __builtin_amdgcn_exp2f(s0[r]); s1[r] = __builtin_amdgcn_exp2f(s1[r]); rs += s0[r] + s1[r]; }
    l += rs;
    u32x4 pw[4];
    pw[0] = (u32x4){cvtpk(s0[0], s0[1]), cvtpk(s0[2], s0[3]), cvtpk(s0[4], s0[5]), cvtpk(s0[6], s0[7])};
    pw[1] = (u32x4){cvtpk(s0[8], s0[9]), cvtpk(s0[10], s0[11]), cvtpk(s0[12], s0[13]), cvtpk(s0[14], s0[15])};
    pw[2] = (u32x4){cvtpk(s1[0], s1[1]), cvtpk(s1[2], s1[3]), cvtpk(s1[4], s1[5]), cvtpk(s1[6], s1[7])};
    pw[3] = (u32x4){cvtpk(s1[8], s1[9]), cvtpk(s1[10], s1[11]), cvtpk(s1[12], s1[13]), cvtpk(s1[14], s1[15])};
    const int hi = lane >> 5;
    LAS const unsigned char* vp = buf + 8192 + ((lane >> 4) & 1) * 32 + (lane & 3) * 8 + (4 * hi + ((lane & 15) >> 2)) * 64;
#pragma unroll
    for (int k = 0; k < 4; ++k) {
        const bf16x8 pf = __builtin_bit_cast(bf16x8, pw[k]);
#pragma unroll
        for (int dh = 0; dh < 2; ++dh) { const s16x4 lo = vtr(vp + dh * 4096 + k * 1024), hh = vtr(vp + dh * 4096 + k * 1024 + 512);
            const bf16x8 vf = (bf16x8){lo[0], lo[1], lo[2], lo[3], hh[0], hh[1], hh[2], hh[3]};
            o[dh] = MFMA32(vf, pf, o[dh]); }
    }
}

template <int MODE>
__device__ __forceinline__ void at_branch(const bf16* ksrc, const bf16* vsrc, int key0, int nst, LAS unsigned char* lds, const bf16x8 (&qf)[4], f32x16 (&o)[2], float& m, float& l,
                                          int t, unsigned long long sel_lo, unsigned long long sel_hi, int wlo, int whi, LAS float* impw, int tid, int lane, float coff = 0.f) {
    constexpr bool NEEDV = MODE != 3;
    const int hi = lane >> 5;
    float carry = 0.f;
    AtStage st = at_load<NEEDV>(ksrc, vsrc, tid);
    at_store<NEEDV>(lds, st, tid);
    __syncthreads();
    for (int s = 0; s < nst; ++s) {
        LAS unsigned char* buf = lds + (s & 1) * AT_STG;
        if (s + 1 < nst) st = at_load<NEEDV>(ksrc + (size_t)(s + 1) * 64 * 64, vsrc + (size_t)(s + 1) * 64 * 64, tid);
        const int kb = key0 + 64 * s;
        bool active = true;
        bool chosen = true;
        if (MODE == 1) { const int j = kb >> 6; const unsigned long long w = j < 64 ? sel_lo : sel_hi; chosen = (w >> (j & 63)) & 1ull; active = __ballot(chosen) != 0ull; }
        if (MODE == 2) active = (kb + 63 >= wlo - 512) && (kb <= whi);
        if (MODE == 0 || MODE == 3) active = 16 * kb + 31 <= whi;
        if (active) {
            f32x16 s0, s1;
            at_scores(buf, qf, s0, s1, lane);
            bool edge;
            if (MODE == 0 || MODE == 3) edge = 16 * (kb + 63) + 31 > wlo;
            else if (MODE == 1) edge = kb + 63 > wlo;
            else edge = (kb + 63 > wlo) || (kb < whi - 512);
            if (edge || MODE == 3) {
#pragma unroll
                for (int r = 0; r < 16; ++r) { const int k0 = kb + crow(r, hi), k1 = k0 + 32; bool v0, v1;
                    if (MODE == 0 || MODE == 3) { v0 = 16 * k0 + 31 <= t; v1 = 16 * k1 + 31 <= t; }
                    else if (MODE == 1) { v0 = k0 <= t; v1 = k1 <= t; }
                    else { v0 = k0 <= t && k0 >= t - 512; v1 = k1 <= t && k1 >= t - 512; }
                    if (MODE != 3) { s0[r] = v0 ? s0[r] : AT_MASKED; s1[r] = v1 ? s1[r] : AT_MASKED; }
                    else { s0[r] = v0 ? __builtin_amdgcn_exp2f(s0[r] - m) * l : 0.f; s1[r] = v1 ? __builtin_amdgcn_exp2f(s1[r] - m) * l : 0.f; } }
            }
            if (MODE == 2) at_softmax_pv_fixed(buf, s0, s1, o, l, lane, coff);
            else if (MODE != 3) at_softmax_pv(buf, s0, s1, o, m, l, lane, chosen);
            else {
#pragma unroll
                for (int n = 0; n < 2; ++n) { const f32x16& pp = n ? s1 : s0; const int jb0 = (kb >> 2) + 8 * n;
                    float own[4], sp[4], rc[4];
#pragma unroll
                    for (int G = 0; G < 4; ++G) { sp[G] = 0.5f * pp[4 * G + 3]; own[G] = pp[4 * G] + pp[4 * G + 1] + pp[4 * G + 2] + sp[G]; rc[G] = xget32(sp[G], hi); }
                    float val[4];
                    if (hi) { val[0] = own[0] + rc[0]; val[1] = own[1] + rc[1]; val[2] = own[2] + rc[2]; val[3] = own[3] + rc[3]; }
                    else { val[0] = own[0] + carry; val[1] = own[1] + rc[0]; val[2] = own[2] + rc[1]; val[3] = own[3] + rc[2]; }
                    carry = rc[3];
#pragma unroll
                    for (int G = 0; G < 4; ++G) { val[G] += dpp_mov<0xB1>(val[G]); val[G] += dpp_mov<0x4E>(val[G]);

                        if ((lane & 3) == 0) impw[((lane & 31) >> 2) * 128 + jb0 + 2 * G + hi] = val[G]; }
                }
            }
        } else if (MODE == 3) carry = 0.f;
        if (s + 1 < nst) at_store<NEEDV>(lds + ((s + 1) & 1) * AT_STG, st, tid);
        __syncthreads();
    }
}

__device__ __forceinline__ void at_slc_tile(LAS unsigned char* lds, LAS const unsigned char* buf, bool diag, int myq, float coff, f32x16 (&o)[2], float& rs, int lane) {
    const int hi = lane >> 5, col = lane & 31, head = col & 3;
    LAS const unsigned char* qimg = lds + AT_IMP;
    const int colg = myq * 4 + head;
    bf16x8 qf[4];
#pragma unroll
    for (int d0 = 0; d0 < 4; ++d0) qf[d0] = *(LAS const bf16x8*)(qimg + colg * 128 + (((d0 * 2 + hi) ^ (colg & 7)) << 4));
    f32x16 s0, s1;
    { LAS const unsigned char* kp = buf + hi * 1024 + col * 16;
      bf16x8 kf[8];
#pragma unroll
      for (int i = 0; i < 8; ++i) kf[i] = *(LAS const bf16x8*)(kp + (i >> 1) * 2048 + (i & 1) * 512);
      asm volatile("" ::: "memory");
      s0 = f32x16{}; s1 = f32x16{};
#pragma unroll
      for (int d0 = 0; d0 < 4; ++d0) { s0 = MFMA32(kf[2 * d0], qf[d0], s0); s1 = MFMA32(kf[2 * d0 + 1], qf[d0], s1); } }
    LAS const unsigned char* vp = buf + 8192 + ((lane >> 4) & 1) * 32 + (lane & 3) * 8 + (4 * hi + ((lane & 15) >> 2)) * 64;
    s16x4 vlo[4][2], vhi[4][2];
#pragma unroll
    for (int k = 0; k < 4; ++k)
#pragma unroll
        for (int dh = 0; dh < 2; ++dh) { vlo[k][dh] = vtr(vp + dh * 4096 + k * 1024); vhi[k][dh] = vtr(vp + dh * 4096 + k * 1024 + 512); }
    asm volatile("" ::: "memory");
    if (diag) {
#pragma unroll
        for (int r = 0; r < 16; ++r) { const int k0 = crow(r, hi); s0[r] = k0 <= myq ? s0[r] : AT_MASKED; s1[r] = k0 + 32 <= myq ? s1[r] : AT_MASKED; } }
    if (coff != 0.f) {
#pragma unroll
        for (int r = 0; r < 16; ++r) { s0[r] -= coff; s1[r] -= coff; } }
    rs = 0.f;
#pragma unroll
    for (int r = 0; r < 16; ++r) { s0[r] = __builtin_amdgcn_exp2f(s0[r]); s1[r] = __builtin_amdgcn_exp2f(s1[r]); rs += s0[r] + s1[r]; }
    u32x4 pw[4];
    pw[0] = (u32x4){cvtpk(s0[0], s0[1]), cvtpk(s0[2], s0[3]), cvtpk(s0[4], s0[5]), cvtpk(s0[6], s0[7])};
    pw[1] = (u32x4){cvtpk(s0[8], s0[9]), cvtpk(s0[10], s0[11]), cvtpk(s0[12], s0[13]), cvtpk(s0[14], s0[15])};
    pw[2] = (u32x4){cvtpk(s1[0], s1[1]), cvtpk(s1[2], s1[3]), cvtpk(s1[4], s1[5]), cvtpk(s1[6], s1[7])};
    pw[3] = (u32x4){cvtpk(s1[8], s1[9]), cvtpk(s1[10], s1[11]), cvtpk(s1[12], s1[13]), cvtpk(s1[14], s1[15])};
    o[0] = f32x16{}; o[1] = f32x16{};
#pragma unroll
    for (int k = 0; k < 4; ++k) {
        const bf16x8 pf = __builtin_bit_cast(bf16x8, pw[k]);
#pragma unroll
        for (int dh = 0; dh < 2; ++dh) { const s16x4 lo = vlo[k][dh], hh = vhi[k][dh];
            const bf16x8 vf = (bf16x8){lo[0], lo[1], lo[2], lo[3], hh[0], hh[1], hh[2], hh[3]};
            o[dh] = MFMA32(vf, pf, o[dh]); }
    }
    rs = xsum32(rs);
}
__device__ __forceinline__ void at_slc_merge(LAS unsigned char* lds, int myq, bool on, const f32x16 (&o)[2], float rs, int lane) {
    const int hi = lane >> 5, colg = myq * 4 + (lane & 3);
    LAS float* ap = (LAS float*)(lds + AT_ACC) + colg * AT_ROW + 4 * hi;
    LAS float* ls = (LAS float*)(lds + AT_LS);
    if (on) {
        f32x4 a4[2][4];
#pragma unroll
        for (int dh = 0; dh < 2; ++dh)
#pragma unroll
            for (int rg = 0; rg < 4; ++rg) a4[dh][rg] = *(LAS const f32x4*)(ap + dh * 32 + 8 * rg);
        asm volatile("" ::: "memory");
        if (hi == 0) ls[colg] += rs;
#pragma unroll
        for (int dh = 0; dh < 2; ++dh)
#pragma unroll
            for (int rg = 0; rg < 4; ++rg) *(LAS f32x4*)(ap + dh * 32 + 8 * rg) = (f32x4){a4[dh][rg][0] + o[dh][4 * rg], a4[dh][rg][1] + o[dh][4 * rg + 1], a4[dh][rg][2] + o[dh][4 * rg + 2], a4[dh][rg][3] + o[dh][4 * rg + 3]};
    }
}
__device__ __forceinline__ void at_slc(const bf16* ksrc, const bf16* vsrc, int jq, LAS unsigned char* lds, float coff, int tid, int lane, int wave) {
    const int col = lane & 31, w4 = wave & 3, side = wave >> 2;
    LAS const int* qcnt = (LAS const int*)(lds + AT_QM);
    LAS const unsigned char* qlist = lds + AT_QL;
    AtStage sa = at_load<true>(ksrc, vsrc, tid), sb = sa;
    if (jq >= 1) sb = at_load<true>(ksrc + 64 * 64, vsrc + 64 * 64, tid);
    at_store<true>(lds, sa, tid);
    if (jq >= 1) at_store<true>(lds + AT_STG, sb, tid);
    __syncthreads();
#pragma unroll 1
    for (int j0 = 0; j0 <= jq; j0 += 2) {
        const bool more_a = j0 + 2 <= jq, more_b = j0 + 3 <= jq;
        if (more_a) sa = at_load<true>(ksrc + (size_t)(j0 + 2) * 64 * 64, vsrc + (size_t)(j0 + 2) * 64 * 64, tid);
        if (more_b) sb = at_load<true>(ksrc + (size_t)(j0 + 3) * 64 * 64, vsrc + (size_t)(j0 + 3) * 64 * 64, tid);
        const int na = __builtin_amdgcn_readfirstlane(qcnt[j0]), nb = j0 + 1 <= jq ? __builtin_amdgcn_readfirstlane(qcnt[j0 + 1]) : 0;
        const int rounds = (na > 32 || nb > 32) ? 2 : 1;
        const int j = j0 + side, n = side ? nb : na;
#pragma unroll 1
        for (int rd = 0; rd < rounds; ++rd) {
            const int tile = w4 + 4 * rd; const bool have = 8 * tile < n;
            f32x16 o[2]; float rs = 0.f; int myq = 0;
            if (have) { myq = qlist[j * 64 + 8 * tile + (col >> 2)];
                at_slc_tile(lds, lds + side * AT_STG, j == jq, myq, coff, o, rs, lane);
                if (side == 0) at_slc_merge(lds, myq, 8 * tile + (col >> 2) < n, o, rs, lane); }
            __syncthreads();
            if (have && side == 1) at_slc_merge(lds, myq, 8 * tile + (col >> 2) < n, o, rs, lane);
            if (rd == rounds - 1) { if (more_a) at_store<true>(lds, sa, tid);
                                    if (more_b) at_store<true>(lds + AT_STG, sb, tid); }
            __syncthreads();
        }
    }
}

__device__ __forceinline__ void ph_attn_prompt(const P& p, LAS unsigned char* lds) {
    const int tid = tid_now(), lane = tid & 63, wave = __builtin_amdgcn_readfirstlane(tid >> 6), hi = lane >> 5;
    const bf16* QB = (const bf16*)(p.ws + WS_QB); const bf16* KB = (const bf16*)(p.ws + WS_KB); const bf16* VB = (const bf16*)(p.ws + WS_VB); const bf16* KCB = (const bf16*)(p.ws + WS_KCB);
    const float* GATES = (const float*)(p.ws + WS_GATES); float* ATTN = (float*)(p.ws + WS_ATTN);
    LAS float* impw = (LAS float*)(lds + AT_IMP + wave * 4096);
    LAS unsigned* selw = (LAS unsigned*)(lds + AT_SEL + wave * 128);
    float coff, coffw; { const float gq = wave_max(fabsf(p.q_g[lane])), gk = wave_max(fabsf(p.k_g[64 + lane])), gw = wave_max(fabsf(p.k_g[128 + lane]));
        coff = fmaxf(0.f, 8.0f * 1.4426950408889634f * 1.01f * gq * gk - 100.f); coffw = fmaxf(0.f, 8.0f * 1.4426950408889634f * 1.01f * gq * gw - 100.f); }
    for (int hw = blockIdx.x; hw < 256; hw += gridDim.x) {
        const int pr = ((hw & 7) >> 1) * 64 + (hw & 1) * 32 + (hw >> 3);
        const int bg = pr >> 6, b = bg >> 1, g = bg & 1;
#pragma unroll 1
        for (int half = 0; half < 2; ++half) {
            const int jq = half ? 127 - (pr & 63) : (pr & 63);
            const int t0 = 64 * jq, col = lane & 31, qi = col >> 2, head = col & 3, t = t0 + 8 * wave + qi;
            const int wlo = t0 + 8 * wave, whi = wlo + 7;
            bf16x8 qf[4];
            { const bf16* qp = QB + ((size_t)bg * SEQ + wlo) * 256 + (size_t)col * 64 + hi * 8;
#pragma unroll
              for (int d0 = 0; d0 < 4; ++d0) qf[d0] = *(const bf16x8*)(qp + d0 * 16); }
            const float* gp = GATES + (size_t)(b * SEQ + t) * 24 + (g * 4 + head) * 3;
            const float g_c = gp[0], g_s = gp[1], g_w = gp[2];
            f32x16 o[2]; float m, l;
            const int ncu = 4 * jq + 3 < NC_P ? 4 * jq + 3 : NC_P;
            const int nstc = (ncu + 63) >> 6;
            const bf16* kc = KCB + (size_t)bg * 512 * 64; const bf16* vc = kc + (size_t)NBP * 2 * 512 * 64;
            o[0] = f32x16{}; o[1] = f32x16{}; m = AT_MINIT; l = 0.f;
            at_branch<0>(kc, vc, 0, nstc, lds, qf, o, m, l, t, 0ull, 0ull, wlo, whi, impw, tid, lane);
            float lt = xsum32(l), il = lt > 0.f ? 1.0f / lt : 0.f;
            float* op = ATTN + (size_t)(b * SEQ + t) * AW + (g * 4 + head) * 64 + 4 * hi;
            { const float sc = g_c * il;
#pragma unroll
              for (int dh = 0; dh < 2; ++dh)
#pragma unroll
                for (int rg = 0; rg < 4; ++rg) *(f32x4*)(op + 32 * dh + 8 * rg) = (f32x4){sc * o[dh][4 * rg], sc * o[dh][4 * rg + 1], sc * o[dh][4 * rg + 2], sc * o[dh][4 * rg + 3]}; }
            if (jq >= 16) {
                for (int i = lane; i < 1024; i += 64) impw[i] = 0.f;
                asm volatile("s_waitcnt lgkmcnt(0)" ::: "memory");
                at_branch<3>(kc, vc, 0, nstc, lds, qf, o, m, il, t, 0ull, 0ull, wlo, whi, impw, tid, lane);
                asm volatile("s_waitcnt lgkmcnt(0)" ::: "memory");
                const int cur = jq;
                for (int q8 = 0; q8 < 8; q8 += 2) {
                    const float v0 = impw[q8 * 128 + lane], v1 = impw[q8 * 128 + 64 + lane], u0 = impw[q8 * 128 + 128 + lane], u1 = impw[q8 * 128 + 192 + lane];
                    const int j0 = lane, j1 = lane + 64;
                    const bool f0 = j0 == 0 || j0 == cur || j0 == cur - 1, f1 = j1 == cur || j1 == cur - 1;
                    const unsigned k0 = j0 > cur ? 0u : f0 ? 0x7F000000u : __float_as_uint(fmaxf(v0, 0.f)) + 1u, k1 = j1 > cur ? 0u : f1 ? 0x7F000000u : __float_as_uint(fmaxf(v1, 0.f)) + 1u;
                    const unsigned h0 = j0 > cur ? 0u : f0 ? 0x7F000000u : __float_as_uint(fmaxf(u0, 0.f)) + 1u, h1 = j1 > cur ? 0u : f1 ? 0x7F000000u : __float_as_uint(fmaxf(u1, 0.f)) + 1u;
                    unsigned T = 0u, U = 0u;
                    for (int bit = 30; bit >= 0; --bit) { const unsigned tr = T | (1u << bit), ur = U | (1u << bit);
                        const int cnt = __popcll(__ballot(k0 >= tr)) + __popcll(__ballot(k1 >= tr)), cnu = __popcll(__ballot(h0 >= ur)) + __popcll(__ballot(h1 >= ur));
                        if (cnt >= 16) T = tr;
                        if (cnu >= 16) U = ur; }
                    const unsigned long long below = (1ull << lane) - 1ull;
                    { const unsigned long long gt0 = __ballot(k0 > T), gt1 = __ballot(k1 > T), eq0 = __ballot(k0 == T), eq1 = __ballot(k1 == T);
                      const int need = 16 - (__popcll(gt0) + __popcll(gt1));
                      const int pre0 = __popcll(eq0 & below), pre1 = __popcll(eq0) + __popcll(eq1 & below);
                      const unsigned long long s0m = __ballot(k0 > T || (k0 == T && pre0 < need)), s1m = __ballot(k1 > T || (k1 == T && pre1 < need));
                      if (lane == 0) { selw[q8 * 4 + 0] = (unsigned)s0m; selw[q8 * 4 + 1] = (unsigned)(s0m >> 32); selw[q8 * 4 + 2] = (unsigned)s1m; selw[q8 * 4 + 3] = (unsigned)(s1m >> 32); } }
                    { const unsigned long long gt0 = __ballot(h0 > U), gt1 = __ballot(h1 > U), eq0 = __ballot(h0 == U), eq1 = __ballot(h1 == U);
                      const int need = 16 - (__popcll(gt0) + __popcll(gt1));
                      const int pre0 = __popcll(eq0 & below), pre1 = __popcll(eq0) + __popcll(eq1 & below);
                      const unsigned long long s0m = __ballot(h0 > U || (h0 == U && pre0 < need)), s1m = __ballot(h1 > U || (h1 == U && pre1 < need));
                      if (lane == 0) { selw[q8 * 4 + 4] = (unsigned)s0m; selw[q8 * 4 + 5] = (unsigned)(s0m >> 32); selw[q8 * 4 + 6] = (unsigned)s1m; selw[q8 * 4 + 7] = (unsigned)(s1m >> 32); } }
                }
            }
            asm volatile("s_waitcnt lgkmcnt(0)" ::: "memory");
            __syncthreads();
            for (int j = wave; j <= jq; j += 8) {
                unsigned long long mk = ~0ull;
                if (jq >= 16) { const unsigned wsel = *(LAS const unsigned*)(lds + AT_SEL + (lane >> 3) * 128 + (lane & 7) * 16 + (j >> 5) * 4); mk = __ballot((wsel >> (j & 31)) & 1u); }
                const unsigned mlo = (unsigned)mk, mhi = (unsigned)(mk >> 32);
                const int n = __popcll(mk), rk = (int)__builtin_amdgcn_mbcnt_hi(mhi, __builtin_amdgcn_mbcnt_lo(mlo, 0u));
                *(LAS unsigned char*)(lds + AT_QL + j * 64 + (((mk >> lane) & 1ull) ? rk : n + (lane - rk))) = (unsigned char)lane;
                if (lane == 0) *(LAS int*)(lds + AT_QM + j * 4) = n;
            }
#ifndef PROBE_SLC2
#define PROBE_SLC2 1
#endif
#ifdef PROBE_LIVE
            __syncthreads();
            if (hw == 0 && half == 1 && wave == 0) {
                int cnt = 0;
                for (int j = lane; j <= jq; j += 64) { const int n = *(LAS const int*)(lds + AT_QM + j * 4); cnt += PROBE_LIVE == 0 ? (n > 0 ? 1 : 0) : (n + 7) >> 3; }
                cnt = (int)wave_sum((float)cnt);
                const unsigned long long t_end = __builtin_amdgcn_s_memrealtime() + (unsigned long long)cnt * (PROBE_LIVE == 0 ? 100ull : 100ull / PROBE_LIVE);
                while (__builtin_amdgcn_s_memrealtime() < t_end) __builtin_amdgcn_s_sleep(8);
            }
#endif
#pragma unroll 1
            for (int rep = 0; rep < PROBE_SLC2; ++rep) {
            { const int colg = 32 * wave + col;
#pragma unroll
              for (int d0 = 0; d0 < 4; ++d0) *(LAS bf16x8*)(lds + AT_IMP + colg * 128 + (((d0 * 2 + hi) ^ (colg & 7)) << 4)) = qf[d0];
              for (int i = tid; i < 256 * AT_ROW / 4; i += 512) *(LAS f32x4*)(lds + AT_ACC + i * 16) = (f32x4){0.f, 0.f, 0.f, 0.f};
              if (tid < 256) *(LAS float*)(lds + AT_LS + tid * 4) = 0.f; }
            at_slc(KB + (size_t)bg * SEQ * 64, VB + (size_t)bg * SEQ * 64, jq, lds, coff, tid, lane, wave);
            }
            { const float lt2 = *(LAS const float*)(lds + AT_LS + (32 * wave + col) * 4);
              const float sc = g_s * (lt2 > 0.f ? 1.0f / lt2 : 0.f);
              LAS float* ap = (LAS float*)(lds + AT_ACC) + (32 * wave + col) * AT_ROW + 4 * hi;
#pragma unroll
              for (int dh = 0; dh < 2; ++dh)
#pragma unroll
                for (int rg = 0; rg < 4; ++rg) { const f32x4 c4 = *(const f32x4*)(op + 32 * dh + 8 * rg);
                    LAS f32x4* a1 = (LAS f32x4*)(ap + dh * 32 + 8 * rg); const f32x4 s4 = *a1; *a1 = c4 + sc * s4; } }
            const int kw0 = t0 >= 512 ? t0 - 512 : 0;
            o[0] = f32x16{}; o[1] = f32x16{}; m = AT_MINIT; l = 0.f;
            at_branch<2>(KB + ((size_t)(4 + bg) * SEQ + kw0) * 64, VB + ((size_t)(4 + bg) * SEQ + kw0) * 64, kw0, (t0 + 64 - kw0) >> 6, lds, qf, o, m, l, t, 0ull, 0ull, wlo, whi, impw, tid, lane, coffw);
            lt = xsum32(l); il = lt > 0.f ? 1.0f / lt : 0.f;
            { const float sc = g_w * il;
              LAS const float* ap = (LAS const float*)(lds + AT_ACC) + (32 * wave + col) * AT_ROW + 4 * hi;
#pragma unroll
              for (int dh = 0; dh < 2; ++dh)
#pragma unroll
                for (int rg = 0; rg < 4; ++rg) { const f32x4 a4 = *(LAS const f32x4*)(ap + dh * 32 + 8 * rg);
                    o[dh][4 * rg] = a4[0] + sc * o[dh][4 * rg]; o[dh][4 * rg + 1] = a4[1] + sc * o[dh][4 * rg + 1]; o[dh][4 * rg + 2] = a4[2] + sc * o[dh][4 * rg + 2]; o[dh][4 * rg + 3] = a4[3] + sc * o[dh][4 * rg + 3]; } }
#pragma unroll
            for (int dh = 0; dh < 2; ++dh)
#pragma unroll
                for (int rg = 0; rg < 4; ++rg) *(f32x4*)(op + 32 * dh + 8 * rg) = (f32x4){o[dh][4 * rg], o[dh][4 * rg + 1], o[dh][4 * rg + 2], o[dh][4 * rg + 3]};
        }
    }
}

enum { SK_Z = 0, SK_GLU, SK_OUT, SK_UP, SK_DOWN };
template <int EP, int K>
__device__ __forceinline__ void skinny_gemm(const P& p, LAS unsigned char* lds, const bf16* A  , const bf16* Bt, int ncolblk, int first_wg) {
    const int tid = tid_now(), lane = tid & 63, wave = __builtin_amdgcn_readfirstlane(tid >> 6), fr = lane & 15, fq = lane >> 4;
    constexpr int KW = K / 8, NKS = KW / 32, KR = NKS > 8 ? 6 : 4;
    static_assert(KW % 32 == 0, "K / 8 must be a multiple of 32");
    LAS float* part = (LAS float*)lds;
    const int nwg = (int)gridDim.x - first_wg;
    if ((int)blockIdx.x < first_wg) return;
    for (int u = (int)blockIdx.x - first_wg; u < 4 * ncolblk; u += nwg) {
        const int rb = u & 3, cb = u >> 2;
        const bf16* ap = A + (size_t)(32 * rb + fr) * K + wave * KW + 8 * fq;
        const bf16* bp[4];
#pragma unroll
        for (int n = 0; n < 4; ++n) { int brow;
            if (EP == SK_UP) brow = (cb >> 2) * 256 + (cb & 3) * 32 + (n >> 1) * 128 + (n & 1) * 16 + fr;
            else brow = cb * 64 + 16 * n + fr;
            bp[n] = Bt + (size_t)brow * K + wave * KW + 8 * fq; }
        f32x4 acc[2][4];
#pragma unroll
        for (int m = 0; m < 2; ++m)
#pragma unroll
            for (int n = 0; n < 4; ++n) acc[m][n] = (f32x4){0.f, 0.f, 0.f, 0.f};
#pragma unroll 1
        for (int k0 = 0; k0 < NKS; k0 += KR) {
            bf16x8 a[KR][2], bw[KR][4];
#pragma unroll
            for (int s = 0; s < KR; ++s) if (k0 + s < NKS) {
#pragma unroll
                for (int m = 0; m < 2; ++m) a[s][m] = *(const bf16x8*)(ap + (size_t)(16 * m) * K + 32 * (k0 + s));
#pragma unroll
                for (int n = 0; n < 4; ++n) bw[s][n] = *(const bf16x8*)(bp[n] + 32 * (k0 + s)); }
#pragma unroll
            for (int s = 0; s < KR; ++s) if (k0 + s < NKS) {
#pragma unroll
                for (int m = 0; m < 2; ++m)
#pragma unroll
                    for (int n = 0; n < 4; ++n) acc[m][n] = MFMA16(bw[s][n], a[s][m], acc[m][n]); }
        }
#pragma unroll
        for (int m = 0; m < 2; ++m)
#pragma unroll
            for (int n = 0; n < 4; ++n) *(LAS f32x4*)(part + wave * 2048 + (16 * m + fr) * 64 + 16 * n + 4 * fq) = acc[m][n];
        __syncthreads();
        {
            const int row = tid >> 4, c4 = tid & 15, r = MP + 32 * rb + row;
            f32x4 v = (f32x4){0.f, 0.f, 0.f, 0.f}, v2 = (f32x4){0.f, 0.f, 0.f, 0.f};
#pragma unroll
            for (int w = 0; w < 8; ++w) { v += *(const LAS f32x4*)(part + w * 2048 + row * 64 + 4 * c4); if (EP == SK_UP) v2 += *(const LAS f32x4*)(part + w * 2048 + row * 64 + ((4 * c4 + 32) & 63)); }
            const float* ADA = (const float*)(p.ws + WS_ADA) + (size_t)ada_row(r) * 6144;
            if (EP == SK_Z) { *(f32x4*)((float*)(p.ws + WS_Z) + (size_t)r * INP + cb * 64 + 4 * c4) = v; }
            if (EP == SK_GLU) { const int col = cb * 64 + 4 * c4; const f32x4 s = *(const f32x4*)((const float*)(p.ws + WS_SF) + (size_t)r * 512 + col); const f32x4 bv = *(const f32x4*)(p.b_glu + col);
                f32x4 o; o.x = s.x * sigmoid_f(v.x + bv.x); o.y = s.y * sigmoid_f(v.y + bv.y); o.z = s.z * sigmoid_f(v.z + bv.z); o.w = s.w * sigmoid_f(v.w + bv.w);
                *(f32x4*)((float*)(p.ws + WS_S2) + (size_t)r * 512 + col) = o; }
            if (EP == SK_OUT) { const int col = cb * 64 + 4 * c4;
                *(f32x4*)((float*)(p.ws + WS_X1) + (size_t)r * D + col) = *(const f32x4*)(p.xs + (size_t)(r - MP) * D + col) + *(const f32x4*)(ADA + 2 * D + col) * v; }
            if (EP == SK_UP) { if (c4 < 8) { u32x2 o; o.x = pk2(silu_f(v.x) * v2.x, silu_f(v.y) * v2.y); o.y = pk2(silu_f(v.z) * v2.z, silu_f(v.w) * v2.w);
                *(u32x2*)((bf16*)(p.ws + WS_FF) + (size_t)r * DFF + cb * 32 + 4 * c4) = o; } }
            if (EP == SK_DOWN) { const int col = cb * 64 + 4 * c4;
                *(f32x4*)(p.out + O_YS + (size_t)(r - MP) * D + col) = *(const f32x4*)((const float*)(p.ws + WS_X1) + (size_t)r * D + col) + *(const f32x4*)(ADA + 5 * D + col) * v; }
        }
        __syncthreads();
    }
}

struct EpiInproj {
    static constexpr bool PERM = false, AFTER_DRAIN = false;
    float* out; bf16 *QB, *KB, *VB; float *GATES, *U; const float *ROPE, *q_g, *k_g; LAS float* red;
    __device__ __forceinline__ void operator()(const pg8::f32x4 (&acc)[2][2][4][2], const pg8::Unit& u, int wr, int wc, int fr, int fq) const {
        const int pn = u.pn, row0 = u.pm * 256 + wr * 64 + fr;
        if (pn >= 5) {
#pragma unroll
            for (int ai = 0; ai < 2; ++ai)
#pragma unroll
                for (int m = 0; m < 4; ++m) { const int r = row0 + ai * 128 + m * 16;
#pragma unroll
                    for (int bj = 0; bj < 2; ++bj)
#pragma unroll
                        for (int n = 0; n < 2; ++n) { const int zc = pn * 256 + bj * 128 + wc * 32 + n * 16 + 4 * fq; const pg8::f32x4 v = acc[ai][bj][m][n];
                            if (zc < O3) { pg8::f32x4 g; g[0] = sigmoid_f(v[0]); g[1] = sigmoid_f(v[1]); g[2] = sigmoid_f(v[2]); g[3] = sigmoid_f(v[3]); *(pg8::f32x4*)(GATES + (size_t)r * 24 + (zc - O2)) = g; }
                            else if (zc < INC) *(pg8::f32x4*)(U + (size_t)r * SW + (zc - O3)) = v; } }
            return;
        }
        const bool qtile = pn < 2; const int br = pn - 2;
        LAS float* rw = red + (wr * 64 + fr) * 8 + wc; LAS float* rx = red + (wr * 64 + fr) * 8 + (wc ^ 1);
#pragma unroll
        for (int ai = 0; ai < 2; ++ai)
#pragma unroll
            for (int m = 0; m < 4; ++m)
#pragma unroll
                for (int bj = 0; bj < 2; ++bj) { if (bj == 1 && !qtile) continue;
                    const pg8::f32x4 a = acc[ai][bj][m][0], c = acc[ai][bj][m][1];
                    float s = (a[0] * a[0] + a[1] * a[1]) + (a[2] * a[2] + a[3] * a[3]) + (c[0] * c[0] + c[1] * c[1]) + (c[2] * c[2] + c[3] * c[3]);
                    { const auto r16 = __builtin_amdgcn_permlane16_swap(__float_as_uint(s), __float_as_uint(s), false, false); s = __uint_as_float(r16[0]) + __uint_as_float(r16[1]); }
                    { const auto r32 = __builtin_amdgcn_permlane32_swap(__float_as_uint(s), __float_as_uint(s), false, false); s = __uint_as_float(r32[0]) + __uint_as_float(r32[1]); }
                    if (fq == 0) rw[(ai * 128 + m * 16) * 8 + bj * 4] = s; }
        asm volatile("s_waitcnt lgkmcnt(0)" ::: "memory"); __builtin_amdgcn_s_barrier(); asm volatile("" ::: "memory");
        const int hc = 32 * (wc & 1) + 4 * fq;
        const int b = (u.pm * 256) / SEQ;
        const float* gp = qtile ? q_g : k_g + br * 64;
        const pg8::f32x4 g0 = *(const pg8::f32x4*)(gp + hc), g1 = *(const pg8::f32x4*)(gp + hc + 16);
        const bool rot = (wc & 1) == 0;
        pg8::f32x4 csn = {0.f, 0.f, 0.f, 0.f}, snn = {0.f, 0.f, 0.f, 0.f};
        if (rot) { const int t0r = (u.pm * 256 + wr * 64 + fr) % SEQ; csn = *(const pg8::f32x4*)(ROPE + (size_t)t0r * 16 + 4 * (fq & 1)); snn = *(const pg8::f32x4*)(ROPE + (size_t)t0r * 16 + 8 + 4 * (fq & 1)); }
#pragma unroll
        for (int ai = 0; ai < 2; ++ai)
#pragma unroll
            for (int m = 0; m < 4; ++m) {
                const int rl = ai * 128 + wr * 64 + m * 16 + fr, r = u.pm * 256 + rl, t = r % SEQ;
                const pg8::f32x4 cs = csn, sn = snn;
                if (rot && (ai * 4 + m) < 7) { const int itn = ai * 4 + m + 1, tn = (u.pm * 256 + (itn >> 2) * 128 + wr * 64 + (itn & 3) * 16 + fr) % SEQ;
                    csn = *(const pg8::f32x4*)(ROPE + (size_t)tn * 16 + 4 * (fq & 1)); snn = *(const pg8::f32x4*)(ROPE + (size_t)tn * 16 + 8 + 4 * (fq & 1)); }
#pragma unroll
                for (int bj = 0; bj < 2; ++bj) {
                    pg8::f32x4 y0 = acc[ai][bj][m][0], y1 = acc[ai][bj][m][1];
                    const bool normed = qtile || bj == 0;
                    if (normed) {
                        const float ss = rw[(ai * 128 + m * 16) * 8 + bj * 4] + rx[(ai * 128 + m * 16) * 8 + bj * 4];
                        const float rstd = 1.0f / sqrtf(ss * (1.0f / 64.0f) + EPS);
                        y0 = y0 * rstd * g0; y1 = y1 * rstd * g1;
                        if (rot) {
#pragma unroll
                            for (int j = 0; j < 4; ++j) { const float own = y0[j];
                                const auto rr = __builtin_amdgcn_permlane32_swap(__float_as_uint(own), __float_as_uint(own), false, false);
                                const float pr = __uint_as_float(fq >= 2 ? rr[0] : rr[1]);
                                y0[j] = fq < 2 ? own * cs[j] - pr * sn[j] : pr * sn[j] + own * cs[j]; }
                        }
                    }
                    if (qtile) {
                        const float qs = 0.125f * 1.4426950408889634f;
                        bf16* qp = QB + ((size_t)(b * 2 + pn) * SEQ + t) * 256 + (2 * bj + (wc >> 1)) * 64 + hc;
                        u32x2 o0, o1; o0.x = pk2(y0[0] * qs, y0[1] * qs); o0.y = pk2(y0[2] * qs, y0[3] * qs); o1.x = pk2(y1[0] * qs, y1[1] * qs); o1.y = pk2(y1[2] * qs, y1[3] * qs);
                        *(u32x2*)qp = o0; *(u32x2*)(qp + 16) = o1;
                    } else {
                        const int kc = bj * 128 + (wc >> 1) * 64 + hc;
                        float* op = br == 0 ? out + O_KVC_P + (size_t)r * 256 : br == 1 ? out + O_KVS_P + (size_t)r * 256 : (t >= SEQ - 512 ? out + O_KVW_P + (size_t)(b * 512 + t - (SEQ - 512)) * 256 : nullptr);
                        if (op) { *(pg8::f32x4*)(op + kc) = y0; *(pg8::f32x4*)(op + kc + 16) = y1; }
                        if (br > 0) { bf16* kp = (bj ? VB : KB) + ((size_t)(((br - 1) * NBP + b) * 2 + (wc >> 1)) * SEQ + t) * 64 + hc;
                            u32x2 o0, o1; o0.x = pk2(y0[0], y0[1]); o0.y = pk2(y0[2], y0[3]); o1.x = pk2(y1[0], y1[1]); o1.y = pk2(y1[2], y1[3]);
                            *(u32x2*)kp = o0; *(u32x2*)(kp + 16) = o1; }
                    }
                }
                asm volatile("" ::: "memory");
            }
    }
};

enum { PH_PREP = 0, PH_H, PH_INPROJ, PH_SSM1, PH_CMPGEMM, PH_ATTN, PH_MIXIN, PH_OUT, PH_H2, PH_UP, PH_DOWN, PH_N };
constexpr int BAR_LDS_OFF = 148 * 1024;
constexpr int CW_BAR = 4096;

template <int PH>
__device__ __forceinline__ void run_phase(const P& p, LAS unsigned char* lds) {
    unsigned char* ws = p.ws;
    if constexpr (PH == PH_PREP) ph_prep(p, lds);
    if constexpr (PH == PH_H) { ph_normmod<0>(p); ph_cmpf<0>(p, lds); }
    if constexpr (PH == PH_INPROJ) { pg8::Gemm g{(const bf16*)(ws + WS_H), (const bf16*)(ws + WS_WIN_T), MP, INP, D}; pg8::StaticOrder S; S.init(MP, INP, gridDim.x, blockIdx.x);
        EpiInproj E{p.out, (bf16*)(ws + WS_QB), (bf16*)(ws + WS_KB), (bf16*)(ws + WS_VB), (float*)(ws + WS_GATES), (float*)(ws + WS_U), (const float*)(ws + WS_ROPE), p.q_g, p.k_g, (LAS float*)(lds + 132 * 1024)};
        pg8::gemm_phase<EpiInproj, pg8::StaticOrder>(lds, g, S, E, nullptr);
        skinny_gemm<SK_Z, 1024>(p, lds, (const bf16*)(ws + WS_H) + (size_t)MP * D, (const bf16*)(ws + WS_WIN_T), 29, 0); }
    if constexpr (PH == PH_SSM1) { ph_split(p, lds); __syncthreads(); ph_ssm<1>(p, lds, 0, (int)gridDim.x, 0, NBP * NSG * NCH, 1 << 30, 0); }
    if constexpr (PH == PH_CMPGEMM) {
        constexpr int NP = NBP * NSG * NCH, NS = DB * NSG;
        if (gridDim.x == 256) {
            if (blockIdx.x < 64) { ph_cmpf_small(p, lds, blockIdx.x); __syncthreads(); ph_ssm<2>(p, lds, 0, 64, NP - 512, NP, 1 << 30, 0); }
            else ph_ssm<2>(p, lds, 64, 256, 0, NP - 512 + NS, NP - 512, 512);
        } else { for (int u = blockIdx.x; u < 64; u += gridDim.x) { ph_cmpf_small(p, lds, u); } __syncthreads(); ph_ssm<2>(p, lds, 0, (int)gridDim.x, 0, NP + NS, 1 << 30, 0); } }
    if constexpr (PH == PH_ATTN) { ph_attn_prompt(p, lds); __syncthreads(); ph_attn_sample(p, lds); __syncthreads();
        { pg8::Gemm g{(const bf16*)(ws + WS_SB), (const bf16*)(ws + WS_WGLU_T), MP, 512, 512}; pg8::StaticOrder S; S.init(MP, 512, gridDim.x, blockIdx.x);
        EpiGlu E{(const float*)(ws + WS_SF), (float*)(ws + WS_S2), p.b_glu}; pg8::gemm_phase<EpiGlu, pg8::StaticOrder>(lds, g, S, E, nullptr);
        skinny_gemm<SK_GLU, 512>(p, lds, (const bf16*)(ws + WS_SB) + (size_t)MP * 512, (const bf16*)(ws + WS_WGLU_T), 8, (int)gridDim.x / 2); }
        __syncthreads();
        ph_late_transposes(p, lds, (int)gridDim.x / 2, (int)gridDim.x); }
    if constexpr (PH == PH_MIXIN) ph_mixin(p);
    if constexpr (PH == PH_OUT) { pg8::Gemm g{(const bf16*)(ws + WS_MIX), (const bf16*)(ws + WS_WOUT_T), MP, D, D}; pg8::StaticOrder S; S.init(MP, D, gridDim.x, blockIdx.x);
        EpiOut E{p.xp, p.xs, (const float*)(ws + WS_ADA), (float*)(ws + WS_X1)}; pg8::gemm_phase<EpiOut, pg8::StaticOrder>(lds, g, S, E, nullptr);
        skinny_gemm<SK_OUT, 1024>(p, lds, (const bf16*)(ws + WS_MIX) + (size_t)MP * D, (const bf16*)(ws + WS_WOUT_T), 16, 0); }
    if constexpr (PH == PH_H2) ph_normmod<1>(p);
    if constexpr (PH == PH_UP) { pg8::Gemm g{(const bf16*)(ws + WS_H), (const bf16*)(ws + WS_WUP_T), MP, 2 * DFF, D}; pg8::StaticOrder S; S.init(MP, 2 * DFF, gridDim.x, blockIdx.x);
        EpiUp E{(bf16*)(ws + WS_FF)}; pg8::gemm_phase<EpiUp, pg8::StaticOrder>(lds, g, S, E, nullptr);
        skinny_gemm<SK_UP, 1024>(p, lds, (const bf16*)(ws + WS_H) + (size_t)MP * D, (const bf16*)(ws + WS_WUP_T), 88, (int)gridDim.x / 2); }
    if constexpr (PH == PH_DOWN) { pg8::Gemm g{(const bf16*)(ws + WS_FF), (const bf16*)(ws + WS_WDN_T), MP, D, DFF}; pg8::StaticOrder S; S.init(MP, D, gridDim.x, blockIdx.x);
        EpiDown E{(const float*)(ws + WS_X1), (const float*)(ws + WS_ADA), p.out}; pg8::gemm_phase<EpiDown, pg8::StaticOrder>(lds, g, S, E, nullptr);
        skinny_gemm<SK_DOWN, 2816>(p, lds, (const bf16*)(ws + WS_FF) + (size_t)MP * DFF, (const bf16*)(ws + WS_WDN_T), 16, 0); }
}

#ifndef REPMASK
#define REPMASK 0u
#endif
template <int PH, int HI>
__device__ __forceinline__ void run_from(const P& p, LAS unsigned char* lds, const XcdBarrier& bar) {
    run_phase<PH>(p, lds);
    if constexpr (((REPMASK) >> PH) & 1u) { xcd_barrier(bar); run_phase<PH>(p, lds); }
    if constexpr (PH + 1 < HI) { xcd_barrier(bar); run_from<PH + 1, HI>(p, lds, bar); }
}

template <int LO, int HI>
__global__ void __launch_bounds__(512, 2) k_fwd(P p) {
    extern __shared__ __attribute__((aligned(16))) unsigned char lds_raw[];
    LAS unsigned char* lds = (LAS unsigned char*)lds_raw;
    if (threadIdx.x < 4) ((LAS unsigned*)(lds + BAR_LDS_OFF))[threadIdx.x] = 0u;
    __syncthreads();
    XcdBarrier bar; bar.bar = (unsigned*)(p.ws + WS_CTL) + CW_BAR; bar.x = 0; bar.st = (volatile LAS unsigned*)(lds + BAR_LDS_OFF);
    if constexpr (HI - LO > 1) bar = xcd_barrier_post((unsigned*)(p.ws + WS_CTL) + CW_BAR, (volatile LAS unsigned*)(lds + BAR_LDS_OFF));
    run_from<LO, HI>(p, lds, bar);
}

extern "C" void kernel_launch(void* const* d_in, const int* in_sizes, int n_in, void* d_out, int out_size, void* d_ws, size_t ws_size, hipStream_t stream) {
    if (n_in != 39 || (size_t)out_size != O_END || ws_size < WS_END) { fprintf(stderr, "kernel_launch: unexpected shapes (n_in %d out %d ws %zu need %zu)\n", n_in, out_size, ws_size, (size_t)WS_END); return; }
    static int grid = 0;
    if (grid == 0) {
        int dev = 0, cus = 0, per_cu = 0;
        if (hipGetDevice(&dev) != hipSuccess || hipDeviceGetAttribute(&cus, hipDeviceAttributeMultiprocessorCount, dev) != hipSuccess) { fprintf(stderr, "kernel_launch: device query failed\n"); grid = -1; return; }
        if (hipFuncSetAttribute((const void*)k_fwd<0, PH_N>, hipFuncAttributeMaxDynamicSharedMemorySize, LDS_BYTES) != hipSuccess) { fprintf(stderr, "kernel_launch: hipFuncSetAttribute failed\n"); grid = -1; return; }
        if (hipOccupancyMaxActiveBlocksPerMultiprocessor(&per_cu, (const void*)k_fwd<0, PH_N>, 512, LDS_BYTES) != hipSuccess || per_cu < 1) { fprintf(stderr, "kernel_launch: occupancy query says %d blocks per CU\n", per_cu); (void)hipGetLastError(); grid = -1; return; }
        grid = cus;
    }
    if (grid < 0) return;
    P p{};
    p.xp = (const float*)d_in[0]; p.xs = (const float*)d_in[1]; p.cache_c = (const float*)d_in[2]; p.cache_s = (const float*)d_in[3]; p.cache_w = (const float*)d_in[4];
    p.st_re = (const float*)d_in[5]; p.st_im = (const float*)d_in[6]; p.pt = (const int*)d_in[7]; p.cp = (const float*)d_in[8]; p.cs = (const float*)d_in[9];
    p.norm_mix_g = (const float*)d_in[10]; p.w_ada = (const float*)d_in[11]; p.b_ada = (const float*)d_in[12]; p.w_in = (const float*)d_in[13]; p.q_g = (const float*)d_in[14]; p.k_g = (const float*)d_in[15];
    p.pe_k = (const float*)d_in[16]; p.w1_k = (const float*)d_in[17]; p.w2_k = (const float*)d_in[18]; p.pe_v = (const float*)d_in[19]; p.w1_v = (const float*)d_in[20]; p.w2_v = (const float*)d_in[21];
    p.a_re = (const float*)d_in[22]; p.a_im = (const float*)d_in[23]; p.log_dt = (const float*)d_in[24]; p.b_re = (const float*)d_in[25]; p.b_im = (const float*)d_in[26]; p.c_re = (const float*)d_in[27]; p.c_im = (const float*)d_in[28];
    p.ssm_d = (const float*)d_in[29]; p.w_glu = (const float*)d_in[30]; p.b_glu = (const float*)d_in[31]; p.attn_g = (const float*)d_in[32]; p.ssm_g = (const float*)d_in[33]; p.w_out = (const float*)d_in[34];
    p.norm_ffn_g = (const float*)d_in[35]; p.w_gate = (const float*)d_in[36]; p.w_up = (const float*)d_in[37]; p.w_down = (const float*)d_in[38];
    p.out = (float*)d_out; p.ws = (unsigned char*)d_ws;
    if (hipMemsetAsync((char*)d_ws + WS_CTL, 0, (size_t)(CW_BAR + XCD_BAR_WORDS) * 4, stream) != hipSuccess) { fprintf(stderr, "kernel_launch: memset failed\n"); return; }
    hipLaunchKernelGGL((k_fwd<0, PH_N>), dim3(grid), dim3(512), LDS_BYTES, stream, p);
}
```

```cpp
#include <hip/hip_runtime.h>
#include <cstdio>
#include <cstdint>
#include <cstddef>

namespace pg8 {
#define PG8_LAS __attribute__((address_space(3)))
typedef unsigned short bf16_t;
typedef short bf16x8 __attribute__((ext_vector_type(8)));
typedef float f32x4 __attribute__((ext_vector_type(4)));
typedef unsigned u32x4 __attribute__((ext_vector_type(4)));
constexpr int BM = 256, BK = 64, HALF = 128, HTB = HALF * BK * 2  , STAGE_BYTES = 8 * HTB, NXCD = 8, WGM = 8;

__host__ __device__ __forceinline__ int lds_byte(int r, int c) { const int st = (r >> 4) * 2 + (c >> 5), rr = r & 15, cc = c & 31, ob = rr * 64 + cc * 2; return st * 1024 + (ob ^ (((ob >> 9) & 1) << 5)); }
__host__ __device__ __forceinline__ void stage_rc(int b, int& R, int& C) { const int st = b / 1024, sb = b % 1024, swz = sb ^ (((sb >> 9) & 1) << 5); R = (st >> 1) * 16 + swz / 64; C = (st & 1) * 32 + (swz % 64) / 2; }
__host__ __device__ __forceinline__ int perm32(int rho) { const int n = rho >> 4, i = rho & 15; return 8 * (i >> 2) + 4 * n + (i & 3); }

struct Unit { int pm, pn; };
struct Gemm { const bf16_t* A; const bf16_t* Bt; int M, N, K; };

struct StaticOrder {
    int nM, nN, nwg, G, c;
    __host__ __device__ void init(int M, int N, int G_, int c_) { nM = M / BM; nN = N / BM; nwg = nM * nN; G = G_; c = c_; }
    __host__ __device__ bool next(int i, Unit& u) const {
        const long L = (long)i * G + c; if (L >= nwg) return false;
        int wgid = (int)L; { const int q = nwg / NXCD, r = nwg % NXCD, xcd = wgid % NXCD, off = wgid / NXCD; wgid = (xcd < r ? xcd * (q + 1) : r * (q + 1) + (xcd - r) * q) + off; }
        const int nig = WGM * nN, gid = wgid / nig, fm = gid * WGM, gsz = (nM - fm) < WGM ? (nM - fm) : WGM;
        u.pm = fm + ((wgid % nig) % gsz); u.pn = (wgid % nig) / gsz; return true;
    }
    __device__ __forceinline__ void a_ready(const Unit&) const {}
    __device__ __forceinline__ void done(const Unit&) const {}
};
__device__ __forceinline__ unsigned cvt_pk_bf16(float lo, float hi) { unsigned r; asm volatile("v_cvt_pk_bf16_f32 %0, %1, %2" : "=v"(r) : "v"(lo), "v"(hi)); return r; }
typedef float f32x2 __attribute__((ext_vector_type(2)));
struct EpiF32 {
    static constexpr bool PERM = false, AFTER_DRAIN = false;
    float* C; int ldc; const float* bias;
    __device__ __forceinline__ void operator()(const f32x4 (&acc)[2][2][4][2], const Unit& u, int wr, int wc, int fr, int fq) const {
        const int row0 = u.pm * BM + wr * 64 + fr, col0 = u.pn * BM + wc * 32 + 4 * fq;
        f32x4 bv[2][2];
#pragma unroll
        for (int bj = 0; bj < 2; ++bj)
#pragma unroll
            for (int n = 0; n < 2; ++n) bv[bj][n] = bias ? *(const f32x4*)(bias + col0 + bj * HALF + n * 16) : (f32x4){0.f, 0.f, 0.f, 0.f};
#pragma unroll
        for (int ai = 0; ai < 2; ++ai)
#pragma unroll
            for (int m = 0; m < 4; ++m) { float* rowp = C + (size_t)(row0 + ai * HALF + m * 16) * ldc + col0;
#pragma unroll
                for (int bj = 0; bj < 2; ++bj)
#pragma unroll
                    for (int n = 0; n < 2; ++n) *(f32x4*)(rowp + bj * HALF + n * 16) = acc[ai][bj][m][n] + bv[bj][n]; }
    }
};
template <class Epi, class Sched, bool STAMP = false>
__device__ __forceinline__ void gemm_phase(PG8_LAS unsigned char* lds, const Gemm g, const Sched& S, const Epi& E, unsigned long long* stamps) {
    int tid_ = threadIdx.x; asm volatile("" : "+v"(tid_));
    const int tid = tid_, wid = __builtin_amdgcn_readfirstlane(tid >> 6), lane = tid & 63, wr = wid >> 2, wc = wid & 3, fr = lane & 15, fq = lane >> 4;
    const int K = g.K, nt = K / BK;
    int ts_lo = 0, ts_hi = 0, nts = 0; const unsigned long long rt_entry = STAMP ? (unsigned long long)wall_clock64() : 0ull;
#define PG8_STAMP() do { if (STAMP && wid == 0 && nts < 64) { const unsigned long long _c = (unsigned long long)clock64(); \
        ts_lo = (lane == nts) ? (int)(unsigned)_c : ts_lo; ts_hi = (lane == nts) ? (int)(unsigned)(_c >> 32) : ts_hi; ++nts; } } while (0)
    PG8_STAMP();
    unsigned voffA[2], voffB[2];
#pragma unroll
    for (int i = 0; i < 2; ++i) { int R, C; stage_rc(tid * 16 + i * 8192, R, C); const int Rb = Epi::PERM ? ((R & ~31) + perm32(R & 31)) : R;
        voffA[i] = (unsigned)(R * K + C) * 2u; voffB[i] = (unsigned)(Rb * K + C) * 2u; }
    const size_t kstep = (size_t)(BK * 2);
    const size_t hstep = (size_t)HALF * K * 2;
    const size_t tstep = 2 * hstep;
    const unsigned ldsw = (unsigned)wid * 1024u;
    const int aoff = lds_byte(wr * 64 + fr, fq * 8), boff = lds_byte(wc * 32 + fr, fq * 8);
#define PG8_SA(b, h) (((b) * 2 + (h)) * HTB)
#define PG8_SB(b, h) ((4 + (b) * 2 + (h)) * HTB)
#define PG8_STAGE(bufoff, gbase, voff) do { _Pragma("unroll") for (int _i = 0; _i < 2; ++_i) \
        __builtin_amdgcn_global_load_lds((const unsigned*)((const char*)(gbase) + (voff)[_i]), (PG8_LAS unsigned*)(lds + (bufoff) + ldsw + _i * 8192), 16, 0, 0); } while (0)
#define PG8_LDA(dst, b, h) do { _Pragma("unroll") for (int m = 0; m < 4; ++m) _Pragma("unroll") for (int k = 0; k < 2; ++k) dst[m][k] = *(const PG8_LAS bf16x8*)(lds + PG8_SA(b, h) + aoff + m * 2048 + k * 1024); } while (0)
#define PG8_LDB(dst, b, h) do { _Pragma("unroll") for (int n = 0; n < 2; ++n) _Pragma("unroll") for (int k = 0; k < 2; ++k) dst[n][k] = *(const PG8_LAS bf16x8*)(lds + PG8_SB(b, h) + boff + n * 2048 + k * 1024); } while (0)
#define PG8_MMA(ai, bj, At, Bt) do { __builtin_amdgcn_s_setprio(1); _Pragma("unroll") for (int m = 0; m < 4; ++m) _Pragma("unroll") for (int n = 0; n < 2; ++n) _Pragma("unroll") for (int k = 0; k < 2; ++k) \
        acc[ai][bj][m][n] = __builtin_amdgcn_mfma_f32_16x16x32_bf16(Bt[n][k], At[m][k], acc[ai][bj][m][n], 0, 0, 0); __builtin_amdgcn_s_setprio(0); } while (0)
#define PG8_WAIT_V(n) asm volatile("s_waitcnt vmcnt(" #n ")" ::: "memory")
#define PG8_WAIT_L(n) asm volatile("s_waitcnt lgkmcnt(" #n ")" ::: "memory")
#define PG8_BAR __builtin_amdgcn_s_barrier()
#define PG8_SCHED __builtin_amdgcn_sched_barrier(0)
    Unit cur, nxt; int ui = 0;
    if (!S.next(0, cur)) return;
    f32x4 acc[2][2][4][2];
#pragma unroll
    for (int a = 0; a < 2; ++a)
#pragma unroll
        for (int b = 0; b < 2; ++b)
#pragma unroll
            for (int m = 0; m < 4; ++m)
#pragma unroll
                for (int n = 0; n < 2; ++n) acc[a][b][m][n] = (f32x4){0.f, 0.f, 0.f, 0.f};
    bf16x8 At[4][2], B0[2][2], B1[2][2];
    const char* cA = (const char*)g.A + (size_t)cur.pm * tstep; const char* cB = (const char*)g.Bt + (size_t)cur.pn * tstep;
    S.a_ready(cur);
    PG8_STAGE(PG8_SB(0, 0), cB, voffB); PG8_STAGE(PG8_SA(0, 0), cA, voffA); PG8_STAGE(PG8_SB(0, 1), cB + hstep, voffB); PG8_STAGE(PG8_SA(0, 1), cA + hstep, voffA);
    if (wr == 1) PG8_BAR;
    PG8_WAIT_V(4); PG8_BAR;
    PG8_STAGE(PG8_SB(1, 0), cB + kstep, voffB); PG8_STAGE(PG8_SA(1, 0), cA + kstep, voffA); PG8_STAGE(PG8_SB(1, 1), cB + hstep + kstep, voffB);
    PG8_WAIT_V(6); PG8_BAR;
    PG8_STAMP();
    for (;;) {
        const bool has_next = S.next(ui + 1, nxt);
        const char* nA = has_next ? (const char*)g.A + (size_t)nxt.pm * tstep : cA; const char* nB = has_next ? (const char*)g.Bt + (size_t)nxt.pn * tstep : cB;
        for (int t = 0; t < nt; t += 2) {
            const bool last = (t == nt - 2);
            const char* a1 = cA + (size_t)(t + 1) * kstep;
            const char* a2 = last ? nA : cA + (size_t)(t + 2) * kstep; const char* b2 = last ? nB : cB + (size_t)(t + 2) * kstep;
            const char* a3 = a2 + kstep; const char* b3 = b2 + kstep;
            if (last && has_next) S.a_ready(nxt);
            PG8_LDB(B0, 0, 0); PG8_SCHED; PG8_LDA(At, 0, 0); PG8_STAGE(PG8_SA(1, 1), a1 + hstep, voffA);
            PG8_WAIT_L(8); PG8_BAR; PG8_WAIT_L(0); PG8_MMA(0, 0, At, B0); PG8_BAR; PG8_SCHED;
            PG8_LDB(B1, 0, 1); PG8_STAGE(PG8_SB(0, 0), b2, voffB);
            PG8_BAR; PG8_WAIT_L(0); PG8_MMA(0, 1, At, B1); PG8_BAR;
            PG8_LDA(At, 0, 1); PG8_STAGE(PG8_SA(0, 0), a2, voffA);
            PG8_BAR; PG8_WAIT_L(0); PG8_MMA(1, 0, At, B0); PG8_BAR; PG8_SCHED;
            PG8_STAGE(PG8_SB(0, 1), b2 + hstep, voffB);
            PG8_WAIT_V(6); PG8_BAR; PG8_MMA(1, 1, At, B1); PG8_BAR;
            PG8_LDB(B0, 1, 0); PG8_SCHED; PG8_LDA(At, 1, 0); PG8_STAGE(PG8_SA(0, 1), a2 + hstep, voffA);
            PG8_WAIT_L(8); PG8_BAR; PG8_WAIT_L(0); PG8_MMA(0, 0, At, B0); PG8_BAR; PG8_SCHED;
            PG8_LDB(B1, 1, 1); PG8_STAGE(PG8_SB(1, 0), b3, voffB);
            PG8_BAR; PG8_WAIT_L(0); PG8_MMA(0, 1, At, B1); PG8_BAR;
            PG8_LDA(At, 1, 1); PG8_STAGE(PG8_SA(1, 0), a3, voffA);
            PG8_BAR; PG8_WAIT_L(0); PG8_MMA(1, 0, At, B0); PG8_BAR; PG8_SCHED;
            PG8_STAGE(PG8_SB(1, 1), b3 + hstep, voffB);
            PG8_WAIT_V(6); PG8_BAR; PG8_MMA(1, 1, At, B1); PG8_BAR;
        }
        PG8_STAMP();
        if constexpr (!Epi::AFTER_DRAIN) { E(acc, cur, wr, wc, fr, fq); S.done(cur); }
        PG8_STAMP();
        if (!has_next) break;
#pragma unroll
        for (int a = 0; a < 2; ++a)
#pragma unroll
            for (int b = 0; b < 2; ++b)
#pragma unroll
                for (int m = 0; m < 4; ++m)
#pragma unroll
                    for (int n = 0; n < 2; ++n) acc[a][b][m][n] = (f32x4){0.f, 0.f, 0.f, 0.f};
        cur = nxt; cA = nA; cB = nB; ++ui;
    }
    PG8_WAIT_V(0);
    if (wr == 0) PG8_BAR;
    PG8_BAR;
    if constexpr (Epi::AFTER_DRAIN) { E.fused(acc, cur, wr, wc, fr, fq, lds, wid, lane); S.done(cur); }
    PG8_STAMP();
    if (STAMP && wid == 0) { stamps[lane] = lane < nts ? (((unsigned long long)(unsigned)ts_hi << 32) | (unsigned)ts_lo) : 0ull;
        if (lane == 62) stamps[62] = rt_entry; if (lane == 63) stamps[63] = (unsigned long long)wall_clock64(); }
#undef PG8_STAMP
#undef PG8_SA
#undef PG8_SB
#undef PG8_STAGE
#undef PG8_LDA
#undef PG8_LDB
#undef PG8_MMA
#undef PG8_WAIT_V
#undef PG8_WAIT_L
#undef PG8_BAR
#undef PG8_SCHED
}
}

#define LAS __attribute__((address_space(3)))
typedef unsigned short bf16;
typedef float f32x4 __attribute__((ext_vector_type(4)));
typedef unsigned u32x4 __attribute__((ext_vector_type(4)));
typedef unsigned u32x2 __attribute__((ext_vector_type(2)));

constexpr int D = 1024, SEQ = 8192, NBP = 2, MP = NBP * SEQ;
constexpr int DB = 32, DSQ = 4, MS = DB * DSQ, MR = MP + MS;
constexpr int MPAD = 16640;
constexpr int PAST = 16384, PAGE = 128, NPG = 128;
constexpr int HD = 64, AW = 512, NH = 8, GQ = 4, NKV = 2;
constexpr int SW = 512, SG = 16, NSG = 32, SST = 64;
constexpr int INC = 1816, INP = 2048, O1 = 512, O2 = 1280, O3 = 1304;
constexpr int DFF = 2816;
constexpr int NC_P = 511, NC_S = 1023;
constexpr int CMP_ROWS_S = DB * 1024 * 2, CMP_ROWS_P = NBP * 512 * 2, CMP_ROWS = CMP_ROWS_S + CMP_ROWS_P;
constexpr int CMPO_S = DB * NC_S * 2 * 64, CMPO_P = NBP * NC_P * 2 * 64, CMPO = CMPO_S + CMPO_P;
constexpr float EPS = 1e-6f;
constexpr int SCH = 128, NCH = SEQ / SCH;

constexpr size_t O_YP = 0, O_YS = 16777216, O_KVC_P = 16908288, O_KVS_P = 21102592, O_KVW_P = 25296896, O_SRE_P = 25559040, O_SIM_P = 25563136,
                 O_KVC_S = 25567232, O_KVS_S = 25600000, O_KVW_S = 25632768, O_SRE_S = 25665536, O_SIM_S = 25731072, O_END = 25796608;

constexpr size_t A256(size_t x) { return (x + 255) & ~(size_t)255; }
constexpr size_t WS_CTL    = 0;
constexpr size_t WS_ADA    = (size_t)1 << 20;
constexpr size_t WS_LB     = WS_ADA + A256((size_t)34 * 6144 * 4);
constexpr size_t WS_BBR    = WS_LB + A256(2048 * 2 * 4);
constexpr size_t WS_BBI    = WS_BBR + A256(2048 * 16 * 4);
constexpr size_t WS_PEB    = WS_BBI + A256(2048 * 16 * 4);
constexpr size_t WS_WIN_T  = WS_PEB + A256(2 * 8 * 128 * 4);
constexpr size_t WS_WGLU_T = WS_WIN_T + (size_t)2048 * 1024 * 2;
constexpr size_t WS_WOUT_T = WS_WGLU_T + (size_t)512 * 512 * 2;
constexpr size_t WS_WUP_T  = WS_WOUT_T + (size_t)1024 * 1024 * 2;
constexpr size_t WS_WDN_T  = WS_WUP_T + (size_t)5632 * 1024 * 2;
constexpr size_t WS_WC1_T  = WS_WDN_T + (size_t)1024 * 2816 * 2;
constexpr size_t WS_H      = WS_WC1_T + (size_t)2 * 256 * 1024 * 2;
constexpr size_t WS_Z      = WS_H + (size_t)MPAD * 1024 * 2;
constexpr size_t WS_Q      = WS_Z + (size_t)MPAD * 2048 * 4;
constexpr size_t WS_KV3    = WS_Q + (size_t)MR * 512 * 4;
constexpr size_t WS_GATES  = WS_KV3 + (size_t)3 * MR * 256 * 4;
constexpr size_t WS_U      = WS_GATES + A256((size_t)MR * 24 * 4);
constexpr size_t WS_ACMP   = WS_U + (size_t)MR * 512 * 4;
constexpr size_t WS_PC     = WS_ACMP + (size_t)2 * CMP_ROWS * 1024 * 2;
constexpr size_t WS_CMPKV  = WS_PC + (size_t)2 * CMP_ROWS * 256 * 4;
constexpr size_t WS_E      = WS_CMPKV + A256((size_t)2 * CMPO * 4);
constexpr size_t WS_SF     = WS_E + (size_t)NBP * NSG * NCH * 64 * 2 * 4;
constexpr size_t WS_SB     = WS_SF + (size_t)MPAD * 512 * 4;
constexpr size_t WS_ATTN   = WS_SB + (size_t)MPAD * 512 * 2;
constexpr size_t WS_S2     = WS_ATTN + (size_t)MR * 512 * 4;
constexpr size_t WS_MIX    = WS_S2 + (size_t)MPAD * 512 * 4;
constexpr size_t WS_X1     = WS_MIX + (size_t)MPAD * 1024 * 2;
constexpr size_t WS_FF     = WS_X1 + (size_t)MPAD * 1024 * 4;
constexpr size_t WS_QB     = WS_FF + (size_t)MPAD * 2816 * 2;
constexpr size_t WS_KB     = WS_QB + (size_t)NBP * 2 * SEQ * 256 * 2;
constexpr size_t WS_VB     = WS_KB + (size_t)2 * NBP * 2 * SEQ * 64 * 2;
constexpr size_t WS_KCB    = WS_VB + (size_t)2 * NBP * 2 * SEQ * 64 * 2;
constexpr size_t WS_ROPE   = WS_KCB + (size_t)2 * NBP * 2 * 512 * 64 * 2;
constexpr size_t WS_END    = WS_ROPE + (size_t)SEQ * 16 * 4;

constexpr int LDS_BYTES = 150 * 1024;

struct P {
    const float *xp, *xs, *cache_c, *cache_s, *cache_w, *st_re, *st_im; const int* pt;
    const float *cp, *cs, *norm_mix_g, *w_ada, *b_ada, *w_in, *q_g, *k_g, *pe_k, *w1_k, *w2_k, *pe_v, *w1_v, *w2_v;
    const float *a_re, *a_im, *log_dt, *b_re, *b_im, *c_re, *c_im, *ssm_d, *w_glu, *b_glu, *attn_g, *ssm_g, *w_out, *norm_ffn_g, *w_gate, *w_up, *w_down;
    float* out; unsigned char* ws;
};

__device__ __forceinline__ int tid_now() { int t = threadIdx.x; asm volatile("" : "+v"(t)); return t; }
__device__ __forceinline__ unsigned pk2(float lo, float hi) { unsigned r; asm("v_cvt_pk_bf16_f32 %0, %1, %2" : "=v"(r) : "v"(lo), "v"(hi)); return r; }
__device__ __forceinline__ unsigned f2bf(float f) { return pk2(f, 0.f) & 0xffffu; }
template <int CTRL> __device__ __forceinline__ float dpp_mov(float v) { return __int_as_float(__builtin_amdgcn_update_dpp(0, __float_as_int(v), CTRL, 0xF, 0xF, true)); }
__device__ __forceinline__ float wave_sum(float v) {
    v += dpp_mov<0xB1>(v); v += dpp_mov<0x4E>(v); v += dpp_mov<0x141>(v); v += dpp_mov<0x140>(v);
    const float a = __int_as_float(__builtin_amdgcn_readlane(__float_as_int(v), 0)), b = __int_as_float(__builtin_amdgcn_readlane(__float_as_int(v), 16));
    const float c = __int_as_float(__builtin_amdgcn_readlane(__float_as_int(v), 32)), d = __int_as_float(__builtin_amdgcn_readlane(__float_as_int(v), 48));
    return (a + b) + (c + d);
}
__device__ __forceinline__ float wave_max(float v) {
    v = fmaxf(v, dpp_mov<0xB1>(v)); v = fmaxf(v, dpp_mov<0x4E>(v)); v = fmaxf(v, dpp_mov<0x141>(v)); v = fmaxf(v, dpp_mov<0x140>(v));
    const float a = __int_as_float(__builtin_amdgcn_readlane(__float_as_int(v), 0)), b = __int_as_float(__builtin_amdgcn_readlane(__float_as_int(v), 16));
    const float c = __int_as_float(__builtin_amdgcn_readlane(__float_as_int(v), 32)), d = __int_as_float(__builtin_amdgcn_readlane(__float_as_int(v), 48));
    return fmaxf(fmaxf(a, b), fmaxf(c, d));
}
__device__ __forceinline__ float rdlane(float v, int l) { return __int_as_float(__builtin_amdgcn_readlane(__float_as_int(v), l)); }
__device__ __forceinline__ float sigmoid_f(float x) { return 1.0f / (1.0f + expf(-x)); }
__device__ __forceinline__ float silu_f(float x) { return x / (1.0f + expf(-x)); }
__device__ __forceinline__ float gelu_tanh(float x) {
    const float y = 0.7978845608028654f * (x + 0.044715f * x * x * x);
    const float t = 1.0f - 2.0f / (expf(2.0f * y) + 1.0f);
    return 0.5f * x * (1.0f + t);
}
__device__ __forceinline__ void sincos_d(double x, double& s, double& c) {
    const double k = rint(x * 0.63661977236758134308);
    double y = fma(-k, 1.57079632679489655800e+00, x);
    y = fma(-k, 6.12323399573676603587e-17, y);
    const double y2 = y * y;
    double sp = 1.0 / 355687428096000.0;
    sp = fma(sp, y2, -1.0 / 1307674368000.0); sp = fma(sp, y2, 1.0 / 6227020800.0); sp = fma(sp, y2, -1.0 / 39916800.0); sp = fma(sp, y2, 1.0 / 362880.0);
    sp = fma(sp, y2, -1.0 / 5040.0); sp = fma(sp, y2, 1.0 / 120.0); sp = fma(sp, y2, -1.0 / 6.0); sp = fma(sp, y2, 1.0);
    const double sy = sp * y;
    double cp = 1.0 / 20922789888000.0;
    cp = fma(cp, y2, -1.0 / 87178291200.0); cp = fma(cp, y2, 1.0 / 479001600.0); cp = fma(cp, y2, -1.0 / 3628800.0); cp = fma(cp, y2, 1.0 / 40320.0);
    cp = fma(cp, y2, -1.0 / 720.0); cp = fma(cp, y2, 1.0 / 24.0); cp = fma(cp, y2, -0.5); cp = fma(cp, y2, 1.0);
    const double cy = cp;
    const int q = (int)((long long)k & 3);
    s = (q == 0) ? sy : (q == 1) ? cy : (q == 2) ? -sy : -cy;
    c = (q == 0) ? cy : (q == 1) ? -sy : (q == 2) ? -cy : sy;
}
__device__ __forceinline__ const float* xrow_ptr(const P& p, int r) { return r < MP ? p.xp + (size_t)r * D : p.xs + (size_t)(r - MP) * D; }
__device__ __forceinline__ int ada_row(int r) { return r < MP ? r / SEQ : 2 + (r - MP) / DSQ; }

__device__ __forceinline__ void transpose_item(const float* W, int ldw, int nvalid, bf16* WT, int ldt, int kb, int nb, int rowmode, int rowoff, LAS float* scr, int lane) {
    const int k0 = 64 * kb, n0 = 32 * nb;
    { float v[32]; const int nn = n0 + (lane & 31);
#pragma unroll
      for (int i = 0; i < 32; ++i) v[i] = nn < nvalid ? __builtin_nontemporal_load(W + (size_t)(k0 + 2 * i + (lane >> 5)) * ldw + nn) : 0.f;
#pragma unroll
      for (int i = 0; i < 32; ++i) scr[(2 * i + (lane >> 5)) * 33 + (lane & 31)] = v[i]; }
    asm volatile("s_waitcnt lgkmcnt(0)" ::: "memory");
    const int c = lane & 7;
#pragma unroll
    for (int j = 0; j < 4; ++j) { const int n = (lane >> 3) + 8 * j, nn = n0 + n; const LAS float* s = scr + (8 * c) * 33 + n;
        u32x4 o; o.x = pk2(s[0 * 33], s[1 * 33]); o.y = pk2(s[2 * 33], s[3 * 33]); o.z = pk2(s[4 * 33], s[5 * 33]); o.w = pk2(s[6 * 33], s[7 * 33]);
        if (nn < nvalid) { const int drow = rowmode ? ((nn >> 7) * 256 + rowoff + (nn & 127)) : (rowoff + nn);
            *(u32x4*)(WT + (size_t)drow * ldt + k0 + 8 * c) = o; } }
    asm volatile("s_waitcnt lgkmcnt(0)" ::: "memory");
}

constexpr int PREP_JOBS = 224;
__device__ __forceinline__ f32x4 peb_load(const float* PEB, int kv, int col) {
    f32x4 s = *(const f32x4*)(PEB + (kv * 8) * 128 + col);
#pragma unroll
    for (int q = 1; q < 8; ++q) s += *(const f32x4*)(PEB + (kv * 8 + q) * 128 + col);
    return s;
}
__device__ __forceinline__ void ph_prep(const P& p, LAS unsigned char* lds) {
    const int tid = tid_now(), lane = tid & 63, wave = tid >> 6;
    unsigned char* ws = p.ws;
    for (int job = blockIdx.x; job < PREP_JOBS; job += gridDim.x) {
        if (job < 192) {
            LAS float* cbuf = (LAS float*)lds;
            { f32x4 cv[17];
#pragma unroll
              for (int it = 0; it < 17; ++it) { const int i = tid + it * 512, r = i >> 8, k4 = i & 255;
                  const float* src = r < 2 ? p.cp + r * D : p.cs + (r - 2) * D; cv[it] = *(const f32x4*)(src + k4 * 4); }
#pragma unroll
              for (int it = 0; it < 17; ++it) { const int i = tid + it * 512; f32x4 v = cv[it];
                  v.x = silu_f(v.x); v.y = silu_f(v.y); v.z = silu_f(v.z); v.w = silu_f(v.w);
                  *(LAS f32x4*)(cbuf + i * 4) = v; } }
            __syncthreads();
            const int c0 = job * 32, col = lane & 31, kh = lane >> 5, kbase = wave * 128 + kh * 64;
            float acc[34];
#pragma unroll
            for (int r = 0; r < 34; ++r) acc[r] = 0.f;
            const float* ub = p.w_ada + (size_t)(__builtin_amdgcn_readfirstlane(wave) * 128) * 6144 + c0;
            const unsigned voff = (unsigned)(kh * 64 * 6144 + col) * 4u;
            LAS const float* cb0 = cbuf + kbase; asm volatile("" : "+v"(cb0));
            LAS const float* cb1 = cb0 + 16 * D; asm volatile("" : "+v"(cb1));
            LAS const float* cb2 = cb0 + 32 * D; asm volatile("" : "+v"(cb2));
#pragma unroll
            for (int hb = 0; hb < 2; ++hb) {
                float wv[32];
#pragma unroll
                for (int k = 0; k < 32; ++k) wv[k] = __builtin_nontemporal_load((const float*)((const char*)(ub + (size_t)(hb * 32 + k) * 6144) + voff));
                asm volatile("" ::: "memory");
#pragma unroll
                for (int k4 = 0; k4 < 8; ++k4) {
#pragma unroll
                    for (int r = 0; r < 34; ++r) { const f32x4 cv = *(const LAS f32x4*)((r < 16 ? cb0 + r * D : r < 32 ? cb1 + (r - 16) * D : cb2 + (r - 32) * D) + hb * 32 + k4 * 4);
                        acc[r] += cv.x * wv[4 * k4] + cv.y * wv[4 * k4 + 1] + cv.z * wv[4 * k4 + 2] + cv.w * wv[4 * k4 + 3]; }
                    asm volatile("" ::: "memory");
                }
            }
            __syncthreads();
            LAS float* red = (LAS float*)lds;
#pragma unroll
            for (int r = 0; r < 34; ++r) red[((wave * 2 + kh) * 34 + r) * 32 + col] = acc[r];
            __syncthreads();
            float* ADA = (float*)(ws + WS_ADA);
            for (int o = tid; o < 34 * 32; o += 512) { const int r = o >> 5, c = o & 31; float s = p.b_ada[c0 + c];
#pragma unroll
                for (int w = 0; w < 16; ++w) s += red[(w * 34 + r) * 32 + c];
                ADA[(size_t)r * 6144 + c0 + c] = s; }
            __syncthreads();
        } else if (job < 208) {
            const int kv = (job - 192) >> 3, part = (job - 192) & 7; const float* pe = kv ? p.pe_v : p.pe_k; const float* w1 = kv ? p.w1_v : p.w1_k;
            float a0 = 0.f, a1 = 0.f;
#pragma unroll 1
            for (int kb = 0; kb < 2; ++kb) { const int k0 = part * 256 + wave * 32 + kb * 16; float x0[16], x1[16], pv[16];
#pragma unroll
                for (int u = 0; u < 16; ++u) { pv[u] = pe[k0 + u]; x0[u] = w1[(size_t)(k0 + u) * 128 + lane]; x1[u] = w1[(size_t)(k0 + u) * 128 + 64 + lane]; }
#pragma unroll
                for (int u = 0; u < 16; ++u) { a0 += pv[u] * x0[u]; a1 += pv[u] * x1[u]; } }
            LAS float* red = (LAS float*)lds;
            red[wave * 128 + lane] = a0; red[wave * 128 + 64 + lane] = a1;
            __syncthreads();
            if (tid < 128) { float s = 0.f;
#pragma unroll
                for (int w = 0; w < 8; ++w) s += red[w * 128 + tid];
                ((float*)(ws + WS_PEB))[(kv * 8 + part) * 128 + tid] = s; }
            __syncthreads();
        } else {
            const int sj = job - 208;
            float* LB = (float*)(ws + WS_LB); float* BBR = (float*)(ws + WS_BBR); float* BBI = (float*)(ws + WS_BBI);
            LAS double* fb = (LAS double*)lds;
            if (tid < 128) { const int idx = sj * 128 + tid, g = idx >> 6;
                const double dt = exp((double)p.log_dt[g]), are = (double)p.a_re[idx], aim = (double)p.a_im[idx];
                const double mag = exp(are * dt); double sn, cs; sincos_d(aim * dt, sn, cs);
                const double lbr = mag * cs, lbi = mag * sn, den = are * are + aim * aim, nre = lbr - 1.0;
                LB[idx * 2] = (float)lbr; LB[idx * 2 + 1] = (float)lbi;
                fb[tid * 2] = (nre * are + lbi * aim) / den; fb[tid * 2 + 1] = (lbi * are - nre * aim) / den; }
            __syncthreads();
#pragma unroll
            for (int it = 0; it < 4; ++it) { const int e = tid + it * 512, il = e >> 4, o = sj * 128 * SG + e;
                const double fre = fb[il * 2], fim = fb[il * 2 + 1], br = (double)p.b_re[o], bi = (double)p.b_im[o];
                BBR[o] = (float)(fre * br - fim * bi); BBI[o] = (float)(fre * bi + fim * br); }
            __syncthreads();
        }
    }
    __syncthreads();
    { float* ROPE = (float*)(ws + WS_ROPE);
      for (int idx = blockIdx.x * 512 + tid; idx < SEQ * 8; idx += gridDim.x * 512) { const int pos = idx >> 3, i = idx & 7;
          const double inv = exp(-(double)i * 1.640295422175541); double sd, cd; sincos_d((double)pos * inv, sd, cd);
          ROPE[pos * 16 + i] = (float)cd; ROPE[pos * 16 + 8 + i] = (float)sd; } }
    LAS float* scr = (LAS float*)(lds + wave * 8448);
    constexpr int I0 = 16 * 57, I1 = 8 * 16, I6 = 16 * 4;
    constexpr int NT = I0 + I1 + 4 * I6;
    const int it0 = (int)blockIdx.x * 8 + wave, step = (int)gridDim.x * 8, lim = NT;
    for (int it = it0; it < lim; it += step) {
        int r = it;
        if (r < I0) { transpose_item(p.w_in, INC, INC, (bf16*)(ws + WS_WIN_T), 1024, r / 57, r % 57, 0, 0, scr, lane); continue; } r -= I0;
        if (r < I1) { transpose_item(p.w_glu, 512, 512, (bf16*)(ws + WS_WGLU_T), 512, r / 16, r % 16, 0, 0, scr, lane); continue; } r -= I1;
        { const int m = r / I6, rr = r % I6, kv = m >> 1, half = m & 1; const float* w1 = kv ? p.w1_v : p.w1_k;
          transpose_item(w1 + (size_t)half * 1024 * 128, 128, 128, (bf16*)(ws + WS_WC1_T) + (size_t)kv * 256 * 1024, 1024, rr / 4, rr % 4, 0, half * 128, scr, lane); }
    }
}
__device__ __forceinline__ void ph_late_transposes(const P& p, LAS unsigned char* lds, int wg_lo, int wg_hi) {
    const int tid = tid_now(), lane = tid & 63, wave = tid >> 6;
    if ((int)blockIdx.x < wg_lo || (int)blockIdx.x >= wg_hi) return;
    unsigned char* ws = p.ws;
    LAS float* scr = (LAS float*)(lds + wave * 8448);
    constexpr int I2 = 16 * 32, I3 = 16 * 88, I5 = 44 * 32;
    constexpr int NT = I2 + 2 * I3 + I5;
    for (int it = ((int)blockIdx.x - wg_lo) * 8 + wave; it < NT; it += (wg_hi - wg_lo) * 8) {
        int r = it;
        if (r < I2) { transpose_item(p.w_out, 1024, 1024, (bf16*)(ws + WS_WOUT_T), 1024, r / 32, r % 32, 0, 0, scr, lane); continue; } r -= I2;
        if (r < I3) { transpose_item(p.w_gate, DFF, DFF, (bf16*)(ws + WS_WUP_T), 1024, r / 88, r % 88, 1, 0, scr, lane); continue; } r -= I3;
        if (r < I3) { transpose_item(p.w_up, DFF, DFF, (bf16*)(ws + WS_WUP_T), 1024, r / 88, r % 88, 1, 128, scr, lane); continue; } r -= I3;
        transpose_item(p.w_down, 1024, 1024, (bf16*)(ws + WS_WDN_T), DFF, r / 32, r % 32, 0, 0, scr, lane);
    }
}

template <int WHICH>
__device__ __forceinline__ void ph_normmod(const P& p) {
    const int tid = tid_now(), lane = tid & 63, wave = tid >> 6, gw = blockIdx.x * 8 + wave, NGW = gridDim.x * 8;
    const float* ADA = (const float*)(p.ws + WS_ADA); const float* gain = WHICH ? p.norm_ffn_g : p.norm_mix_g;
    bf16* H = (bf16*)(p.ws + WS_H);
    int cur = -1; f32x4 mul[4], add[4];
#pragma unroll
    for (int j = 0; j < 4; ++j) { mul[j] = (f32x4){0.f, 0.f, 0.f, 0.f}; add[j] = mul[j]; }
    for (int r0 = gw; r0 < MR; r0 += 4 * NGW) {
        f32x4 v[4][4];
#pragma unroll
        for (int i = 0; i < 4; ++i) { const int r = r0 + i * NGW < MR ? r0 + i * NGW : r0;
            const float* src = WHICH ? (const float*)(p.ws + WS_X1) + (size_t)r * D : xrow_ptr(p, r);
#pragma unroll
            for (int j = 0; j < 4; ++j) { if (WHICH == 0) v[i][j] = __builtin_nontemporal_load((const f32x4*)(src + 4 * (lane + 64 * j))); else v[i][j] = *(const f32x4*)(src + 4 * (lane + 64 * j)); } }
#pragma unroll
        for (int i = 0; i < 4; ++i) { const int r = r0 + i * NGW; if (r >= MR) break;
            const int arow = ada_row(r);
            if (arow != cur) { cur = arow; const float* ar = ADA + (size_t)arow * 6144; const float* sh = ar + (WHICH ? 3 : 0) * D; const float* sc = ar + (WHICH ? 4 : 1) * D;
#pragma unroll
                for (int j = 0; j < 4; ++j) { const int c = 4 * (lane + 64 * j); const f32x4 g = *(const f32x4*)(gain + c), s1 = *(const f32x4*)(sc + c); mul[j] = g * (s1 + 1.0f); add[j] = *(const f32x4*)(sh + c); } }
            float ss = 0.f;
#pragma unroll
            for (int j = 0; j < 4; ++j) ss += (v[i][j].x * v[i][j].x + v[i][j].y * v[i][j].y) + (v[i][j].z * v[i][j].z + v[i][j].w * v[i][j].w);
            const float rstd = 1.0f / sqrtf(wave_sum(ss) * (1.0f / D) + EPS);
#pragma unroll
            for (int j = 0; j < 4; ++j) { const int c = 4 * (lane + 64 * j);
                const f32x4 y = (v[i][j] * rstd) * mul[j] + add[j];
                u32x2 o; o.x = pk2(y.x, y.y); o.y = pk2(y.z, y.w);
                *(u32x2*)(H + (size_t)r * D + c) = o; } }
    }
}

__device__ __forceinline__ void ph_split(const P& p, LAS unsigned char* lds) {
    const int tid = tid_now(), lane = tid & 63, wave = tid >> 6, gw = blockIdx.x * 8 + wave, NGW = gridDim.x * 8;
    LAS float* zrow = (LAS float*)(lds + wave * 7424);
    const float* Z = (const float*)(p.ws + WS_Z); float* Q = (float*)(p.ws + WS_Q); float* KV3 = (float*)(p.ws + WS_KV3);
    float* GATES = (float*)(p.ws + WS_GATES); float* U = (float*)(p.ws + WS_U);
    bf16* QB = (bf16*)(p.ws + WS_QB); bf16* KB = (bf16*)(p.ws + WS_KB); bf16* VB = (bf16*)(p.ws + WS_VB);
    const float qg = p.q_g[lane];
    for (int tk = gw; tk < 4 * (MR - MP); tk += NGW) {
        const int r = MP + (tk >> 2), q4 = tk & 3;
        const float* zr = Z + (size_t)r * INP;
        for (int i = lane; i < INC / 4; i += 64) *(LAS f32x4*)(zrow + 4 * i) = *(const f32x4*)(zr + 4 * i);
        const int pos = r < MP ? (r % SEQ) : PAST + ((r - MP) % DSQ);
        float cs, sn;
        { const double inv = exp(-(double)(lane & 7) * 1.640295422175541); double sd, cd; sincos_d((double)pos * inv, sd, cd); cs = (float)cd; sn = (float)sd; }
        float *oc, *os, *ow;
        if (r < MP) { const int b = r / SEQ, t = r % SEQ; oc = p.out + O_KVC_P + (size_t)r * 256; os = p.out + O_KVS_P + (size_t)r * 256;
            ow = t >= SEQ - 512 ? p.out + O_KVW_P + (size_t)(b * 512 + t - (SEQ - 512)) * 256 : nullptr; }
        else { const int s = r - MP; oc = p.out + O_KVC_S + (size_t)s * 256; os = p.out + O_KVS_S + (size_t)s * 256; ow = p.out + O_KVW_S + (size_t)s * 256; }
        asm volatile("s_waitcnt lgkmcnt(0)" ::: "memory");
        for (int hh = q4; hh < 14; hh += 4) {
            int off; float gain;
            if (hh < 8) { off = hh * 64; gain = qg; }
            else { const int kk = hh - 8, br = kk >> 1, g = kk & 1; off = O1 + br * 256 + g * 64; gain = p.k_g[br * 64 + lane]; }
            const float v = zrow[off + lane];
            const float ss = wave_sum(v * v);
            float y = v * (1.0f / sqrtf(ss * (1.0f / 64.0f) + EPS)) * gain;
            const float pr = __shfl_xor(y, 8);
            if (lane < 8) y = y * cs - pr * sn; else if (lane < 16) y = pr * sn + y * cs;
            if (hh < 8) { if (r >= MP) Q[(size_t)r * AW + hh * 64 + lane] = y;
                if (r < MP) QB[((size_t)((r / SEQ) * 2 + (hh >> 2)) * SEQ + (r % SEQ)) * 256 + (hh & 3) * 64 + lane] = (bf16)f2bf(y * (0.125f * 1.4426950408889634f)); }
            else { const int kk = hh - 8, br = kk >> 1, g = kk & 1;
                if (r >= MP) KV3[((size_t)br * MR + r) * 256 + g * 64 + lane] = y;
                if (r < MP && br > 0) KB[((size_t)(((br - 1) * NBP + r / SEQ) * 2 + g) * SEQ + (r % SEQ)) * 64 + lane] = (bf16)f2bf(y);
                float* o = br == 0 ? oc : br == 1 ? os : ow; if (o) o[g * 64 + lane] = y; }
        }
#pragma unroll
        for (int br = 0; br < 3; ++br)
#pragma unroll
            for (int g = 0; g < 2; ++g) { if (((br * 2 + g) & 3) != q4) continue; const float v = zrow[O1 + br * 256 + 128 + g * 64 + lane];
                if (r >= MP) KV3[((size_t)br * MR + r) * 256 + 128 + g * 64 + lane] = v;
                if (r < MP && br > 0) VB[((size_t)(((br - 1) * NBP + r / SEQ) * 2 + g) * SEQ + (r % SEQ)) * 64 + lane] = (bf16)f2bf(v);
                float* o = br == 0 ? oc : br == 1 ? os : ow; if (o) o[128 + g * 64 + lane] = v; }
        if (q4 == 1 && lane < 24) GATES[(size_t)r * 24 + lane] = sigmoid_f(zrow[O2 + lane]);
        if (q4 == 3) for (int i = lane; i < SW / 4; i += 64) *(f32x4*)(U + (size_t)r * SW + 4 * i) = *(const LAS f32x4*)(zrow + O3 + 4 * i);
        asm volatile("s_waitcnt lgkmcnt(0)" ::: "memory");
    }
}

template <int PART> __device__ __forceinline__ void ph_cmp_build(const P& p) {
    const int tid = tid_now(), lane = tid & 63, wave = tid >> 6, gw = blockIdx.x * 8 + wave, NGW = gridDim.x * 8;
    bf16* A = (bf16*)(p.ws + WS_ACMP); const float* KVC = (const float*)(p.ws + WS_KV3);
    const int seg = lane >> 4, kvi = seg >> 1, g = seg & 1, d4 = (lane & 15) * 4;
    constexpr int NIS = DB * PAST / 64, NIP = MP / 64, NI = NIS + NIP;
    for (int it = (PART ? NIS : 0) + gw; it < (PART ? NI : NIS); it += NGW) {
        const float* src; size_t arow0;
        if (it < NIS) { const int b = it / (PAST / 64), h64 = it % (PAST / 64), t0 = h64 * 64; const int page = p.pt[b * NPG + t0 / PAGE];
            src = p.cache_c + ((size_t)page * PAGE + (t0 % PAGE)) * 256; arow0 = (size_t)(b * 1024 + t0 / 16) * 2; }
        else { const int r0 = (it - NIS) * 64, b = r0 / SEQ, t0 = r0 % SEQ; src = KVC + (size_t)r0 * 256; arow0 = (size_t)CMP_ROWS_S + (size_t)(b * 512 + t0 / 16) * 2; }
#pragma unroll 1
        for (int c = 0; c < 4; ++c) {
            f32x4 v[16];
#pragma unroll
            for (int tok = 0; tok < 16; ++tok) v[tok] = *(const f32x4*)(src + (size_t)(c * 16 + tok) * 256 + 4 * lane);
            bf16* dst = A + ((size_t)kvi * CMP_ROWS + arow0 + 2 * c + g) * 1024 + d4;
#pragma unroll
            for (int tok = 0; tok < 16; ++tok) { u32x2 o; o.x = pk2(v[tok].x, v[tok].y); o.y = pk2(v[tok].z, v[tok].w); *(u32x2*)(dst + tok * 64) = o; }
        }
    }
}

__device__ __forceinline__ void ph_cmp_out(const P& p, LAS unsigned char* lds) {
    const int tid = tid_now(), lane = tid & 63, wave = tid >> 6, gw = blockIdx.x * 8 + wave, NGW = gridDim.x * 8;
    LAS float* w2s = (LAS float*)lds;
    for (int i = tid; i < 2 * 128 * 64; i += 512) w2s[i] = i < 8192 ? p.w2_k[i] : p.w2_v[i - 8192];
    __syncthreads();
    const float* PC = (const float*)(p.ws + WS_PC); const float* PEB = (const float*)(p.ws + WS_PEB); float* CK = (float*)(p.ws + WS_CMPKV);
    bf16* KCB = (bf16*)(p.ws + WS_KCB);
    constexpr int NOS = DB * NC_S * 2, NOP = NBP * NC_P * 2, NO = NOS + NOP;
    auto srcrow = [&](int it, int& kv, int& o, size_t& dst) -> const float* {
        kv = it / NO; o = it % NO; size_t ra;
        if (o < NOS) { const int b = o / (NC_S * 2), rem = o % (NC_S * 2), i = rem >> 1, g = rem & 1; ra = (size_t)(b * 1024 + i) * 2 + g; dst = (size_t)o * 64; }
        else { const int o2 = o - NOS, b = o2 / (NC_P * 2), rem = o2 % (NC_P * 2), i = rem >> 1, g = rem & 1; ra = (size_t)CMP_ROWS_S + (size_t)(b * 512 + i) * 2 + g; dst = (size_t)CMPO_S + (size_t)o2 * 64; }
        return PC + ((size_t)kv * CMP_ROWS + ra) * 256; };
    float x0 = 0.f, x1 = 0.f, x2 = 0.f, x3 = 0.f;
    if (gw < 2 * NO) { int kv, o; size_t dst; const float* pa = srcrow(gw, kv, o, dst); x0 = pa[lane]; x1 = pa[512 + 128 + lane]; x2 = pa[64 + lane]; x3 = pa[512 + 192 + lane]; }
    for (int it = gw; it < 2 * NO; it += NGW) {
        int kv, o; size_t dst; (void)srcrow(it, kv, o, dst);
        const float h0 = gelu_tanh(x0 + x1 + PEB[kv * 128 + lane]);
        const float h1 = gelu_tanh(x2 + x3 + PEB[kv * 128 + 64 + lane]);
        if (it + NGW < 2 * NO) { int kv2, o2; size_t d2; const float* pa = srcrow(it + NGW, kv2, o2, d2); x0 = pa[lane]; x1 = pa[512 + 128 + lane]; x2 = pa[64 + lane]; x3 = pa[512 + 192 + lane]; }
        const LAS float* w2 = w2s + kv * 8192;
        float acc0 = 0.f, acc1 = 0.f;
#pragma unroll 8
        for (int n = 0; n < 64; ++n) { acc0 += rdlane(h0, n) * w2[n * 64 + lane]; acc1 += rdlane(h1, n) * w2[(64 + n) * 64 + lane]; }
        const float acc = acc0 + acc1;
        CK[(size_t)kv * CMPO + dst + lane] = acc;
        if (o >= NOS) { const int o2 = o - NOS, b = o2 / (NC_P * 2), rem = o2 % (NC_P * 2), i = rem >> 1, g = rem & 1;
            KCB[((size_t)((kv * NBP + b) * 2 + g) * 512 + i) * 64 + lane] = (bf16)f2bf(acc);
            if (i == 0) KCB[((size_t)((kv * NBP + b) * 2 + g) * 512 + 511) * 64 + lane] = (bf16)0; }
    }
}
#define XB_TMO      128
#define XB_XCNT(j)  (256  + 64 * (j))
#define XB_XSUB(j)  (1280 + 64 * (j))
#define XB_XGEN(j)  (2304 + 64 * (j))
#define XB_TOP      3328
#define XB_TOPGEN   3392
#define XCD_BAR_WORDS 3456
#define XB_SPIN_CAP (1u << 21)
__device__ __forceinline__ unsigned xb_ld(unsigned* p)              { return __hip_atomic_load(p, __ATOMIC_RELAXED, __HIP_MEMORY_SCOPE_AGENT); }
__device__ __forceinline__ unsigned xb_add(unsigned* p, unsigned v) { return __hip_atomic_fetch_add(p, v, __ATOMIC_RELAXED, __HIP_MEMORY_SCOPE_AGENT); }
__device__ __forceinline__ unsigned xb_xcc_id() { return (unsigned)__builtin_amdgcn_s_getreg((3 << 11) | 20) & 0xFu; }
#define XB_SPIN(cond, bar) do { unsigned _sp = 0; while (cond) { __builtin_amdgcn_s_sleep(1); \
    if ((++_sp & 255u) == 0u) { if (xb_ld(&(bar)[XB_TMO])) break; if (_sp > XB_SPIN_CAP) { atomicAdd(&(bar)[XB_TMO], 1u); break; } } } } while (0)

struct XcdBarrier {
    unsigned* bar; unsigned x;
    volatile LAS unsigned* st;
};

__device__ __forceinline__ XcdBarrier xcd_barrier_post(unsigned* bar, volatile LAS unsigned* st) {
    XcdBarrier b; b.bar = bar; b.x = xb_xcc_id(); b.st = st;
    if (threadIdx.x == 0) (void)xb_add(&bar[XB_XCNT(b.x)], 1u);
    return b;
}
__device__ __forceinline__ void xcd_barrier_complete(unsigned* bar, unsigned x, unsigned& nloc, unsigned& nx) {
    const unsigned G = gridDim.x * gridDim.y * gridDim.z;
    unsigned sum, cnt, mine, sp = 0u;
    for (;;) {
        sum = 0u; cnt = 0u; mine = 0u;
#pragma unroll
        for (unsigned j = 0; j < 16; ++j) { const unsigned c = xb_ld(&bar[XB_XCNT(j)]); sum += c; cnt += (c > 0u) ? 1u : 0u; mine = (j == x) ? c : mine; }
        if (sum == G) break;
        __builtin_amdgcn_s_sleep(1);
        if ((++sp & 255u) == 0u) { if (xb_ld(&bar[XB_TMO])) break; if (sp > XB_SPIN_CAP) { atomicAdd(&bar[XB_TMO], 1u); break; } }
    }
    nloc = mine > 0u ? mine : 1u; nx = cnt > 0u ? cnt : 1u;
}

__device__ __forceinline__ void xcd_barrier(const XcdBarrier& b) {
    asm volatile("s_waitcnt vmcnt(0)" ::: "memory");
    __syncthreads();
    if (threadIdx.x == 0) {
        unsigned* bar = b.bar;
        __builtin_amdgcn_s_waitcnt(0);
        unsigned nloc = b.st[0], nx = b.st[1];
        if (nloc == 0u) { xcd_barrier_complete(bar, b.x, nloc, nx); b.st[0] = nloc; b.st[1] = nx; }
        const unsigned old = xb_add(&bar[XB_XSUB(b.x)], 1u);
        const unsigned gen = old / nloc;
        if (old + 1u == (gen + 1u) * nloc) {
            __builtin_amdgcn_fence(__ATOMIC_RELEASE, "agent");
            asm volatile("s_waitcnt vmcnt(0)" ::: "memory");
            const unsigned og = xb_add(&bar[XB_TOP], 1u);
            const unsigned tg = og / nx;
            if (og + 1u == (tg + 1u) * nx) xb_add(&bar[XB_TOPGEN], 1u);
            else XB_SPIN(xb_ld(&bar[XB_TOPGEN]) == tg, bar);
            __builtin_amdgcn_fence(__ATOMIC_ACQUIRE, "agent");
            xb_add(&bar[XB_XGEN(b.x)], 1u);
            asm volatile("s_waitcnt vmcnt(0)" ::: "memory");
        } else {
            XB_SPIN(xb_ld(&bar[XB_XGEN(b.x)]) == gen, bar);
            __builtin_amdgcn_fence(__ATOMIC_ACQUIRE, "agent");
            asm volatile("s_waitcnt vmcnt(0)" ::: "memory");
        }
    }
    __syncthreads();
}

typedef short bf16x8 __attribute__((ext_vector_type(8)));
#define MFMA16(a, b, c) __builtin_amdgcn_mfma_f32_16x16x32_bf16(a, b, c, 0, 0, 0)
__device__ __forceinline__ unsigned cvtpk_bf16(float lo, float hi) { unsigned r; asm("v_cvt_pk_bf16_f32 %0, %1, %2" : "=v"(r) : "v"(lo), "v"(hi)); return r; }
__device__ __forceinline__ void split8(const f32x4& x0, const f32x4& x1, bf16x8& hi, bf16x8& lo) {
    u32x4 h, l;
    h.x = cvtpk_bf16(x0.x, x0.y); h.y = cvtpk_bf16(x0.z, x0.w); h.z = cvtpk_bf16(x1.x, x1.y); h.w = cvtpk_bf16(x1.z, x1.w);
    l.x = cvtpk_bf16(x0.x - __uint_as_float(h.x << 16), x0.y - __uint_as_float(h.x & 0xffff0000u)); l.y = cvtpk_bf16(x0.z - __uint_as_float(h.y << 16), x0.w - __uint_as_float(h.y & 0xffff0000u));
    l.z = cvtpk_bf16(x1.x - __uint_as_float(h.z << 16), x1.y - __uint_as_float(h.z & 0xffff0000u)); l.w = cvtpk_bf16(x1.z - __uint_as_float(h.w << 16), x1.w - __uint_as_float(h.w & 0xffff0000u));
    hi = __builtin_bit_cast(bf16x8, h); lo = __builtin_bit_cast(bf16x8, l);
}
template <int PASS>
__device__ __forceinline__ void ph_ssm(const P& p, LAS unsigned char* lds, int wg_lo, int wg_hi, int vlo, int vhi, int vsplit, int vshift) {
    const int tid = tid_now(), lane = tid & 63, wave = tid >> 6, gw = ((int)blockIdx.x - wg_lo) * 8 + wave, NGW = (wg_hi - wg_lo) * 8;
    const float* LB = (const float*)(p.ws + WS_LB); const float* BBR = (const float*)(p.ws + WS_BBR); const float* BBI = (const float*)(p.ws + WS_BBI);
    const float* U = (const float*)(p.ws + WS_U); float* E = (float*)(p.ws + WS_E);
    float* SF = (float*)(p.ws + WS_SF); bf16* SB = (bf16*)(p.ws + WS_SB);
    LAS float* bu = (LAS float*)(lds + wave * 17920);
    LAS float* hb = bu + 16 * 132;
    LAS float* ubuf = hb + 16 * 132;
    constexpr int NIT_P = NBP * NSG * NCH, NIT = PASS == 1 ? NIT_P : NIT_P + DB * NSG;
    const int l15 = lane & 15, lq = lane >> 4, ih = 8 * (lq & 1);
    for (int vit = vlo + gw; vit < vhi; vit += NGW) {
        const int it = vit >= vsplit ? vit + vshift : vit;
        if (it >= NIT) break;
        int b, g, c, r0, ntok; const bool prompt = it < NIT_P;
        if (prompt) { c = it % NCH; g = (it / NCH) % NSG; b = it / (NCH * NSG); r0 = b * SEQ + c * SCH; ntok = SCH; }
        else { const int i2 = it - NIT_P; c = 0; g = i2 % NSG; b = i2 / NSG; r0 = MP + b * DSQ; ntok = DSQ; }
        const int sp = g * SST + lane;
        bf16x8 b1[8], b2[8];
#pragma unroll
        for (int ct = 0; ct < 8; ++ct) { const int n = 16 * ct + l15; const float* src = (ct < 4 ? BBR : BBI) + (size_t)(g * SST + (n & 63)) * SG + ih;
            bf16x8 lo; split8(*(const f32x4*)src, *(const f32x4*)(src + 4), b1[ct], lo); b2[ct] = lane < 32 ? lo : (bf16x8){0, 0, 0, 0, 0, 0, 0, 0}; }
        const float lbr = LB[sp * 2], lbi = LB[sp * 2 + 1];
        float hr = 0.f, hi = 0.f;
        if (PASS == 2) {
            if (prompt) {
                float tr = lbr, ti = lbi;
#pragma unroll
                for (int q = 0; q < 7; ++q) { const float nr = tr * tr - ti * ti, ni = 2.0f * tr * ti; tr = nr; ti = ni; }
                const float* e = E + ((size_t)((b * NSG + g) * NCH) * 64 + lane) * 2;
                for (int c0 = 0; c0 < c; c0 += 16) { float er[16], ei[16];
#pragma unroll
                    for (int u = 0; u < 16; ++u) { const int cc = c0 + u < c ? c0 + u : c - 1; er[u] = e[(size_t)cc * 128]; ei[u] = e[(size_t)cc * 128 + 1]; }
#pragma unroll
                    for (int u = 0; u < 16; ++u) if (c0 + u < c) { const float nr = tr * hr - ti * hi + er[u], ni = tr * hi + ti * hr + ei[u]; hr = nr; hi = ni; } }
            } else { hr = p.st_re[(b * NSG + g) * SST + lane]; hi = p.st_im[(b * NSG + g) * SST + lane]; }
        }
        bf16x8 ch[4], cl[4];
        f32x4 dv = (f32x4){0.f, 0.f, 0.f, 0.f};
        if (PASS == 2) {
#pragma unroll
            for (int ks = 0; ks < 4; ++ks) { const float* src = (ks < 2 ? p.c_re : p.c_im) + (size_t)(g * SG + l15) * SST + (32 * ks + 8 * lq) % 64;
                f32x4 x0 = *(const f32x4*)src, x1 = *(const f32x4*)(src + 4);
                if (ks >= 2) { x0 = -x0; x1 = -x1; }
                split8(x0, x1, ch[ks], cl[ks]); }
            dv[0] = p.ssm_d[g * SG + l15];
        }
        const int nsb = (ntok + 15) >> 4;
        for (int sb = 0; sb < nsb; ++sb) {
            const int nt = ntok - sb * 16 < 16 ? ntok - sb * 16 : 16;
            bf16x8 ua;
            { const int tl = l15 < nt ? l15 : 0; const float* up = U + (size_t)(r0 + sb * 16 + tl) * SW + g * SG + ih;
              const f32x4 x0 = *(const f32x4*)up, x1 = *(const f32x4*)(up + 4);
              bf16x8 uh, ul; split8(x0, x1, uh, ul); ua = lane < 32 ? uh : ul;
              if (PASS == 2 && lane < 32) { *(LAS f32x4*)(ubuf + l15 * 16 + ih) = x0; *(LAS f32x4*)(ubuf + l15 * 16 + ih + 4) = x1; } }
#pragma unroll
            for (int ct = 0; ct < 8; ++ct) { f32x4 d = (f32x4){0.f, 0.f, 0.f, 0.f}; d = MFMA16(ua, b1[ct], d); d = MFMA16(ua, b2[ct], d);
#pragma unroll
                for (int rg = 0; rg < 4; ++rg) bu[(4 * lq + rg) * 132 + 16 * ct + l15] = d[rg]; }
            asm volatile("s_waitcnt lgkmcnt(0)" ::: "memory");
            if (nt == 16) {
                float br[16], bi[16];
#pragma unroll
                for (int tt = 0; tt < 16; ++tt) { br[tt] = bu[tt * 132 + lane]; bi[tt] = bu[tt * 132 + 64 + lane]; }
#pragma unroll
                for (int tt = 0; tt < 16; ++tt) {
                    const float nr = lbr * hr - lbi * hi + br[tt], ni = lbr * hi + lbi * hr + bi[tt];
                    hr = nr; hi = ni;
                    if (PASS == 2) { hb[tt * 132 + lane] = hr; hb[tt * 132 + 64 + lane] = hi; }
                }
            } else
            for (int tt = 0; tt < nt; ++tt) {
                const float br = bu[tt * 132 + lane], bi = bu[tt * 132 + 64 + lane];
                const float nr = lbr * hr - lbi * hi + br, ni = lbr * hi + lbi * hr + bi;
                hr = nr; hi = ni;
                if (PASS == 2) { hb[tt * 132 + lane] = hr; hb[tt * 132 + 64 + lane] = hi; }
            }
            if (PASS == 2) {
                asm volatile("s_waitcnt lgkmcnt(0)" ::: "memory");
                f32x4 y = (f32x4){0.f, 0.f, 0.f, 0.f};
#pragma unroll
                for (int ks = 0; ks < 4; ++ks) { const LAS float* hp = hb + l15 * 132 + 32 * ks + 8 * lq;
                    const f32x4 h0 = *(const LAS f32x4*)hp, h1 = *(const LAS f32x4*)(hp + 4); bf16x8 ah, al; split8(h0, h1, ah, al);
                    y = MFMA16(ah, ch[ks], y); y = MFMA16(al, ch[ks], y); y = MFMA16(ah, cl[ks], y); }
#pragma unroll
                for (int rg = 0; rg < 4; ++rg) { const int tt = 4 * lq + rg;
                    if (tt < nt) { const int r = r0 + sb * 16 + tt; const float uv = ubuf[tt * 16 + l15];
                        const float s = gelu_tanh(y[rg] + dv[0] * uv);
                        SF[(size_t)r * SW + g * SG + l15] = s; SB[(size_t)r * SW + g * SG + l15] = (bf16)f2bf(s); } }
                asm volatile("s_waitcnt lgkmcnt(0)" ::: "memory");
            }
        }
        if (PASS == 1) { float* e = E + ((size_t)((b * NSG + g) * NCH + c) * 64 + lane) * 2; e[0] = hr; e[1] = hi; }
        else if (prompt) { if (c == NCH - 1) { p.out[O_SRE_P + (b * NSG + g) * SST + lane] = hr; p.out[O_SIM_P + (b * NSG + g) * SST + lane] = hi; } }
        else { p.out[O_SRE_S + (b * NSG + g) * SST + lane] = hr; p.out[O_SIM_S + (b * NSG + g) * SST + lane] = hi; }
    }
}

constexpr float NEGM = -1e30f;
constexpr int SA_TILE = 0;
constexpr int SA_MO = 8 * 16640;
constexpr int SA_ML = SA_MO + 8192;
constexpr int SA_PS = SA_ML + 256;
constexpr int SA_IMP = SA_PS + 1088 * 4;
constexpr int SA_SEL = SA_IMP + 320 * 4;
__device__ __forceinline__ void att_stage(const float* kp, int stride, int klo, int khi, LAS float* tile, int lane) {
#pragma unroll 1
    for (int u0 = 0; u0 < 64; u0 += 32) { float v[32];
#pragma unroll
        for (int u = 0; u < 32; ++u) v[u] = (u0 + u >= klo && u0 + u < khi) ? __builtin_nontemporal_load(kp + (ptrdiff_t)(u0 + u) * stride + lane) : 0.f;
#pragma unroll
        for (int u = 0; u < 32; ++u) tile[(u0 + u) * 65 + lane] = v[u]; }
}
__device__ __forceinline__ void att_qk(LAS float* tile, int lane, const float (&q)[4], float (&s)[4]) {
    asm volatile("s_waitcnt vmcnt(0) lgkmcnt(0)" ::: "memory");
    s[0] = 0.f; s[1] = 0.f; s[2] = 0.f; s[3] = 0.f;
#pragma unroll 8
    for (int d = 0; d < 64; ++d) { const float kv = tile[lane * 65 + d];
        s[0] += kv * rdlane(q[0], d); s[1] += kv * rdlane(q[1], d); s[2] += kv * rdlane(q[2], d); s[3] += kv * rdlane(q[3], d); }
    asm volatile("s_waitcnt lgkmcnt(0)" ::: "memory");
}
__device__ __forceinline__ void att_scores(const float* kp, int stride, int klo, int khi, LAS float* tile, int lane, const float (&q)[4], float (&s)[4]) {
    att_stage(kp, stride, klo, khi, tile, lane);
    att_qk(tile, lane, q, s);
}
__device__ __forceinline__ void att_tile(const float* kp, const float* vp, int stride, int klo, int khi, bool valid, LAS float* tile, int lane,
                                         const float (&q)[4], float (&m)[4], float (&l)[4], float (&o)[4], float (&s)[4]) {
    float pr[4];
    att_stage(kp, stride, klo, khi, tile, lane);
    float vr[64];
#pragma unroll
    for (int u = 0; u < 64; ++u) vr[u] = (u >= klo && u < khi) ? __builtin_nontemporal_load(vp + (ptrdiff_t)u * stride + lane) : 0.f;
    {
        asm volatile("s_waitcnt lgkmcnt(0)" ::: "memory");
        s[0] = 0.f; s[1] = 0.f; s[2] = 0.f; s[3] = 0.f;
#pragma unroll 8
        for (int d = 0; d < 64; ++d) { const float kv = tile[lane * 65 + d];
            s[0] += kv * rdlane(q[0], d); s[1] += kv * rdlane(q[1], d); s[2] += kv * rdlane(q[2], d); s[3] += kv * rdlane(q[3], d); }
    }
#pragma unroll
    for (int h = 0; h < 4; ++h) {
        const float sc = valid ? s[h] : NEGM;
        const float mn = fmaxf(m[h], wave_max(sc));
        const float pv = valid ? expf(sc - mn) : 0.f;
        const float al = expf(m[h] - mn);
        l[h] = l[h] * al + wave_sum(pv); o[h] *= al; m[h] = mn; pr[h] = pv;
    }
#pragma unroll
    for (int u = 0; u < 64; ++u) { o[0] += rdlane(pr[0], u) * vr[u]; o[1] += rdlane(pr[1], u) * vr[u]; o[2] += rdlane(pr[2], u) * vr[u]; o[3] += rdlane(pr[3], u) * vr[u]; }
}
__device__ __forceinline__ void sa_merge(LAS unsigned char* lds, int wave, int lane, const float (&m)[4], const float (&l)[4], const float (&o)[4], float gate, float& outv, float (&gm)[4], float (&gil)[4]) {
    LAS float* mo = (LAS float*)(lds + SA_MO); LAS float* ml = (LAS float*)(lds + SA_ML);
#pragma unroll
    for (int h = 0; h < 4; ++h) { mo[(wave * 4 + h) * 64 + lane] = o[h]; if (lane == 0) { ml[(wave * 4 + h) * 2] = m[h]; ml[(wave * 4 + h) * 2 + 1] = l[h]; } }
    __syncthreads();
#pragma unroll
    for (int h = 0; h < 4; ++h) { float M = NEGM;
#pragma unroll
        for (int w = 0; w < 8; ++w) M = fmaxf(M, ml[(w * 4 + h) * 2]);
        float L = 0.f;
#pragma unroll
        for (int w = 0; w < 8; ++w) L += ml[(w * 4 + h) * 2 + 1] * expf(ml[(w * 4 + h) * 2] - M);
        gm[h] = M; gil[h] = L > 0.f ? 1.0f / L : 0.f; }
    if (wave < 4) { float M = NEGM, il = 0.f;
#pragma unroll
        for (int h = 0; h < 4; ++h) if (h == wave) { M = gm[h]; il = gil[h]; }
        float acc = 0.f;
#pragma unroll
        for (int w = 0; w < 8; ++w) acc += mo[(w * 4 + wave) * 64 + lane] * expf(ml[(w * 4 + wave) * 2] - M);
        outv += gate * acc * il; }
    __syncthreads();
}

__device__ __forceinline__ void ph_attn_sample(const P& p, LAS unsigned char* lds) {
    const int tid = tid_now(), lane = tid & 63, wave = __builtin_amdgcn_readfirstlane(tid >> 6);
    LAS float* tile = (LAS float*)(lds + SA_TILE + wave * 16640);
    LAS float* psall = (LAS float*)(lds + SA_PS); LAS float* imp = (LAS float*)(lds + SA_IMP); LAS int* sel = (LAS int*)(lds + SA_SEL);
    const float* Q = (const float*)(p.ws + WS_Q); const float* KV3 = (const float*)(p.ws + WS_KV3); const float* GATES = (const float*)(p.ws + WS_GATES);
    const float* CK = (const float*)(p.ws + WS_CMPKV); float* ATTN = (float*)(p.ws + WS_ATTN);
    const float* KVS = KV3 + (size_t)MR * 256; const float* KVW = KV3 + (size_t)2 * MR * 256;
    for (int hw = blockIdx.x; hw < MS * 2; hw += gridDim.x) {
        const int cidx = (hw & 7) * 8 + ((hw >> 3) >> 2), qi = (hw >> 3) & 3, b = cidx >> 1, g = cidx & 1;
        const int r = MP + b * DSQ + qi, t = PAST + qi;
        float q[4];
#pragma unroll
        for (int h = 0; h < 4; ++h) q[h] = Q[(size_t)r * AW + (g * 4 + h) * 64 + lane] * 0.125f;
        const float* gt = GATES + (size_t)r * 24 + g * 12;
        float gc = 0.f, gs = 0.f, gw_ = 0.f;
        if (wave < 4) { gc = gt[wave * 3]; gs = gt[wave * 3 + 1]; gw_ = gt[wave * 3 + 2]; }
        float outv = 0.f, gm[4], gil[4], m[4], l[4], o[4];
        const float* kc = CK + (size_t)b * NC_S * 128 + g * 64; const float* vc = kc + CMPO;
#pragma unroll
        for (int h = 0; h < 4; ++h) { m[h] = NEGM; l[h] = 0.f; o[h] = 0.f; }
        float sc2[2][4];
#pragma unroll 1
        for (int ix = 0; ix < 2; ++ix) { const int ti = wave + 8 * ix, khi = NC_S - 64 * ti < 64 ? NC_S - 64 * ti : 64; float st[4];
            att_tile(kc + (size_t)ti * 64 * 128, vc + (size_t)ti * 64 * 128, 128, 0, khi, 64 * ti + lane < NC_S, tile, lane, q, m, l, o, st);
#pragma unroll
            for (int h = 0; h < 4; ++h) { sc2[0][h] = ix == 0 ? st[h] : sc2[0][h]; sc2[1][h] = st[h]; } }
        sa_merge(lds, wave, lane, m, l, o, gc, outv, gm, gil);
#pragma unroll
        for (int ix = 0; ix < 2; ++ix) { const int ti = wave + 8 * ix;
            float ps = 0.f;
            if (64 * ti + lane < NC_S) {
#pragma unroll
                for (int h = 0; h < 4; ++h) ps += expf(sc2[ix][h] - gm[h]) * gil[h]; }
            psall[ti * 64 + lane] = ps;
        }
        if (wave == 0) psall[16 * 64 + lane] = 0.f;
        __syncthreads();
        const int cur = t >> 6;
        if (tid < 320) { float v = 0.f;
            if (tid < 257) { const int c4 = 4 * tid; v = psall[c4] + psall[c4 + 1] + psall[c4 + 2] + 0.5f * psall[c4 + 3] + (tid > 0 ? 0.5f * psall[c4 - 1] : 0.f); }
            imp[tid] = v; }
        __syncthreads();
        {
            unsigned key[5];
#pragma unroll
            for (int i = 0; i < 5; ++i) { const int j = lane + 64 * i; key[i] = 0u;
                if (j < 257) key[i] = j > cur ? 1u : (j == 0 || j == cur || j == cur - 1) ? 0x7F000000u : __float_as_uint(fmaxf(imp[j], 0.f)) + 2u; }
            unsigned T = 0u;
            for (int bit = 30; bit >= 0; --bit) { const unsigned tr = T | (1u << bit); int cnt = 0;
#pragma unroll
                for (int i = 0; i < 5; ++i) cnt += __popcll(__ballot(key[i] >= tr));
                if (cnt >= 16) T = tr; }
            int ngt = 0;
#pragma unroll
            for (int i = 0; i < 5; ++i) ngt += __popcll(__ballot(key[i] > T));
            const int need = 16 - ngt; const unsigned long long below = (1ull << lane) - 1ull;
            int eqbefore = 0, rank = 0;
#pragma unroll
            for (int i = 0; i < 5; ++i) { const unsigned long long eqm = __ballot(key[i] == T);
                const bool take = key[i] > T || (key[i] == T && eqbefore + __popcll(eqm & below) < need);
                const unsigned long long tm = __ballot(take);
                if (take && wave == 0) sel[rank + __popcll(tm & below)] = lane + 64 * i;
                rank += __popcll(tm); eqbefore += __popcll(eqm); }
        }
        __syncthreads();
        float sdump[4];
#pragma unroll
        for (int h = 0; h < 4; ++h) { m[h] = NEGM; l[h] = 0.f; o[h] = 0.f; }
        for (int k = wave; k < 16; k += 8) {
            const int j = __builtin_amdgcn_readfirstlane(sel[k]);
            if (j < 256) { const int page = p.pt[b * NPG + (j >> 1)]; const float* kp = p.cache_s + ((size_t)page * PAGE + (j & 1) * 64) * 256 + g * 64;
                att_tile(kp, kp + 128, 256, 0, 64, true, tile, lane, q, m, l, o, sdump); }
            else { const float* kp = KVS + (size_t)(MP + b * DSQ) * 256 + g * 64;
                att_tile(kp, kp + 128, 256, 0, DSQ, lane <= qi, tile, lane, q, m, l, o, sdump); }
        }
        sa_merge(lds, wave, lane, m, l, o, gs, outv, gm, gil);
#pragma unroll
        for (int h = 0; h < 4; ++h) { m[h] = NEGM; l[h] = 0.f; o[h] = 0.f; }
        { const float* kp = p.cache_w + ((size_t)(b * 512 + 64 * wave)) * 256 + g * 64;
          att_tile(kp, kp + 128, 256, 0, 64, 64 * wave + lane >= qi, tile, lane, q, m, l, o, sdump); }
        if (wave == 0) { const float* kp = KVW + (size_t)(MP + b * DSQ) * 256 + g * 64;
            att_tile(kp, kp + 128, 256, 0, DSQ, lane <= qi, tile, lane, q, m, l, o, sdump); }
        sa_merge(lds, wave, lane, m, l, o, gw_, outv, gm, gil);
        if (wave < 4) ATTN[(size_t)r * AW + (g * 4 + wave) * 64 + lane] = outv;
    }
}

__device__ __forceinline__ void ph_mixin(const P& p) {
    const int tid = tid_now(), lane = tid & 63, wave = tid >> 6, gw = blockIdx.x * 8 + wave, NGW = gridDim.x * 8;
    const float* ATTN = (const float*)(p.ws + WS_ATTN); const float* S2 = (const float*)(p.ws + WS_S2); bf16* MIX = (bf16*)(p.ws + WS_MIX);
    f32x4 gn[2][2];
#pragma unroll
    for (int part = 0; part < 2; ++part)
#pragma unroll
        for (int j = 0; j < 2; ++j) gn[part][j] = *(const f32x4*)((part ? p.ssm_g : p.attn_g) + 4 * (lane + 64 * j));
    for (int r0 = gw; r0 < MR; r0 += 4 * NGW) {
        f32x4 v[4][2][2];
#pragma unroll
        for (int w = 0; w < 4; ++w) { const int r = r0 + w * NGW < MR ? r0 + w * NGW : r0;
#pragma unroll
            for (int part = 0; part < 2; ++part) { const float* src = (part ? S2 : ATTN) + (size_t)r * 512;
#pragma unroll
                for (int j = 0; j < 2; ++j) v[w][part][j] = *(const f32x4*)(src + 4 * (lane + 64 * j)); } }
#pragma unroll
        for (int w = 0; w < 4; ++w) { const int r = r0 + w * NGW; if (r >= MR) break;
#pragma unroll
            for (int part = 0; part < 2; ++part) { float ss = 0.f;
#pragma unroll
                for (int j = 0; j < 2; ++j) { const f32x4 x = v[w][part][j]; ss += (x.x * x.x + x.y * x.y) + (x.z * x.z + x.w * x.w); }
                const float rstd = 1.0f / sqrtf(wave_sum(ss) * (1.0f / 512.0f) + EPS);
#pragma unroll
                for (int j = 0; j < 2; ++j) { const int c = 4 * (lane + 64 * j); const f32x4 y = v[w][part][j] * rstd * gn[part][j];
                    u32x2 o; o.x = pk2(y.x, y.y); o.y = pk2(y.z, y.w); *(u32x2*)(MIX + (size_t)r * D + part * 512 + c) = o; } } }
    }
}

struct EpiCmp {
    static constexpr bool PERM = false, AFTER_DRAIN = false;
    float* C;
    __device__ __forceinline__ void operator()(const pg8::f32x4 (&acc)[2][2][4][2], const pg8::Unit& u, int wr, int wc, int fr, int fq) const {
        const int row0 = u.pm * 256 + wr * 64 + fr, col0 = wc * 32 + 4 * fq;
#pragma unroll
        for (int ai = 0; ai < 2; ++ai)
#pragma unroll
            for (int m = 0; m < 4; ++m) { float* rowp = C + (size_t)(row0 + ai * 128 + m * 16) * 256 + col0;
#pragma unroll
                for (int bj = 0; bj < 2; ++bj)
#pragma unroll
                    for (int n = 0; n < 2; ++n) *(pg8::f32x4*)(rowp + bj * 128 + n * 16) = acc[ai][bj][m][n]; }
    }
};
struct CmpOrder {
    int G, c;
    __device__ bool next(int i, pg8::Unit& u) const { const int L = i * G + c; if (L >= 2 * (CMP_ROWS / 256)) return false; u.pm = L; u.pn = L >= CMP_ROWS / 256 ? 1 : 0; return true; }
    __device__ __forceinline__ void a_ready(const pg8::Unit&) const {}
    __device__ __forceinline__ void done(const pg8::Unit&) const {}
};
struct EpiGlu {
    static constexpr bool PERM = false, AFTER_DRAIN = false;
    const float* SF; float* S2; const float* bias;
    __device__ __forceinline__ void operator()(const pg8::f32x4 (&acc)[2][2][4][2], const pg8::Unit& u, int wr, int wc, int fr, int fq) const {
        const int row0 = u.pm * 256 + wr * 64 + fr, col0 = u.pn * 256 + wc * 32 + 4 * fq;
#pragma unroll
        for (int ai = 0; ai < 2; ++ai)
#pragma unroll
            for (int m = 0; m < 4; ++m) { const size_t ro = (size_t)(row0 + ai * 128 + m * 16) * 512 + col0;
#pragma unroll
                for (int bj = 0; bj < 2; ++bj)
#pragma unroll
                    for (int n = 0; n < 2; ++n) { const int co = bj * 128 + n * 16; const pg8::f32x4 s = *(const pg8::f32x4*)(SF + ro + co); const pg8::f32x4 bv = *(const pg8::f32x4*)(bias + col0 + co);
                        const pg8::f32x4 t = acc[ai][bj][m][n] + bv; pg8::f32x4 o;
                        o[0] = s[0] * sigmoid_f(t[0]); o[1] = s[1] * sigmoid_f(t[1]); o[2] = s[2] * sigmoid_f(t[2]); o[3] = s[3] * sigmoid_f(t[3]);
                        *(pg8::f32x4*)(S2 + ro + co) = o; } }
    }
};
struct EpiOut {
    static constexpr bool PERM = false, AFTER_DRAIN = false;
    const float *xp, *xs, *ADA; float* X1;
    __device__ __forceinline__ void operator()(const pg8::f32x4 (&acc)[2][2][4][2], const pg8::Unit& u, int wr, int wc, int fr, int fq) const {
        const int row0 = u.pm * 256 + wr * 64 + fr, col0 = u.pn * 256 + wc * 32 + 4 * fq;
#pragma unroll
        for (int ai = 0; ai < 2; ++ai)
#pragma unroll
            for (int m = 0; m < 4; ++m) { const int r = row0 + ai * 128 + m * 16;
                if (r < MR) { const float* xr = (r < MP ? xp + (size_t)r * D : xs + (size_t)(r - MP) * D) + col0; const float* gr = ADA + (size_t)ada_row(r) * 6144 + 2 * D + col0;
#pragma unroll
                    for (int bj = 0; bj < 2; ++bj)
#pragma unroll
                        for (int n = 0; n < 2; ++n) { const int co = bj * 128 + n * 16;
                            *(pg8::f32x4*)(X1 + (size_t)r * D + col0 + co) = *(const pg8::f32x4*)(xr + co) + *(const pg8::f32x4*)(gr + co) * acc[ai][bj][m][n]; } } }
    }
};
struct EpiUp {
    static constexpr bool PERM = true, AFTER_DRAIN = false;
    bf16* FF;
    __device__ __forceinline__ void operator()(const pg8::f32x4 (&acc)[2][2][4][2], const pg8::Unit& u, int wr, int wc, int fr, int fq) const {
        const int row0 = u.pm * 256 + wr * 64 + fr, col0 = u.pn * 128 + wc * 32 + 8 * fq;
#pragma unroll
        for (int ai = 0; ai < 2; ++ai)
#pragma unroll
            for (int m = 0; m < 4; ++m) { bf16* rowp = FF + (size_t)(row0 + ai * 128 + m * 16) * DFF + col0;
                const pg8::f32x4 g0 = acc[ai][0][m][0], g1 = acc[ai][0][m][1], u0 = acc[ai][1][m][0], u1 = acc[ai][1][m][1];
                pg8::u32x4 w; w.x = pk2(silu_f(g0[0]) * u0[0], silu_f(g0[1]) * u0[1]); w.y = pk2(silu_f(g0[2]) * u0[2], silu_f(g0[3]) * u0[3]);
                w.z = pk2(silu_f(g1[0]) * u1[0], silu_f(g1[1]) * u1[1]); w.w = pk2(silu_f(g1[2]) * u1[2], silu_f(g1[3]) * u1[3]);
                *(pg8::u32x4*)rowp = w; }
    }
};
struct EpiDown {
    static constexpr bool PERM = false, AFTER_DRAIN = false;
    const float *X1, *ADA; float* out;
    __device__ __forceinline__ void operator()(const pg8::f32x4 (&acc)[2][2][4][2], const pg8::Unit& u, int wr, int wc, int fr, int fq) const {
        const int row0 = u.pm * 256 + wr * 64 + fr, col0 = u.pn * 256 + wc * 32 + 4 * fq;
#pragma unroll
        for (int ai = 0; ai < 2; ++ai)
#pragma unroll
            for (int m = 0; m < 4; ++m) { const int r = row0 + ai * 128 + m * 16;
                if (r < MR) { const float* xr = X1 + (size_t)r * D + col0; const float* gr = ADA + (size_t)ada_row(r) * 6144 + 5 * D + col0;
                    float* orow = (r < MP ? out + O_YP + (size_t)r * D : out + O_YS + (size_t)(r - MP) * D) + col0;
#pragma unroll
                    for (int bj = 0; bj < 2; ++bj)
#pragma unroll
                        for (int n = 0; n < 2; ++n) { const int co = bj * 128 + n * 16;
                            *(pg8::f32x4*)(orow + co) = *(const pg8::f32x4*)(xr + co) + *(const pg8::f32x4*)(gr + co) * acc[ai][bj][m][n]; } } }
    }
};


constexpr int CF_ABYTES = 258 * 128, CF_A0 = 0, CF_A1 = CF_ABYTES, CF_B0 = 2 * CF_ABYTES, CF_BBYTES = 256 * 128, CF_B1 = CF_B0 + CF_BBYTES;
constexpr int CF_HID = 0, CF_W2 = 66048;
__device__ __forceinline__ int cf_off(int row, int q) { return row * 128 + ((q ^ ((row >> 1) & 7)) << 4); }
__device__ __forceinline__ int cf_off2(int row, int q) { return row * 256 + ((q ^ ((row >> 1) & 7)) << 4); }

template <int PART>
__device__ __forceinline__ void ph_cmpf(const P& p, LAS unsigned char* lds) {
    const int tid = tid_now(), lane = tid & 63, wave = __builtin_amdgcn_readfirstlane(tid >> 6), fr = lane & 15, fq = lane >> 4, wr = wave >> 1, wc = wave & 1;
    const float* KVC = p.out + O_KVC_P; const bf16* WC1 = (const bf16*)(p.ws + WS_WC1_T); const float* PEB = (const float*)(p.ws + WS_PEB);
    float* CK = (float*)(p.ws + WS_CMPKV); bf16* KCB = (bf16*)(p.ws + WS_KCB);
    constexpr int NU = PART ? 16 : 512, NCH_B = PART ? 512 : 1024, NC = PART ? NC_P : NC_S;
    const int lh = lane >> 5, pc = lane & 31, ag = pc >> 4, ad = 4 * (pc & 15);
    for (int u = blockIdx.x; u < NU; u += (PART ? 16 : (int)gridDim.x)) {
        const int kv = PART ? (u >> 3) : (u >> 8), b = PART ? ((u >> 2) & 1) : ((u >> 3) & 31), c0 = (PART ? (u & 3) : (u & 7)) * 128;
        const float* abase0; const float* abase1; const float* esrc = nullptr; const bool ext = c0 + 128 < NCH_B;
        if (PART == 0) { const int pg0 = p.pt[b * NPG + ((c0 + 16 * wave) >> 3)], pg1 = p.pt[b * NPG + ((c0 + 16 * wave) >> 3) + 1];
            abase0 = p.cache_c + ((size_t)pg0 * PAGE + lh * 16) * 256 + kv * 128 + 4 * pc; abase1 = p.cache_c + ((size_t)pg1 * PAGE + lh * 16) * 256 + kv * 128 + 4 * pc;
            if (ext && tid < 32) { const int ce = c0 + 128; const int pg = p.pt[b * NPG + (ce >> 3)]; esrc = p.cache_c + ((size_t)pg * PAGE + (ce & 7) * 16) * 256 + kv * 128 + 4 * tid; } }
        else { abase0 = KVC + ((size_t)b * SEQ + (size_t)(c0 + 16 * wave + lh) * 16) * 256 + kv * 128 + 4 * pc; abase1 = abase0 + (size_t)8 * 16 * 256;
            if (ext && tid < 32) esrc = KVC + ((size_t)b * SEQ + (size_t)(c0 + 128) * 16) * 256 + kv * 128 + 4 * tid; }
        const bf16* wsrc = WC1 + ((size_t)kv * 256 + (tid >> 3)) * 1024 + (tid & 7) * 8;
        f32x4 av[8], ev; u32x4 wv[4];
        ev = (f32x4){0.f, 0.f, 0.f, 0.f};
#define CF_LOAD(tok) do { _Pragma("unroll") for (int j = 0; j < 8; ++j) av[j] = __builtin_nontemporal_load((const f32x4*)((j < 4 ? abase0 : abase1) + (size_t)(2 * (j & 3)) * 16 * 256 + (size_t)(tok) * 256)); \
            if (esrc) ev = *(const f32x4*)(esrc + (size_t)(tok) * 256); \
            _Pragma("unroll") for (int i = 0; i < 4; ++i) wv[i] = *(const u32x4*)(wsrc + (size_t)i * 64 * 1024 + (tok) * 64); } while (0)
#define CF_STORE(abuf, bbuf) do { \
            _Pragma("unroll") for (int j = 0; j < 8; ++j) { const int row_ = 2 * (16 * wave + 2 * j + lh) + ag; u32x2 o_; o_.x = pk2(av[j].x, av[j].y); o_.y = pk2(av[j].z, av[j].w); \
                *(LAS u32x2*)(lds + (abuf) + cf_off(row_, ad >> 3) + ((ad >> 2) & 1) * 8) = o_; } \
            if (tid < 32) { u32x2 o_; o_.x = pk2(ev.x, ev.y); o_.y = pk2(ev.z, ev.w); *(LAS u32x2*)(lds + (abuf) + cf_off(256 + (tid >> 4), (tid & 15) >> 1) + (tid & 1) * 8) = o_; } \
            _Pragma("unroll") for (int i = 0; i < 4; ++i) *(LAS u32x4*)(lds + (bbuf) + cf_off((tid >> 3) + 64 * i, tid & 7)) = wv[i]; } while (0)
        f32x4 acc[4][4];
#pragma unroll
        for (int m = 0; m < 4; ++m)
#pragma unroll
            for (int n = 0; n < 4; ++n) acc[m][n] = (f32x4){0.f, 0.f, 0.f, 0.f};
        CF_LOAD(0); CF_STORE(CF_A0, CF_B0);
        __syncthreads();
#pragma unroll 1
        for (int tok = 0; tok < 16; ++tok) {
            const int ab = (tok & 1) ? CF_A1 : CF_A0, bb = (tok & 1) ? CF_B1 : CF_B0;
            if (tok + 1 < 16) CF_LOAD(tok + 1);
#pragma unroll
            for (int half = 0; half < 2; ++half)
#pragma unroll
                for (int ks = 0; ks < 2; ++ks) {
                    bf16x8 a[4], bw[4];
#pragma unroll
                    for (int m = 0; m < 4; ++m) a[m] = *(const LAS bf16x8*)(lds + ab + cf_off(64 * wr + 16 * m + fr + 2 * half, 4 * ks + fq));
#pragma unroll
                    for (int n = 0; n < 4; ++n) bw[n] = *(const LAS bf16x8*)(lds + bb + cf_off(128 * half + 64 * wc + 16 * n + fr, 4 * ks + fq));
#pragma unroll
                    for (int m = 0; m < 4; ++m)
#pragma unroll
                        for (int n = 0; n < 4; ++n) acc[m][n] = MFMA16(bw[n], a[m], acc[m][n]);
                }
            if (tok + 1 < 16) { if (tok & 1) CF_STORE(CF_A0, CF_B0); else CF_STORE(CF_A1, CF_B1); }
            __syncthreads();
        }
#undef CF_LOAD
#undef CF_STORE
#pragma unroll
        for (int n = 0; n < 4; ++n) { const int col = 64 * wc + 16 * n + 4 * fq; const f32x4 bias = peb_load(PEB, kv, col);
#pragma unroll
            for (int m = 0; m < 4; ++m) { const int row = 64 * wr + 16 * m + fr; const f32x4 v = acc[m][n] + bias;
                u32x2 o; o.x = pk2(gelu_tanh(v.x), gelu_tanh(v.y)); o.y = pk2(gelu_tanh(v.z), gelu_tanh(v.w));
                *(LAS u32x2*)(lds + CF_HID + cf_off2(row, col >> 3) + (col & 7) * 2) = o; } }
        { const float* w2 = kv ? p.w2_v : p.w2_k; const int n = tid & 63, kb = tid >> 6; float x[16];
#pragma unroll
          for (int j = 0; j < 16; ++j) x[j] = w2[(size_t)(16 * kb + j) * 64 + n];
#pragma unroll
          for (int h2 = 0; h2 < 2; ++h2) { u32x4 o; o.x = pk2(x[8 * h2], x[8 * h2 + 1]); o.y = pk2(x[8 * h2 + 2], x[8 * h2 + 3]); o.z = pk2(x[8 * h2 + 4], x[8 * h2 + 5]); o.w = pk2(x[8 * h2 + 6], x[8 * h2 + 7]);
              *(LAS u32x4*)(lds + CF_W2 + cf_off2(n, 2 * kb + h2)) = o; } }
        __syncthreads();
        f32x4 acc2[2][4];
#pragma unroll
        for (int m = 0; m < 2; ++m)
#pragma unroll
            for (int n = 0; n < 4; ++n) acc2[m][n] = (f32x4){0.f, 0.f, 0.f, 0.f};
#pragma unroll
        for (int ks = 0; ks < 4; ++ks) { bf16x8 a[2], bw[4];
#pragma unroll
            for (int m = 0; m < 2; ++m) a[m] = *(const LAS bf16x8*)(lds + CF_HID + cf_off2(32 * wave + 16 * m + fr, 4 * ks + fq));
#pragma unroll
            for (int n = 0; n < 4; ++n) bw[n] = *(const LAS bf16x8*)(lds + CF_W2 + cf_off2(16 * n + fr, 4 * ks + fq));
#pragma unroll
            for (int m = 0; m < 2; ++m)
#pragma unroll
                for (int n = 0; n < 4; ++n) acc2[m][n] = MFMA16(bw[n], a[m], acc2[m][n]); }
#pragma unroll
        for (int m = 0; m < 2; ++m) { const int row = 32 * wave + 16 * m + fr, i = c0 + (row >> 1), g = row & 1;
            if (i < NC) {
                float* dst = CK + (size_t)kv * CMPO + (PART ? (size_t)CMPO_S : 0) + ((size_t)(b * NC + i) * 2 + g) * 64 + 4 * fq;
#pragma unroll
                for (int n = 0; n < 4; ++n) *(f32x4*)(dst + 16 * n) = acc2[m][n];
                if (PART) { bf16* kd = KCB + ((size_t)((kv * NBP + b) * 2 + g) * 512 + i) * 64 + 4 * fq;
#pragma unroll
                    for (int n = 0; n < 4; ++n) { u32x2 o; o.x = pk2(acc2[m][n].x, acc2[m][n].y); o.y = pk2(acc2[m][n].z, acc2[m][n].w); *(u32x2*)(kd + 16 * n) = o;
                        if (i == 0) *(u32x2*)(kd + (size_t)511 * 64 + 16 * n) = (u32x2){0u, 0u}; } }
            } }
        __syncthreads();
    }
}


constexpr int CS_A0 = 0, CS_ABYTES = 66 * 128, CS_A1 = CS_ABYTES, CS_B0 = 2 * CS_ABYTES, CS_B1 = CS_B0 + 32768;
constexpr int CS_HID = 0, CS_W2 = CS_B0;
__device__ __forceinline__ void ph_cmpf_small(const P& p, LAS unsigned char* lds, int u) {
    const int tid = tid_now(), lane = tid & 63, wave = __builtin_amdgcn_readfirstlane(tid >> 6), fr = lane & 15, fq = lane >> 4;
    const float* KVC = p.out + O_KVC_P; const bf16* WC1 = (const bf16*)(p.ws + WS_WC1_T); const float* PEB = (const float*)(p.ws + WS_PEB);
    float* CK = (float*)(p.ws + WS_CMPKV); bf16* KCB = (bf16*)(p.ws + WS_KCB);
    const int kv = u >> 5, b = (u >> 4) & 1, c0 = (u & 15) * 32; const bool ext = c0 + 32 < 512;
    const int pc = tid & 31, ch0 = tid >> 5, ag = pc >> 4, ad = 4 * (pc & 15);
    const float* abase = KVC + ((size_t)b * SEQ + (size_t)(c0 + ch0) * 16) * 256 + kv * 128 + 4 * pc;
    const float* esrc = (ext && tid < 32) ? KVC + ((size_t)b * SEQ + (size_t)(c0 + 32) * 16) * 256 + kv * 128 + 4 * tid : nullptr;
    const bf16* wsrc = WC1 + ((size_t)kv * 256 + (tid >> 3)) * 1024 + (tid & 7) * 8;
    f32x4 aA0, aA1, aB0, aB1, eA, eB; u32x4 wA[4], wB[4];
    eA = (f32x4){0.f, 0.f, 0.f, 0.f}; eB = eA;
#define CS_LOAD(a0, a1, EV, WV, tok) do { a0 = *(const f32x4*)(abase + (size_t)(tok) * 256); a1 = *(const f32x4*)(abase + (size_t)16 * 16 * 256 + (size_t)(tok) * 256); \
        if (esrc) EV = *(const f32x4*)(esrc + (size_t)(tok) * 256); \
        _Pragma("unroll") for (int i = 0; i < 4; ++i) WV[i] = *(const u32x4*)(wsrc + (size_t)i * 64 * 1024 + (tok) * 64); } while (0)
#define CS_STORE(a0, a1, EV, WV, abuf, bbuf) do { \
        { u32x2 o_; o_.x = pk2(a0.x, a0.y); o_.y = pk2(a0.z, a0.w); *(LAS u32x2*)(lds + (abuf) + cf_off(2 * ch0 + ag, ad >> 3) + ((ad >> 2) & 1) * 8) = o_; } \
        { u32x2 o_; o_.x = pk2(a1.x, a1.y); o_.y = pk2(a1.z, a1.w); *(LAS u32x2*)(lds + (abuf) + cf_off(2 * (ch0 + 16) + ag, ad >> 3) + ((ad >> 2) & 1) * 8) = o_; } \
        if (tid < 32) { u32x2 o_; o_.x = pk2(EV.x, EV.y); o_.y = pk2(EV.z, EV.w); *(LAS u32x2*)(lds + (abuf) + cf_off(64 + (tid >> 4), (tid & 15) >> 1) + (tid & 1) * 8) = o_; } \
        _Pragma("unroll") for (int i = 0; i < 4; ++i) *(LAS u32x4*)(lds + (bbuf) + cf_off((tid >> 3) + 64 * i, tid & 7)) = WV[i]; } while (0)
    const int sA0 = (fr >> 1) & 7, sA1 = ((fr >> 1) + 1) & 7;
    const int aoff00 = fr * 128 + ((fq ^ sA0) << 4), aoff01 = fr * 128 + (((4 + fq) ^ sA0) << 4);
    const int aoff10 = (fr + 2) * 128 + ((fq ^ sA1) << 4), aoff11 = (fr + 2) * 128 + (((4 + fq) ^ sA1) << 4);
    const int woff0 = (16 * wave + fr) * 128 + ((fq ^ sA0) << 4), woff1 = (16 * wave + fr) * 128 + (((4 + fq) ^ sA0) << 4);
    f32x4 acc[4];
#pragma unroll
    for (int m = 0; m < 4; ++m) acc[m] = (f32x4){0.f, 0.f, 0.f, 0.f};
#define CS_STEP(ab, bb, AO, WO, HALF) do { const bf16x8 bw = *(const LAS bf16x8*)(lds + (bb) + (WO) + (HALF) * 16384); \
        _Pragma("unroll") for (int m = 0; m < 4; ++m) { const bf16x8 a = *(const LAS bf16x8*)(lds + (ab) + (AO) + m * 2048); acc[m] = MFMA16(bw, a, acc[m]); } } while (0)
#define CS_COMPUTE(ab, bb) do { CS_STEP(ab, bb, aoff00, woff0, 0); CS_STEP(ab, bb, aoff01, woff1, 0); CS_STEP(ab, bb, aoff10, woff0, 1); CS_STEP(ab, bb, aoff11, woff1, 1); } while (0)
    CS_LOAD(aA0, aA1, eA, wA, 0); CS_LOAD(aB0, aB1, eB, wB, 1);
    CS_STORE(aA0, aA1, eA, wA, CS_A0, CS_B0);
    CS_LOAD(aA0, aA1, eA, wA, 2);
    __syncthreads();
#pragma unroll 1
    for (int tok = 0; tok < 16; tok += 2) {
        CS_COMPUTE(CS_A0, CS_B0);
        CS_STORE(aB0, aB1, eB, wB, CS_A1, CS_B1);
        if (tok + 3 < 16) CS_LOAD(aB0, aB1, eB, wB, tok + 3);
        __syncthreads();
        CS_COMPUTE(CS_A1, CS_B1);
        if (tok + 2 < 16) CS_STORE(aA0, aA1, eA, wA, CS_A0, CS_B0);
        if (tok + 4 < 16) CS_LOAD(aA0, aA1, eA, wA, tok + 4);
        __syncthreads();
    }
#undef CS_LOAD
#undef CS_STORE
#undef CS_STEP
#undef CS_COMPUTE
    { const int col = 16 * wave + 4 * fq; const f32x4 bias = peb_load(PEB, kv, col);
#pragma unroll
      for (int m = 0; m < 4; ++m) { const int row = 16 * m + fr; const f32x4 v = acc[m] + bias;
          u32x2 o; o.x = pk2(gelu_tanh(v.x), gelu_tanh(v.y)); o.y = pk2(gelu_tanh(v.z), gelu_tanh(v.w));
          *(LAS u32x2*)(lds + CS_HID + cf_off2(row, col >> 3) + (col & 7) * 2) = o; } }
    { const float* w2 = kv ? p.w2_v : p.w2_k; const int n = tid & 63, kb = tid >> 6; float x[16];
#pragma unroll
      for (int j = 0; j < 16; ++j) x[j] = w2[(size_t)(16 * kb + j) * 64 + n];
#pragma unroll
      for (int h2 = 0; h2 < 2; ++h2) { u32x4 o; o.x = pk2(x[8 * h2], x[8 * h2 + 1]); o.y = pk2(x[8 * h2 + 2], x[8 * h2 + 3]); o.z = pk2(x[8 * h2 + 4], x[8 * h2 + 5]); o.w = pk2(x[8 * h2 + 6], x[8 * h2 + 7]);
          *(LAS u32x4*)(lds + CS_W2 + cf_off2(n, 2 * kb + h2)) = o; } }
    __syncthreads();
    { const int m = wave & 3, n0 = 2 * (wave >> 2);
      f32x4 acc2[2]; acc2[0] = (f32x4){0.f, 0.f, 0.f, 0.f}; acc2[1] = acc2[0];
#pragma unroll
      for (int ks = 0; ks < 4; ++ks) { const bf16x8 a = *(const LAS bf16x8*)(lds + CS_HID + cf_off2(16 * m + fr, 4 * ks + fq));
#pragma unroll
          for (int j = 0; j < 2; ++j) { const bf16x8 bw = *(const LAS bf16x8*)(lds + CS_W2 + cf_off2(16 * (n0 + j) + fr, 4 * ks + fq)); acc2[j] = MFMA16(bw, a, acc2[j]); } }
      const int row = 16 * m + fr, i = c0 + (row >> 1), g = row & 1;
      if (i < NC_P) {
          float* dst = CK + (size_t)kv * CMPO + (size_t)CMPO_S + ((size_t)(b * NC_P + i) * 2 + g) * 64 + 4 * fq;
          bf16* kd = KCB + ((size_t)((kv * NBP + b) * 2 + g) * 512 + i) * 64 + 4 * fq;
#pragma unroll
          for (int j = 0; j < 2; ++j) { *(f32x4*)(dst + 16 * (n0 + j)) = acc2[j];
              u32x2 o; o.x = pk2(acc2[j].x, acc2[j].y); o.y = pk2(acc2[j].z, acc2[j].w); *(u32x2*)(kd + 16 * (n0 + j)) = o;
              if (i == 0) *(u32x2*)(kd + (size_t)511 * 64 + 16 * (n0 + j)) = (u32x2){0u, 0u}; }
      } }
    __syncthreads();
}

typedef short s16x4 __attribute__((ext_vector_type(4)));
typedef float f32x16 __attribute__((ext_vector_type(16)));
#define MFMA32(a, b, c) __builtin_amdgcn_mfma_f32_32x32x16_bf16(a, b, c, 0, 0, 0)
constexpr int AT_STG = 16384;
constexpr int AT_IMP = 2 * AT_STG;
constexpr int AT_SEL = AT_IMP + 8 * 4096;
constexpr int AT_QM = AT_SEL + 1024;
constexpr int AT_LS = AT_QM + 1024;
constexpr int AT_ACC = 68 * 1024;
constexpr int AT_ROW = 68;
constexpr int AT_QL = AT_ACC + 256 * AT_ROW * 4;
constexpr float AT_MASKED = -1e30f, AT_MINIT = -1e20f;

__device__ __forceinline__ int crow(int r, int hi) { return (r & 3) + 8 * (r >> 2) + 4 * hi; }
__device__ __forceinline__ unsigned cvtpk(float lo, float hi) { unsigned r; asm("v_cvt_pk_bf16_f32 %0, %1, %2" : "=v"(r) : "v"(lo), "v"(hi)); return r; }
__device__ __forceinline__ float xmax32(float v) { const auto rr = __builtin_amdgcn_permlane32_swap(__float_as_uint(v), __float_as_uint(v), false, false); return fmaxf(__uint_as_float(rr[0]), __uint_as_float(rr[1])); }
__device__ __forceinline__ float xsum32(float v) { const auto rr = __builtin_amdgcn_permlane32_swap(__float_as_uint(v), __float_as_uint(v), false, false); return __uint_as_float(rr[0]) + __uint_as_float(rr[1]); }
__device__ __forceinline__ float xget32(float v, int hi) { const auto rr = __builtin_amdgcn_permlane32_swap(__float_as_uint(v), __float_as_uint(v), false, false); return __uint_as_float(hi ? rr[0] : rr[1]); }
__device__ __forceinline__ s16x4 vtr(LAS const unsigned char* p) { typedef short v4i16_t __attribute__((ext_vector_type(4)));
    return __builtin_bit_cast(s16x4, __builtin_amdgcn_ds_read_tr16_b64_v4i16((LAS v4i16_t*)p)); }

struct AtStage { u32x4 k, v; };
template <bool NEEDV> __device__ __forceinline__ AtStage at_load(const bf16* ksrc, const bf16* vsrc, int tid) {
    AtStage s; const size_t off = (size_t)(tid >> 3) * 64 + (tid & 7) * 8;
    s.k = *(const u32x4*)(ksrc + off); if (NEEDV) s.v = *(const u32x4*)(vsrc + off); else s.v = (u32x4){0u, 0u, 0u, 0u};
    return s;
}
template <bool NEEDV> __device__ __forceinline__ void at_store(LAS unsigned char* buf, const AtStage& s, int tid) {
    const int key = tid >> 3, ch = tid & 7;
    *(LAS u32x4*)(buf + ch * 1024 + key * 16) = s.k;
    if (NEEDV) *(LAS u32x4*)(buf + 8192 + (ch >> 2) * 4096 + key * 64 + (ch & 3) * 16) = s.v;
}
__device__ __forceinline__ void at_scores(LAS const unsigned char* buf, const bf16x8 (&qf)[4], f32x16& s0, f32x16& s1, int lane) {
    LAS const unsigned char* kp = buf + (lane >> 5) * 1024 + (lane & 31) * 16;
    s0 = f32x16{}; s1 = f32x16{};
#pragma unroll
    for (int d0 = 0; d0 < 4; ++d0) { const bf16x8 ka = *(LAS const bf16x8*)(kp + d0 * 2048), kb = *(LAS const bf16x8*)(kp + d0 * 2048 + 512);
        s0 = MFMA32(ka, qf[d0], s0); s1 = MFMA32(kb, qf[d0], s1); }
}
__device__ __forceinline__ void at_softmax_pv(LAS const unsigned char* buf, f32x16& s0, f32x16& s1, f32x16 (&o)[2], float& m, float& l, int lane, bool lane_on) {
    float mx = fmaxf(s0[0], s1[0]);
#pragma unroll
    for (int r = 1; r < 16; r += 1) mx = __builtin_fmaxf(__builtin_fmaxf(mx, s0[r]), s1[r]);
    mx = xmax32(mx);
    mx = lane_on ? mx : AT_MASKED;
    const float mn = fmaxf(m, mx), al = __builtin_amdgcn_exp2f(m - mn);
    m = mn;
    const float off = lane_on ? mn : 1e30f;
    float rs = 0.f;
#pragma unroll
    for (int r = 0; r < 16; ++r) { s0[r] = __builtin_amdgcn_exp2f(s0[r] - off); s1[r] = __builtin_amdgcn_exp2f(s1[r] - off); rs += s0[r] + s1[r]; }
    l = l * al + rs;
    if (__ballot(al != 1.0f) != 0ull) {
#pragma unroll
        for (int r = 0; r < 16; ++r) { o[0][r] *= al; o[1][r] *= al; } }
    u32x4 pw[4];
    pw[0] = (u32x4){cvtpk(s0[0], s0[1]), cvtpk(s0[2], s0[3]), cvtpk(s0[4], s0[5]), cvtpk(s0[6], s0[7])};
    pw[1] = (u32x4){cvtpk(s0[8], s0[9]), cvtpk(s0[10], s0[11]), cvtpk(s0[12], s0[13]), cvtpk(s0[14], s0[15])};
    pw[2] = (u32x4){cvtpk(s1[0], s1[1]), cvtpk(s1[2], s1[3]), cvtpk(s1[4], s1[5]), cvtpk(s1[6], s1[7])};
    pw[3] = (u32x4){cvtpk(s1[8], s1[9]), cvtpk(s1[10], s1[11]), cvtpk(s1[12], s1[13]), cvtpk(s1[14], s1[15])};
    const int hi = lane >> 5;
    LAS const unsigned char* vp = buf + 8192 + ((lane >> 4) & 1) * 32 + (lane & 3) * 8 + (4 * hi + ((lane & 15) >> 2)) * 64;
#pragma unroll
    for (int k = 0; k < 4; ++k) {
        const bf16x8 pf = __builtin_bit_cast(bf16x8, pw[k]);
#pragma unroll
        for (int dh = 0; dh < 2; ++dh) { const s16x4 lo = vtr(vp + dh * 4096 + k * 1024), hh = vtr(vp + dh * 4096 + k * 1024 + 512);
            const bf16x8 vf = (bf16x8){lo[0], lo[1], lo[2], lo[3], hh[0], hh[1], hh[2], hh[3]};
            o[dh] = MFMA32(vf, pf, o[dh]); }
    }
}

__device__ __forceinline__ void at_softmax_pv_fixed(LAS const unsigned char* buf, f32x16& s0, f32x16& s1, f32x16 (&o)[2], float& l, int lane, float coff) {
    if (coff != 0.f) {
#pragma unroll
        for (int r = 0; r < 16; ++r) { s0[r] -= coff; s1[r] -= coff; } }
    float rs = 0.f;
#pragma unroll
    for (int r = 0; r < 16; ++r) { s0[r] = __builtin_amdgcn_exp2f(s0[r]); s1[r] = __builtin_amdgcn_exp2f(s1[r]); rs += s0[r] + s1[r]; }
    l += rs;
    u32x4 pw[4];
    pw[0] = (u32x4){cvtpk(s0[0], s0[1]), cvtpk(s0[2], s0[3]), cvtpk(s0[4], s0[5]), cvtpk(s0[6], s0[7])};
    pw[1] = (u32x4){cvtpk(s0[8], s0[9]), cvtpk(s0[10], s0[11]), cvtpk(s0[12], s0[13]), cvtpk(s0[14], s0[15])};
    pw[2] = (u32x4){cvtpk(s1[0], s1[1]), cvtpk(s1[2], s1[3]), cvtpk(s1[4], s1[5]), cvtpk(s1[6], s1[7])};
    pw[3] = (u32x4){cvtpk(s1[8], s1[9]), cvtpk(s1[10], s1[11]), cvtpk(s1[12], s1[13]), cvtpk(s1[14], s1[15])};
    const int hi = lane >> 5;
    LAS const unsigned char* vp = buf + 8192 + ((lane >> 4) & 1) * 32 + (lane & 3) * 8 + (4 * hi + ((lane & 15) >> 2)) * 64;
#pragma unroll
    for (int k = 0; k < 4; ++k) {
        const bf16x8 pf = __builtin_bit_cast(bf16x8, pw[k]);
#pragma unroll
        for (int dh = 0; dh < 2; ++dh) { const s16x4 lo = vtr(vp + dh * 4096 + k * 1024), hh = vtr(vp + dh * 4096 + k * 1024 + 512);
            const bf16x8 vf = (bf16x8){lo[0], lo[1], lo[2], lo[3], hh[0], hh[1], hh[2], hh[3]};
            o[dh] = MFMA32(vf, pf, o[dh]); }
    }
}

template <int MODE>
__device__ __forceinline__ void at_branch(const bf16* ksrc, const bf16* vsrc, int key0, int nst, LAS unsigned char* lds, const bf16x8 (&qf)[4], f32x16 (&o)[2], float& m, float& l,
                                          int t, unsigned long long sel_lo, unsigned long long sel_hi, int wlo, int whi, LAS float* impw, int tid, int lane, float coff = 0.f) {
    constexpr bool NEEDV = MODE != 3;
    const int hi = lane >> 5;
    float carry = 0.f;
    AtStage st = at_load<NEEDV>(ksrc, vsrc, tid);
    at_store<NEEDV>(lds, st, tid);
    __syncthreads();
    for (int s = 0; s < nst; ++s) {
        LAS unsigned char* buf = lds + (s & 1) * AT_STG;
        if (s + 1 < nst) st = at_load<NEEDV>(ksrc + (size_t)(s + 1) * 64 * 64, vsrc + (size_t)(s + 1) * 64 * 64, tid);
        const int kb = key0 + 64 * s;
        bool active = true;
        bool chosen = true;
        if (MODE == 1) { const int j = kb >> 6; const unsigned long long w = j < 64 ? sel_lo : sel_hi; chosen = (w >> (j & 63)) & 1ull; active = __ballot(chosen) != 0ull; }
        if (MODE == 2) active = (kb + 63 >= wlo - 512) && (kb <= whi);
        if (MODE == 0 || MODE == 3) active = 16 * kb + 31 <= whi;
        if (active) {
            f32x16 s0, s1;
            at_scores(buf, qf, s0, s1, lane);
            bool edge;
            if (MODE == 0 || MODE == 3) edge = 16 * (kb + 63) + 31 > wlo;
            else if (MODE == 1) edge = kb + 63 > wlo;
            else edge = (kb + 63 > wlo) || (kb < whi - 512);
            if (edge || MODE == 3) {
#pragma unroll
                for (int r = 0; r < 16; ++r) { const int k0 = kb + crow(r, hi), k1 = k0 + 32; bool v0, v1;
                    if (MODE == 0 || MODE == 3) { v0 = 16 * k0 + 31 <= t; v1 = 16 * k1 + 31 <= t; }
                    else if (MODE == 1) { v0 = k0 <= t; v1 = k1 <= t; }
                    else { v0 = k0 <= t && k0 >= t - 512; v1 = k1 <= t && k1 >= t - 512; }
                    if (MODE != 3) { s0[r] = v0 ? s0[r] : AT_MASKED; s1[r] = v1 ? s1[r] : AT_MASKED; }
                    else { s0[r] = v0 ? __builtin_amdgcn_exp2f(s0[r] - m) * l : 0.f; s1[r] = v1 ? __builtin_amdgcn_exp2f(s1[r] - m) * l : 0.f; } }
            }
            if (MODE == 2) at_softmax_pv_fixed(buf, s0, s1, o, l, lane, coff);
            else if (MODE != 3) at_softmax_pv(buf, s0, s1, o, m, l, lane, chosen);
            else {
#pragma unroll
                for (int n = 0; n < 2; ++n) { const f32x16& pp = n ? s1 : s0; const int jb0 = (kb >> 2) + 8 * n;
                    float own[4], sp[4], rc[4];
#pragma unroll
                    for (int G = 0; G < 4; ++G) { sp[G] = 0.5f * pp[4 * G + 3]; own[G] = pp[4 * G] + pp[4 * G + 1] + pp[4 * G + 2] + sp[G]; rc[G] = xget32(sp[G], hi); }
                    float val[4];
                    if (hi) { val[0] = own[0] + rc[0]; val[1] = own[1] + rc[1]; val[2] = own[2] + rc[2]; val[3] = own[3] + rc[3]; }
                    else { val[0] = own[0] + carry; val[1] = own[1] + rc[0]; val[2] = own[2] + rc[1]; val[3] = own[3] + rc[2]; }
                    carry = rc[3];
#pragma unroll
                    for (int G = 0; G < 4; ++G) { val[G] += dpp_mov<0xB1>(val[G]); val[G] += dpp_mov<0x4E>(val[G]);

                        if ((lane & 3) == 0) impw[((lane & 31) >> 2) * 128 + jb0 + 2 * G + hi] = val[G]; }
                }
            }
        } else if (MODE == 3) carry = 0.f;
        if (s + 1 < nst) at_store<NEEDV>(lds + ((s + 1) & 1) * AT_STG, st, tid);
        __syncthreads();
    }
}

__device__ __forceinline__ void at_slc_tile(LAS unsigned char* lds, LAS const unsigned char* buf, bool diag, int myq, float coff, f32x16 (&o)[2], float& rs, int lane) {
    const int hi = lane >> 5, col = lane & 31, head = col & 3;
    LAS const unsigned char* qimg = lds + AT_IMP;
    const int colg = myq * 4 + head;
    bf16x8 qf[4];
#pragma unroll
    for (int d0 = 0; d0 < 4; ++d0) qf[d0] = *(LAS const bf16x8*)(qimg + colg * 128 + (((d0 * 2 + hi) ^ (colg & 7)) << 4));
    f32x16 s0, s1;
    { LAS const unsigned char* kp = buf + hi * 1024 + col * 16;
      bf16x8 kf[8];
#pragma unroll
      for (int i = 0; i < 8; ++i) kf[i] = *(LAS const bf16x8*)(kp + (i >> 1) * 2048 + (i & 1) * 512);
      asm volatile("" ::: "memory");
      s0 = f32x16{}; s1 = f32x16{};
#pragma unroll
      for (int d0 = 0; d0 < 4; ++d0) { s0 = MFMA32(kf[2 * d0], qf[d0], s0); s1 = MFMA32(kf[2 * d0 + 1], qf[d0], s1); } }
    LAS const unsigned char* vp = buf + 8192 + ((lane >> 4) & 1) * 32 + (lane & 3) * 8 + (4 * hi + ((lane & 15) >> 2)) * 64;
    s16x4 vlo[4][2], vhi[4][2];
#pragma unroll
    for (int k = 0; k < 4; ++k)
#pragma unroll
        for (int dh = 0; dh < 2; ++dh) { vlo[k][dh] = vtr(vp + dh * 4096 + k * 1024); vhi[k][dh] = vtr(vp + dh * 4096 + k * 1024 + 512); }
    asm volatile("" ::: "memory");
    if (diag) {
#pragma unroll
        for (int r = 0; r < 16; ++r) { const int k0 = crow(r, hi); s0[r] = k0 <= myq ? s0[r] : AT_MASKED; s1[r] = k0 + 32 <= myq ? s1[r] : AT_MASKED; } }
    if (coff != 0.f) {
#pragma unroll
        for (int r = 0; r < 16; ++r) { s0[r] -= coff; s1[r] -= coff; } }
    rs = 0.f;
#pragma unroll
    for (int r = 0; r < 16; ++r) { s0[r] = __builtin_amdgcn_exp2f(s0[r]); s1[r] = __builtin_amdgcn_exp2f(s1[r]); rs += s0[r] + s1[r]; }
    u32x4 pw[4];
    pw[0] = (u32x4){cvtpk(s0[0], s0[1]), cvtpk(s0[2], s0[3]), cvtpk(s0[4], s0[5]), cvtpk(s0[6], s0[7])};
    pw[1] = (u32x4){cvtpk(s0[8], s0[9]), cvtpk(s0[10], s0[11]), cvtpk(s0[12], s0[13]), cvtpk(s0[14], s0[15])};
    pw[2] = (u32x4){cvtpk(s1[0], s1[1]), cvtpk(s1[2], s1[3]), cvtpk(s1[4], s1[5]), cvtpk(s1[6], s1[7])};
    pw[3] = (u32x4){cvtpk(s1[8], s1[9]), cvtpk(s1[10], s1[11]), cvtpk(s1[12], s1[13]), cvtpk(s1[14], s1[15])};
    o[0] = f32x16{}; o[1] = f32x16{};
#pragma unroll
    for (int k = 0; k < 4; ++k) {
        const bf16x8 pf = __builtin_bit_cast(bf16x8, pw[k]);
#pragma unroll
        for (int dh = 0; dh < 2; ++dh) { const s16x4 lo = vlo[k][dh], hh = vhi[k][dh];
            const bf16x8 vf = (bf16x8){lo[0], lo[1], lo[2], lo[3], hh[0], hh[1], hh[2], hh[3]};
            o[dh] = MFMA32(vf, pf, o[dh]); }
    }
    rs = xsum32(rs);
}
__device__ __forceinline__ void at_slc_merge(LAS unsigned char* lds, int myq, bool on, const f32x16 (&o)[2], float rs, int lane) {
    const int hi = lane >> 5, colg = myq * 4 + (lane & 3);
    LAS float* ap = (LAS float*)(lds + AT_ACC) + colg * AT_ROW + 4 * hi;
    LAS float* ls = (LAS float*)(lds + AT_LS);
    if (on) {
        f32x4 a4[2][4];
#pragma unroll
        for (int dh = 0; dh < 2; ++dh)
#pragma unroll
            for (int rg = 0; rg < 4; ++rg) a4[dh][rg] = *(LAS const f32x4*)(ap + dh * 32 + 8 * rg);
        asm volatile("" ::: "memory");
        if (hi == 0) ls[colg] += rs;
#pragma unroll
        for (int dh = 0; dh < 2; ++dh)
#pragma unroll
            for (int rg = 0; rg < 4; ++rg) *(LAS f32x4*)(ap + dh * 32 + 8 * rg) = (f32x4){a4[dh][rg][0] + o[dh][4 * rg], a4[dh][rg][1] + o[dh][4 * rg + 1], a4[dh][rg][2] + o[dh][4 * rg + 2], a4[dh][rg][3] + o[dh][4 * rg + 3]};
    }
}
__device__ __forceinline__ void at_slc(const bf16* ksrc, const bf16* vsrc, int jq, LAS unsigned char* lds, float coff, int tid, int lane, int wave) {
    const int col = lane & 31, w4 = wave & 3, side = wave >> 2;
    LAS const int* qcnt = (LAS const int*)(lds + AT_QM);
    LAS const unsigned char* qlist = lds + AT_QL;
    AtStage sa = at_load<true>(ksrc, vsrc, tid), sb = sa;
    if (jq >= 1) sb = at_load<true>(ksrc + 64 * 64, vsrc + 64 * 64, tid);
    at_store<true>(lds, sa, tid);
    if (jq >= 1) at_store<true>(lds + AT_STG, sb, tid);
    __syncthreads();
#pragma unroll 1
    for (int j0 = 0; j0 <= jq; j0 += 2) {
        const bool more_a = j0 + 2 <= jq, more_b = j0 + 3 <= jq;
        if (more_a) sa = at_load<true>(ksrc + (size_t)(j0 + 2) * 64 * 64, vsrc + (size_t)(j0 + 2) * 64 * 64, tid);
        if (more_b) sb = at_load<true>(ksrc + (size_t)(j0 + 3) * 64 * 64, vsrc + (size_t)(j0 + 3) * 64 * 64, tid);
        const int na = __builtin_amdgcn_readfirstlane(qcnt[j0]), nb = j0 + 1 <= jq ? __builtin_amdgcn_readfirstlane(qcnt[j0 + 1]) : 0;
        const int rounds = (na > 32 || nb > 32) ? 2 : 1;
        const int j = j0 + side, n = side ? nb : na;
#pragma unroll 1
        for (int rd = 0; rd < rounds; ++rd) {
            const int tile = w4 + 4 * rd; const bool have = 8 * tile < n;
            f32x16 o[2]; float rs = 0.f; int myq = 0;
            if (have) { myq = qlist[j * 64 + 8 * tile + (col >> 2)];
                at_slc_tile(lds, lds + side * AT_STG, j == jq, myq, coff, o, rs, lane);
                if (side == 0) at_slc_merge(lds, myq, 8 * tile + (col >> 2) < n, o, rs, lane); }
            __syncthreads();
            if (have && side == 1) at_slc_merge(lds, myq, 8 * tile + (col >> 2) < n, o, rs, lane);
            if (rd == rounds - 1) { if (more_a) at_store<true>(lds, sa, tid);
                                    if (more_b) at_store<true>(lds + AT_STG, sb, tid); }
            __syncthreads();
        }
    }
}

__device__ __forceinline__ void ph_attn_prompt(const P& p, LAS unsigned char* lds) {
    const int tid = tid_now(), lane = tid & 63, wave = __builtin_amdgcn_readfirstlane(tid >> 6), hi = lane >> 5;
    const bf16* QB = (const bf16*)(p.ws + WS_QB); const bf16* KB = (const bf16*)(p.ws + WS_KB); const bf16* VB = (const bf16*)(p.ws + WS_VB); const bf16* KCB = (const bf16*)(p.ws + WS_KCB);
    const float* GATES = (const float*)(p.ws + WS_GATES); float* ATTN = (float*)(p.ws + WS_ATTN);
    LAS float* impw = (LAS float*)(lds + AT_IMP + wave * 4096);
    LAS unsigned* selw = (LAS unsigned*)(lds + AT_SEL + wave * 128);
    float coff, coffw; { const float gq = wave_max(fabsf(p.q_g[lane])), gk = wave_max(fabsf(p.k_g[64 + lane])), gw = wave_max(fabsf(p.k_g[128 + lane]));
        coff = fmaxf(0.f, 8.0f * 1.4426950408889634f * 1.01f * gq * gk - 100.f); coffw = fmaxf(0.f, 8.0f * 1.4426950408889634f * 1.01f * gq * gw - 100.f); }
    for (int hw = blockIdx.x; hw < 256; hw += gridDim.x) {
        const int pr = ((hw & 7) >> 1) * 64 + (hw & 1) * 32 + (hw >> 3);
        const int bg = pr >> 6, b = bg >> 1, g = bg & 1;
#pragma unroll 1
        for (int half = 0; half < 2; ++half) {
            const int jq = half ? 127 - (pr & 63) : (pr & 63);
            const int t0 = 64 * jq, col = lane & 31, qi = col >> 2, head = col & 3, t = t0 + 8 * wave + qi;
            const int wlo = t0 + 8 * wave, whi = wlo + 7;
            bf16x8 qf[4];
            { const bf16* qp = QB + ((size_t)bg * SEQ + wlo) * 256 + (size_t)col * 64 + hi * 8;
#pragma unroll
              for (int d0 = 0; d0 < 4; ++d0) qf[d0] = *(const bf16x8*)(qp + d0 * 16); }
            const float* gp = GATES + (size_t)(b * SEQ + t) * 24 + (g * 4 + head) * 3;
            const float g_c = gp[0], g_s = gp[1], g_w = gp[2];
            f32x16 o[2]; float m, l;
            const int ncu = 4 * jq + 3 < NC_P ? 4 * jq + 3 : NC_P;
            const int nstc = (ncu + 63) >> 6;
            const bf16* kc = KCB + (size_t)bg * 512 * 64; const bf16* vc = kc + (size_t)NBP * 2 * 512 * 64;
            o[0] = f32x16{}; o[1] = f32x16{}; m = AT_MINIT; l = 0.f;
            at_branch<0>(kc, vc, 0, nstc, lds, qf, o, m, l, t, 0ull, 0ull, wlo, whi, impw, tid, lane);
            float lt = xsum32(l), il = lt > 0.f ? 1.0f / lt : 0.f;
            float* op = ATTN + (size_t)(b * SEQ + t) * AW + (g * 4 + head) * 64 + 4 * hi;
            { const float sc = g_c * il;
#pragma unroll
              for (int dh = 0; dh < 2; ++dh)
#pragma unroll
                for (int rg = 0; rg < 4; ++rg) *(f32x4*)(op + 32 * dh + 8 * rg) = (f32x4){sc * o[dh][4 * rg], sc * o[dh][4 * rg + 1], sc * o[dh][4 * rg + 2], sc * o[dh][4 * rg + 3]}; }
            if (jq >= 16) {
                for (int i = lane; i < 1024; i += 64) impw[i] = 0.f;
                asm volatile("s_waitcnt lgkmcnt(0)" ::: "memory");
                at_branch<3>(kc, vc, 0, nstc, lds, qf, o, m, il, t, 0ull, 0ull, wlo, whi, impw, tid, lane);
                asm volatile("s_waitcnt lgkmcnt(0)" ::: "memory");
                const int cur = jq;
                for (int q8 = 0; q8 < 8; q8 += 2) {
                    const float v0 = impw[q8 * 128 + lane], v1 = impw[q8 * 128 + 64 + lane], u0 = impw[q8 * 128 + 128 + lane], u1 = impw[q8 * 128 + 192 + lane];
                    const int j0 = lane, j1 = lane + 64;
                    const bool f0 = j0 == 0 || j0 == cur || j0 == cur - 1, f1 = j1 == cur || j1 == cur - 1;
                    const unsigned k0 = j0 > cur ? 0u : f0 ? 0x7F000000u : __float_as_uint(fmaxf(v0, 0.f)) + 1u, k1 = j1 > cur ? 0u : f1 ? 0x7F000000u : __float_as_uint(fmaxf(v1, 0.f)) + 1u;
                    const unsigned h0 = j0 > cur ? 0u : f0 ? 0x7F000000u : __float_as_uint(fmaxf(u0, 0.f)) + 1u, h1 = j1 > cur ? 0u : f1 ? 0x7F000000u : __float_as_uint(fmaxf(u1, 0.f)) + 1u;
                    unsigned T = 0u, U = 0u;
                    for (int bit = 30; bit >= 0; --bit) { const unsigned tr = T | (1u << bit), ur = U | (1u << bit);
                        const int cnt = __popcll(__ballot(k0 >= tr)) + __popcll(__ballot(k1 >= tr)), cnu = __popcll(__ballot(h0 >= ur)) + __popcll(__ballot(h1 >= ur));
                        if (cnt >= 16) T = tr;
                        if (cnu >= 16) U = ur; }
                    const unsigned long long below = (1ull << lane) - 1ull;
                    { const unsigned long long gt0 = __ballot(k0 > T), gt1 = __ballot(k1 > T), eq0 = __ballot(k0 == T), eq1 = __ballot(k1 == T);
                      const int need = 16 - (__popcll(gt0) + __popcll(gt1));
                      const int pre0 = __popcll(eq0 & below), pre1 = __popcll(eq0) + __popcll(eq1 & below);
                      const unsigned long long s0m = __ballot(k0 > T || (k0 == T && pre0 < need)), s1m = __ballot(k1 > T || (k1 == T && pre1 < need));
                      if (lane == 0) { selw[q8 * 4 + 0] = (unsigned)s0m; selw[q8 * 4 + 1] = (unsigned)(s0m >> 32); selw[q8 * 4 + 2] = (unsigned)s1m; selw[q8 * 4 + 3] = (unsigned)(s1m >> 32); } }
                    { const unsigned long long gt0 = __ballot(h0 > U), gt1 = __ballot(h1 > U), eq0 = __ballot(h0 == U), eq1 = __ballot(h1 == U);
                      const int need = 16 - (__popcll(gt0) + __popcll(gt1));
                      const int pre0 = __popcll(eq0 & below), pre1 = __popcll(eq0) + __popcll(eq1 & below);
                      const unsigned long long s0m = __ballot(h0 > U || (h0 == U && pre0 < need)), s1m = __ballot(h1 > U || (h1 == U && pre1 < need));
                      if (lane == 0) { selw[q8 * 4 + 4] = (unsigned)s0m; selw[q8 * 4 + 5] = (unsigned)(s0m >> 32); selw[q8 * 4 + 6] = (unsigned)s1m; selw[q8 * 4 + 7] = (unsigned)(s1m >> 32); } }
                }
            }
            asm volatile("s_waitcnt lgkmcnt(0)" ::: "memory");
            __syncthreads();
            for (int j = wave; j <= jq; j += 8) {
                unsigned long long mk = ~0ull;
                if (jq >= 16) { const unsigned wsel = *(LAS const unsigned*)(lds + AT_SEL + (lane >> 3) * 128 + (lane & 7) * 16 + (j >> 5) * 4); mk = __ballot((wsel >> (j & 31)) & 1u); }
                const unsigned mlo = (unsigned)mk, mhi = (unsigned)(mk >> 32);
                const int n = __popcll(mk), rk = (int)__builtin_amdgcn_mbcnt_hi(mhi, __builtin_amdgcn_mbcnt_lo(mlo, 0u));
                *(LAS unsigned char*)(lds + AT_QL + j * 64 + (((mk >> lane) & 1ull) ? rk : n + (lane - rk))) = (unsigned char)lane;
                if (lane == 0) *(LAS int*)(lds + AT_QM + j * 4) = n;
            }
#ifndef PROBE_SLC2
#define PROBE_SLC2 1
#endif
#ifdef PROBE_LIVE
            __syncthreads();
            if (hw == 0 && half == 1 && wave == 0) {
                int cnt = 0;
                for (int j = lane; j <= jq; j += 64) { const int n = *(LAS const int*)(lds + AT_QM + j * 4); cnt += PROBE_LIVE == 0 ? (n > 0 ? 1 : 0) : (n + 7) >> 3; }
                cnt = (int)wave_sum((float)cnt);
                const unsigned long long t_end = __builtin_amdgcn_s_memrealtime() + (unsigned long long)cnt * (PROBE_LIVE == 0 ? 100ull : 100ull / PROBE_LIVE);
                while (__builtin_amdgcn_s_memrealtime() < t_end) __builtin_amdgcn_s_sleep(8);
            }
#endif
#pragma unroll 1
            for (int rep = 0; rep < PROBE_SLC2; ++rep) {
            { const int colg = 32 * wave + col;
#pragma unroll
              for (int d0 = 0; d0 < 4; ++d0) *(LAS bf16x8*)(lds + AT_IMP + colg * 128 + (((d0 * 2 + hi) ^ (colg & 7)) << 4)) = qf[d0];
              for (int i = tid; i < 256 * AT_ROW / 4; i += 512) *(LAS f32x4*)(lds + AT_ACC + i * 16) = (f32x4){0.f, 0.f, 0.f, 0.f};
              if (tid < 256) *(LAS float*)(lds + AT_LS + tid * 4) = 0.f; }
            at_slc(KB + (size_t)bg * SEQ * 64, VB + (size_t)bg * SEQ * 64, jq, lds, coff, tid, lane, wave);
            }
            { const float lt2 = *(LAS const float*)(lds + AT_LS + (32 * wave + col) * 4);
              const float sc = g_s * (lt2 > 0.f ? 1.0f / lt2 : 0.f);
              LAS float* ap = (LAS float*)(lds + AT_ACC) + (32 * wave + col) * AT_ROW + 4 * hi;
#pragma unroll
              for (int dh = 0; dh < 2; ++dh)
#pragma unroll
                for (int rg = 0; rg < 4; ++rg) { const f32x4 c4 = *(const f32x4*)(op + 32 * dh + 8 * rg);
                    LAS f32x4* a1 = (LAS f32x4*)(ap + dh * 32 + 8 * rg); const f32x4 s4 = *a1; *a1 = c4 + sc * s4; } }
            const int kw0 = t0 >= 512 ? t0 - 512 : 0;
            o[0] = f32x16{}; o[1] = f32x16{}; m = AT_MINIT; l = 0.f;
            at_branch<2>(KB + ((size_t)(4 + bg) * SEQ + kw0) * 64, VB + ((size_t)(4 + bg) * SEQ + kw0) * 64, kw0, (t0 + 64 - kw0) >> 6, lds, qf, o, m, l, t, 0ull, 0ull, wlo, whi, impw, tid, lane, coffw);
            lt = xsum32(l); il = lt > 0.f ? 1.0f / lt : 0.f;
            { const float sc = g_w * il;
              LAS const float* ap = (LAS const float*)(lds + AT_ACC) + (32 * wave + col) * AT_ROW + 4 * hi;
#pragma unroll
              for (int dh = 0; dh < 2; ++dh)
#pragma unroll
                for (int rg = 0; rg < 4; ++rg) { const f32x4 a4 = *(LAS const f32x4*)(ap + dh * 32 + 8 * rg);
                    o[dh][4 * rg] = a4[0] + sc * o[dh][4 * rg]; o[dh][4 * rg + 1] = a4[1] + sc * o[dh][4 * rg + 1]; o[dh][4 * rg + 2] = a4[2] + sc * o[dh][4 * rg + 2]; o[dh][4 * rg + 3] = a4[3] + sc * o[dh][4 * rg + 3]; } }
#pragma unroll
            for (int dh = 0; dh < 2; ++dh)
#pragma unroll
                for (int rg = 0; rg < 4; ++rg) *(f32x4*)(op + 32 * dh + 8 * rg) = (f32x4){o[dh][4 * rg], o[dh][4 * rg + 1], o[dh][4 * rg + 2], o[dh][4 * rg + 3]};
        }
    }
}

enum { SK_Z = 0, SK_GLU, SK_OUT, SK_UP, SK_DOWN };
template <int EP, int K, int NCG = 4>
__device__ __forceinline__ void skinny_gemm(const P& p, LAS unsigned char* lds, const bf16* A  , const bf16* Bt, int ncolblk, int first_wg) {
    const int tid = tid_now(), lane = tid & 63, wave = __builtin_amdgcn_readfirstlane(tid >> 6), fr = lane & 15, fq = lane >> 4;
    constexpr int KW = K / 8, NKS = KW / 32, KR = NCG == 2 ? NKS : (NKS > 8 ? 6 : 4);
    static_assert(KW % 32 == 0, "K / 8 must be a multiple of 32");
    LAS float* part = (LAS float*)lds;
    const int nwg = (int)gridDim.x - first_wg;
    if ((int)blockIdx.x < first_wg) return;
    for (int u = (int)blockIdx.x - first_wg; u < 4 * ncolblk; u += nwg) {
        const int rb = u & 3, cb = u >> 2;
        const bf16* ap = A + (size_t)(32 * rb + fr) * K + wave * KW + 8 * fq;
        const bf16* bp[NCG];
#pragma unroll
        for (int n = 0; n < NCG; ++n) { int brow;
            if (EP == SK_UP) brow = (cb >> 2) * 256 + (cb & 3) * 32 + (n >> 1) * 128 + (n & 1) * 16 + fr;
            else brow = cb * (16 * NCG) + 16 * n + fr;
            bp[n] = Bt + (size_t)brow * K + wave * KW + 8 * fq; }
        f32x4 acc[2][NCG];
#pragma unroll
        for (int m = 0; m < 2; ++m)
#pragma unroll
            for (int n = 0; n < NCG; ++n) acc[m][n] = (f32x4){0.f, 0.f, 0.f, 0.f};
#pragma unroll 1
        for (int k0 = 0; k0 < NKS; k0 += KR) {
            bf16x8 a[KR][2], bw[KR][NCG];
#pragma unroll
            for (int s = 0; s < KR; ++s) if (k0 + s < NKS) {
#pragma unroll
                for (int m = 0; m < 2; ++m) a[s][m] = *(const bf16x8*)(ap + (size_t)(16 * m) * K + 32 * (k0 + s));
#pragma unroll
                for (int n = 0; n < NCG; ++n) bw[s][n] = *(const bf16x8*)(bp[n] + 32 * (k0 + s)); }
#pragma unroll
            for (int s = 0; s < KR; ++s) if (k0 + s < NKS) {
#pragma unroll
                for (int m = 0; m < 2; ++m)
#pragma unroll
                    for (int n = 0; n < NCG; ++n) acc[m][n] = MFMA16(bw[s][n], a[s][m], acc[m][n]); }
        }
#pragma unroll
        for (int m = 0; m < 2; ++m)
#pragma unroll
            for (int n = 0; n < NCG; ++n) *(LAS f32x4*)(part + wave * 2048 + (16 * m + fr) * 64 + 16 * n + 4 * fq) = acc[m][n];
        __syncthreads();
        {
            const int row = tid >> 4, c4 = tid & 15, r = MP + 32 * rb + row;
            f32x4 v = (f32x4){0.f, 0.f, 0.f, 0.f}, v2 = (f32x4){0.f, 0.f, 0.f, 0.f};
#pragma unroll
            for (int w = 0; w < 8; ++w) { v += *(const LAS f32x4*)(part + w * 2048 + row * 64 + 4 * c4); if (EP == SK_UP) v2 += *(const LAS f32x4*)(part + w * 2048 + row * 64 + ((4 * c4 + 32) & 63)); }
            const float* ADA = (const float*)(p.ws + WS_ADA) + (size_t)ada_row(r) * 6144;
            if (EP == SK_Z) { *(f32x4*)((float*)(p.ws + WS_Z) + (size_t)r * INP + cb * 64 + 4 * c4) = v; }
            if (EP == SK_GLU) { const int col = cb * 64 + 4 * c4; const f32x4 s = *(const f32x4*)((const float*)(p.ws + WS_SF) + (size_t)r * 512 + col); const f32x4 bv = *(const f32x4*)(p.b_glu + col);
                f32x4 o; o.x = s.x * sigmoid_f(v.x + bv.x); o.y = s.y * sigmoid_f(v.y + bv.y); o.z = s.z * sigmoid_f(v.z + bv.z); o.w = s.w * sigmoid_f(v.w + bv.w);
                *(f32x4*)((float*)(p.ws + WS_S2) + (size_t)r * 512 + col) = o; }
            if (EP == SK_OUT) { const int col = cb * 64 + 4 * c4;
                *(f32x4*)((float*)(p.ws + WS_X1) + (size_t)r * D + col) = *(const f32x4*)(p.xs + (size_t)(r - MP) * D + col) + *(const f32x4*)(ADA + 2 * D + col) * v; }
            if (EP == SK_UP) { if (c4 < 8) { u32x2 o; o.x = pk2(silu_f(v.x) * v2.x, silu_f(v.y) * v2.y); o.y = pk2(silu_f(v.z) * v2.z, silu_f(v.w) * v2.w);
                *(u32x2*)((bf16*)(p.ws + WS_FF) + (size_t)r * DFF + cb * 32 + 4 * c4) = o; } }
            if (EP == SK_DOWN && 4 * c4 < 16 * NCG) { const int col = cb * (16 * NCG) + 4 * c4;
                *(f32x4*)(p.out + O_YS + (size_t)(r - MP) * D + col) = *(const f32x4*)((const float*)(p.ws + WS_X1) + (size_t)r * D + col) + *(const f32x4*)(ADA + 5 * D + col) * v; }
        }
        __syncthreads();
    }
}

struct EpiInproj {
    static constexpr bool PERM = false, AFTER_DRAIN = false;
    float* out; bf16 *QB, *KB, *VB; float *GATES, *U; const float *ROPE, *q_g, *k_g; LAS float* red;
    __device__ __forceinline__ void operator()(const pg8::f32x4 (&acc)[2][2][4][2], const pg8::Unit& u, int wr, int wc, int fr, int fq) const {
        const int pn = u.pn, row0 = u.pm * 256 + wr * 64 + fr;
        if (pn >= 5) {
#pragma unroll
            for (int ai = 0; ai < 2; ++ai)
#pragma unroll
                for (int m = 0; m < 4; ++m) { const int r = row0 + ai * 128 + m * 16;
#pragma unroll
                    for (int bj = 0; bj < 2; ++bj)
#pragma unroll
                        for (int n = 0; n < 2; ++n) { const int zc = pn * 256 + bj * 128 + wc * 32 + n * 16 + 4 * fq; const pg8::f32x4 v = acc[ai][bj][m][n];
                            if (zc < O3) { pg8::f32x4 g; g[0] = sigmoid_f(v[0]); g[1] = sigmoid_f(v[1]); g[2] = sigmoid_f(v[2]); g[3] = sigmoid_f(v[3]); *(pg8::f32x4*)(GATES + (size_t)r * 24 + (zc - O2)) = g; }
                            else if (zc < INC) *(pg8::f32x4*)(U + (size_t)r * SW + (zc - O3)) = v; } }
            return;
        }
        const bool qtile = pn < 2; const int br = pn - 2;
        LAS float* rw = red + (wr * 64 + fr) * 8 + wc; LAS float* rx = red + (wr * 64 + fr) * 8 + (wc ^ 1);
#pragma unroll
        for (int ai = 0; ai < 2; ++ai)
#pragma unroll
            for (int m = 0; m < 4; ++m)
#pragma unroll
                for (int bj = 0; bj < 2; ++bj) { if (bj == 1 && !qtile) continue;
                    const pg8::f32x4 a = acc[ai][bj][m][0], c = acc[ai][bj][m][1];
                    float s = (a[0] * a[0] + a[1] * a[1]) + (a[2] * a[2] + a[3] * a[3]) + (c[0] * c[0] + c[1] * c[1]) + (c[2] * c[2] + c[3] * c[3]);
                    { const auto r16 = __builtin_amdgcn_permlane16_swap(__float_as_uint(s), __float_as_uint(s), false, false); s = __uint_as_float(r16[0]) + __uint_as_float(r16[1]); }
                    { const auto r32 = __builtin_amdgcn_permlane32_swap(__float_as_uint(s), __float_as_uint(s), false, false); s = __uint_as_float(r32[0]) + __uint_as_float(r32[1]); }
                    if (fq == 0) rw[(ai * 128 + m * 16) * 8 + bj * 4] = s; }
        asm volatile("s_waitcnt lgkmcnt(0)" ::: "memory"); __builtin_amdgcn_s_barrier(); asm volatile("" ::: "memory");
        const int hc = 32 * (wc & 1) + 4 * fq;
        const int b = (u.pm * 256) / SEQ;
        const float* gp = qtile ? q_g : k_g + br * 64;
        const pg8::f32x4 g0 = *(const pg8::f32x4*)(gp + hc), g1 = *(const pg8::f32x4*)(gp + hc + 16);
        const bool rot = (wc & 1) == 0;
        pg8::f32x4 csn = {0.f, 0.f, 0.f, 0.f}, snn = {0.f, 0.f, 0.f, 0.f};
        if (rot) { const int t0r = (u.pm * 256 + wr * 64 + fr) % SEQ; csn = *(const pg8::f32x4*)(ROPE + (size_t)t0r * 16 + 4 * (fq & 1)); snn = *(const pg8::f32x4*)(ROPE + (size_t)t0r * 16 + 8 + 4 * (fq & 1)); }
#pragma unroll
        for (int ai = 0; ai < 2; ++ai)
#pragma unroll
            for (int m = 0; m < 4; ++m) {
                const int rl = ai * 128 + wr * 64 + m * 16 + fr, r = u.pm * 256 + rl, t = r % SEQ;
                const pg8::f32x4 cs = csn, sn = snn;
                if (rot && (ai * 4 + m) < 7) { const int itn = ai * 4 + m + 1, tn = (u.pm * 256 + (itn >> 2) * 128 + wr * 64 + (itn & 3) * 16 + fr) % SEQ;
                    csn = *(const pg8::f32x4*)(ROPE + (size_t)tn * 16 + 4 * (fq & 1)); snn = *(const pg8::f32x4*)(ROPE + (size_t)tn * 16 + 8 + 4 * (fq & 1)); }
#pragma unroll
                for (int bj = 0; bj < 2; ++bj) {
                    pg8::f32x4 y0 = acc[ai][bj][m][0], y1 = acc[ai][bj][m][1];
                    const bool normed = qtile || bj == 0;
                    if (normed) {
                        const float ss = rw[(ai * 128 + m * 16) * 8 + bj * 4] + rx[(ai * 128 + m * 16) * 8 + bj * 4];
                        const float rstd = 1.0f / sqrtf(ss * (1.0f / 64.0f) + EPS);
                        y0 = y0 * rstd * g0; y1 = y1 * rstd * g1;
                        if (rot) {
#pragma unroll
                            for (int j = 0; j < 4; ++j) { const float own = y0[j];
                                const auto rr = __builtin_amdgcn_permlane32_swap(__float_as_uint(own), __float_as_uint(own), false, false);
                                const float pr = __uint_as_float(fq >= 2 ? rr[0] : rr[1]);
                                y0[j] = fq < 2 ? own * cs[j] - pr * sn[j] : pr * sn[j] + own * cs[j]; }
                        }
                    }
                    if (qtile) {
                        const float qs = 0.125f * 1.4426950408889634f;
                        bf16* qp = QB + ((size_t)(b * 2 + pn) * SEQ + t) * 256 + (2 * bj + (wc >> 1)) * 64 + hc;
                        u32x2 o0, o1; o0.x = pk2(y0[0] * qs, y0[1] * qs); o0.y = pk2(y0[2] * qs, y0[3] * qs); o1.x = pk2(y1[0] * qs, y1[1] * qs); o1.y = pk2(y1[2] * qs, y1[3] * qs);
                        *(u32x2*)qp = o0; *(u32x2*)(qp + 16) = o1;
                    } else {
                        const int kc = bj * 128 + (wc >> 1) * 64 + hc;
                        float* op = br == 0 ? out + O_KVC_P + (size_t)r * 256 : br == 1 ? out + O_KVS_P + (size_t)r * 256 : (t >= SEQ - 512 ? out + O_KVW_P + (size_t)(b * 512 + t - (SEQ - 512)) * 256 : nullptr);
                        if (op) { *(pg8::f32x4*)(op + kc) = y0; *(pg8::f32x4*)(op + kc + 16) = y1; }
                        if (br > 0) { bf16* kp = (bj ? VB : KB) + ((size_t)(((br - 1) * NBP + b) * 2 + (wc >> 1)) * SEQ + t) * 64 + hc;
                            u32x2 o0, o1; o0.x = pk2(y0[0], y0[1]); o0.y = pk2(y0[2], y0[3]); o1.x = pk2(y1[0], y1[1]); o1.y = pk2(y1[2], y1[3]);
                            *(u32x2*)kp = o0; *(u32x2*)(kp + 16) = o1; }
                    }
                }
                asm volatile("" ::: "memory");
            }
    }
};

enum { PH_PREP = 0, PH_H, PH_INPROJ, PH_SSM1, PH_CMPGEMM, PH_ATTN, PH_MIXIN, PH_OUT, PH_H2, PH_UP, PH_DOWN, PH_N };
constexpr int BAR_LDS_OFF = 148 * 1024;
constexpr int CW_BAR = 4096;

template <int PH>
__device__ __forceinline__ void run_phase(const P& p, LAS unsigned char* lds) {
    unsigned char* ws = p.ws;
    if constexpr (PH == PH_PREP) ph_prep(p, lds);
    if constexpr (PH == PH_H) { ph_normmod<0>(p); ph_cmpf<0>(p, lds); }
    if constexpr (PH == PH_INPROJ) { pg8::Gemm g{(const bf16*)(ws + WS_H), (const bf16*)(ws + WS_WIN_T), MP, INP, D}; pg8::StaticOrder S; S.init(MP, INP, gridDim.x, blockIdx.x);
        EpiInproj E{p.out, (bf16*)(ws + WS_QB), (bf16*)(ws + WS_KB), (bf16*)(ws + WS_VB), (float*)(ws + WS_GATES), (float*)(ws + WS_U), (const float*)(ws + WS_ROPE), p.q_g, p.k_g, (LAS float*)(lds + 132 * 1024)};
        pg8::gemm_phase<EpiInproj, pg8::StaticOrder>(lds, g, S, E, nullptr);
        skinny_gemm<SK_Z, 1024>(p, lds, (const bf16*)(ws + WS_H) + (size_t)MP * D, (const bf16*)(ws + WS_WIN_T), 29, 0); }
    if constexpr (PH == PH_SSM1) { ph_split(p, lds); __syncthreads(); ph_ssm<1>(p, lds, 0, (int)gridDim.x, 0, NBP * NSG * NCH, 1 << 30, 0); }
    if constexpr (PH == PH_CMPGEMM) {
        constexpr int NP = NBP * NSG * NCH, NS = DB * NSG;
        if (gridDim.x == 256) {
            if (blockIdx.x < 64) { ph_cmpf_small(p, lds, blockIdx.x); __syncthreads(); ph_ssm<2>(p, lds, 0, 64, NP - 512, NP, 1 << 30, 0); }
            else ph_ssm<2>(p, lds, 64, 256, 0, NP - 512 + NS, NP - 512, 512);
        } else { for (int u = blockIdx.x; u < 64; u += gridDim.x) { ph_cmpf_small(p, lds, u); } __syncthreads(); ph_ssm<2>(p, lds, 0, (int)gridDim.x, 0, NP + NS, 1 << 30, 0); } }
    if constexpr (PH == PH_ATTN) { ph_attn_prompt(p, lds); __syncthreads(); ph_attn_sample(p, lds); __syncthreads();
        { pg8::Gemm g{(const bf16*)(ws + WS_SB), (const bf16*)(ws + WS_WGLU_T), MP, 512, 512}; pg8::StaticOrder S; S.init(MP, 512, gridDim.x, blockIdx.x);
        EpiGlu E{(const float*)(ws + WS_SF), (float*)(ws + WS_S2), p.b_glu}; pg8::gemm_phase<EpiGlu, pg8::StaticOrder>(lds, g, S, E, nullptr);
        skinny_gemm<SK_GLU, 512>(p, lds, (const bf16*)(ws + WS_SB) + (size_t)MP * 512, (const bf16*)(ws + WS_WGLU_T), 8, (int)gridDim.x / 2); }
        __syncthreads();
        ph_late_transposes(p, lds, (int)gridDim.x / 2, (int)gridDim.x); }
    if constexpr (PH == PH_MIXIN) ph_mixin(p);
    if constexpr (PH == PH_OUT) { pg8::Gemm g{(const bf16*)(ws + WS_MIX), (const bf16*)(ws + WS_WOUT_T), MP, D, D}; pg8::StaticOrder S; S.init(MP, D, gridDim.x, blockIdx.x);
        EpiOut E{p.xp, p.xs, (const float*)(ws + WS_ADA), (float*)(ws + WS_X1)}; pg8::gemm_phase<EpiOut, pg8::StaticOrder>(lds, g, S, E, nullptr);
        skinny_gemm<SK_OUT, 1024>(p, lds, (const bf16*)(ws + WS_MIX) + (size_t)MP * D, (const bf16*)(ws + WS_WOUT_T), 16, 0); }
    if constexpr (PH == PH_H2) ph_normmod<1>(p);
    if constexpr (PH == PH_UP) { pg8::Gemm g{(const bf16*)(ws + WS_H), (const bf16*)(ws + WS_WUP_T), MP, 2 * DFF, D}; pg8::StaticOrder S; S.init(MP, 2 * DFF, gridDim.x, blockIdx.x);
        EpiUp E{(bf16*)(ws + WS_FF)}; pg8::gemm_phase<EpiUp, pg8::StaticOrder>(lds, g, S, E, nullptr);
        skinny_gemm<SK_UP, 1024>(p, lds, (const bf16*)(ws + WS_H) + (size_t)MP * D, (const bf16*)(ws + WS_WUP_T), 88, (int)gridDim.x / 2); }
    if constexpr (PH == PH_DOWN) { pg8::Gemm g{(const bf16*)(ws + WS_FF), (const bf16*)(ws + WS_WDN_T), MP, D, DFF}; pg8::StaticOrder S; S.init(MP, D, gridDim.x, blockIdx.x);
        EpiDown E{(const float*)(ws + WS_X1), (const float*)(ws + WS_ADA), p.out}; pg8::gemm_phase<EpiDown, pg8::StaticOrder>(lds, g, S, E, nullptr);
        skinny_gemm<SK_DOWN, 2816, 2>(p, lds, (const bf16*)(ws + WS_FF) + (size_t)MP * DFF, (const bf16*)(ws + WS_WDN_T), 32, 0); }
}

#ifndef REPMASK
#define REPMASK 0u
#endif
template <int PH, int HI>
__device__ __forceinline__ void run_from(const P& p, LAS unsigned char* lds, const XcdBarrier& bar) {
    run_phase<PH>(p, lds);
    if constexpr (((REPMASK) >> PH) & 1u) { xcd_barrier(bar); run_phase<PH>(p, lds); }
    if constexpr (PH + 1 < HI) { xcd_barrier(bar); run_from<PH + 1, HI>(p, lds, bar); }
}

template <int LO, int HI>
__global__ void __launch_bounds__(512, 2) k_fwd(P p) {
    extern __shared__ __attribute__((aligned(16))) unsigned char lds_raw[];
    LAS unsigned char* lds = (LAS unsigned char*)lds_raw;
    if (threadIdx.x < 4) ((LAS unsigned*)(lds + BAR_LDS_OFF))[threadIdx.x] = 0u;
    __syncthreads();
    XcdBarrier bar; bar.bar = (unsigned*)(p.ws + WS_CTL) + CW_BAR; bar.x = 0; bar.st = (volatile LAS unsigned*)(lds + BAR_LDS_OFF);
    if constexpr (HI - LO > 1) bar = xcd_barrier_post((unsigned*)(p.ws + WS_CTL) + CW_BAR, (volatile LAS unsigned*)(lds + BAR_LDS_OFF));
    run_from<LO, HI>(p, lds, bar);
}

extern "C" void kernel_launch(void* const* d_in, const int* in_sizes, int n_in, void* d_out, int out_size, void* d_ws, size_t ws_size, hipStream_t stream) {
    if (n_in != 39 || (size_t)out_size != O_END || ws_size < WS_END) { fprintf(stderr, "kernel_launch: unexpected shapes (n_in %d out %d ws %zu need %zu)\n", n_in, out_size, ws_size, (size_t)WS_END); return; }
    static int grid = 0;
    if (grid == 0) {
        int dev = 0, cus = 0, per_cu = 0;
        if (hipGetDevice(&dev) != hipSuccess || hipDeviceGetAttribute(&cus, hipDeviceAttributeMultiprocessorCount, dev) != hipSuccess) { fprintf(stderr, "kernel_launch: device query failed\n"); grid = -1; return; }
        if (hipFuncSetAttribute((const void*)k_fwd<0, PH_N>, hipFuncAttributeMaxDynamicSharedMemorySize, LDS_BYTES) != hipSuccess) { fprintf(stderr, "kernel_launch: hipFuncSetAttribute failed\n"); grid = -1; return; }
        if (hipOccupancyMaxActiveBlocksPerMultiprocessor(&per_cu, (const void*)k_fwd<0, PH_N>, 512, LDS_BYTES) != hipSuccess || per_cu < 1) { fprintf(stderr, "kernel_launch: occupancy query says %d blocks per CU\n", per_cu); (void)hipGetLastError(); grid = -1; return; }
        grid = cus;
    }
    if (grid < 0) return;
    P p{};
    p.xp = (const float*)d_in[0]; p.xs = (const float*)d_in[1]; p.cache_c = (const float*)d_in[2]; p.cache_s = (const float*)d_in[3]; p.cache_w = (const float*)d_in[4];
    p.st_re = (const float*)d_in[5]; p.st_im = (const float*)d_in[6]; p.pt = (const int*)d_in[7]; p.cp = (const float*)d_in[8]; p.cs = (const float*)d_in[9];
    p.norm_mix_g = (const float*)d_in[10]; p.w_ada = (const float*)d_in[11]; p.b_ada = (const float*)d_in[12]; p.w_in = (const float*)d_in[13]; p.q_g = (const float*)d_in[14]; p.k_g = (const float*)d_in[15];
    p.pe_k = (const float*)d_in[16]; p.w1_k = (const float*)d_in[17]; p.w2_k = (const float*)d_in[18]; p.pe_v = (const float*)d_in[19]; p.w1_v = (const float*)d_in[20]; p.w2_v = (const float*)d_in[21];
    p.a_re = (const float*)d_in[22]; p.a_im = (const float*)d_in[23]; p.log_dt = (const float*)d_in[24]; p.b_re = (const float*)d_in[25]; p.b_im = (const float*)d_in[26]; p.c_re = (const float*)d_in[27]; p.c_im = (const float*)d_in[28];
    p.ssm_d = (const float*)d_in[29]; p.w_glu = (const float*)d_in[30]; p.b_glu = (const float*)d_in[31]; p.attn_g = (const float*)d_in[32]; p.ssm_g = (const float*)d_in[33]; p.w_out = (const float*)d_in[34];
    p.norm_ffn_g = (const float*)d_in[35]; p.w_gate = (const float*)d_in[36]; p.w_up = (const float*)d_in[37]; p.w_down = (const float*)d_in[38];
    p.out = (float*)d_out; p.ws = (unsigned char*)d_ws;
    if (hipMemsetAsync((char*)d_ws + WS_CTL, 0, (size_t)(CW_BAR + XCD_BAR_WORDS) * 4, stream) != hipSuccess) { fprintf(stderr, "kernel_launch: memset failed\n"); return; }
    hipLaunchKernelGGL((k_fwd<0, PH_N>), dim3(grid), dim3(512), LDS_BYTES, stream, p);
}
```
